# Optimizing an MI355X kernel written in HIP

```python
import jax, jax.numpy as jnp
from jax import lax
import numpy as np

D_MODEL = 1024
BATCH = 4
SEQ = 8192
DEPTH = 2

HEAD_DIM = 64
MOBA_HEADS = 6
MOBA_BLOCK = 256
MOBA_TOPK = 3
MOBA_QBLOCK = 64
CONV_CH = 256
CONV_WIDTH = 31
DSA_HEADS = 6
DSA_TOPK = 256
DSA_QBLOCK = 128
IDX_HEADS = 8
IDX_DIM = 64
MOBA_W = 384
DSA_W = 384
MIX_W = 1024
SPLIT_SIZES = (384, 384, 384, 256, 256, 384, 384, 384, 512, 64, 8)
N_IN = 3400
N_GROUPS = 4
EXPERTS_PER_GROUP = 8
N_EXPERTS = 32
EXPERT_TOPK = 2
D_EXPERT = 512
MOE_BLOCK = 256
EPS = 1e-6

kernel_name = "hymba_moba_conformer_dsa_hmoe_adaln"


def rms_norm(x, g):
    xf = x.astype(jnp.float32)
    y = xf * lax.rsqrt(jnp.mean(xf * xf, axis=-1, keepdims=True) + EPS)
    return (y * g.astype(jnp.float32)).astype(x.dtype)


def layer_norm(x, g, b):
    xf = x.astype(jnp.float32)
    mu = jnp.mean(xf, axis=-1, keepdims=True)
    xc = xf - mu
    y = xc * lax.rsqrt(jnp.mean(xc * xc, axis=-1, keepdims=True) + EPS)
    return (y * g.astype(jnp.float32) + b.astype(jnp.float32)).astype(x.dtype)


def moba_attention(q, k, v):
    B, S, H, Dh = q.shape
    nb = -(-S // MOBA_BLOCK)
    pad = nb * MOBA_BLOCK - S
    to_blocks = lambda t: jnp.pad(t, ((0, 0), (0, pad), (0, 0), (0, 0))).reshape(
        B, nb, MOBA_BLOCK, H, Dh).transpose(0, 3, 1, 2, 4)
    kb, vb = to_blocks(k), to_blocks(v)
    k_mean = jnp.mean(kb.astype(jnp.float32), axis=3).astype(q.dtype)
    topb = min(MOBA_TOPK, nb)
    n_sel = topb * MOBA_BLOCK
    nq = S // MOBA_QBLOCK
    QB = MOBA_QBLOCK
    scale = HEAD_DIM ** -0.5
    gather_blocks = jax.vmap(jax.vmap(lambda blocks, idx: blocks[idx]))
    qs = q.reshape(B, nq, QB, H, Dh).transpose(1, 0, 3, 2, 4)

    def one_block(args):
        qb, i = args
        t = i * QB + jnp.arange(QB)
        own = (i * QB) // MOBA_BLOCK
        gate = jnp.einsum('bhqd,bhnd->bhqn', qb, k_mean).astype(jnp.float32)
        gate = jnp.where(jnp.arange(nb) < own, gate, -jnp.inf)
        _, sel = lax.top_k(gate, topb)
        k_sel = gather_blocks(kb, sel)
        v_sel = gather_blocks(vb, sel)
        k_own = lax.dynamic_index_in_dim(kb, own, axis=2, keepdims=False)
        v_own = lax.dynamic_index_in_dim(vb, own, axis=2, keepdims=False)
        s_sel = jnp.einsum('bhqd,bhqjkd->bhqjk', qb, k_sel).astype(jnp.float32) * scale
        s_sel = jnp.where((jnp.arange(topb) < own)[:, None], s_sel, -jnp.inf)
        s_own = jnp.einsum('bhqd,bhkd->bhqk', qb, k_own).astype(jnp.float32) * scale
        kpos = own * MOBA_BLOCK + jnp.arange(MOBA_BLOCK)
        s_own = jnp.where(kpos[None, :] <= t[:, None], s_own, -jnp.inf)
        p = jax.nn.softmax(jnp.concatenate([s_sel.reshape(B, H, QB, n_sel), s_own], axis=-1),
                           axis=-1).astype(v.dtype)
        out = (jnp.einsum('bhqjk,bhqjkd->bhqd', p[..., :n_sel].reshape(B, H, QB, topb, MOBA_BLOCK), v_sel)
               + jnp.einsum('bhqk,bhkd->bhqd', p[..., n_sel:], v_own))
        return out

    out = lax.map(one_block, (qs, jnp.arange(nq)))
    return out.transpose(1, 0, 3, 2, 4).reshape(B, S, H * Dh)


def conformer_conv(a, g, conv_w, conv_b, ln_g, ln_b):
    u = a * jax.nn.sigmoid(g)
    u = jnp.pad(u, ((0, 0), (CONV_WIDTH - 1, 0), (0, 0)))
    y = lax.conv_general_dilated(u, conv_w[:, None, :], window_strides=(1,), padding='VALID',
                                 dimension_numbers=('NWC', 'WIO', 'NWC'),
                                 feature_group_count=CONV_CH) + conv_b
    return jax.nn.silu(layer_norm(y, ln_g, ln_b))


def dsa_attention(q, k, v, q_idx, k_idx, w_idx):
    B, S, H, Dh = q.shape
    topk = min(DSA_TOPK, S // 4)
    QB = DSA_QBLOCK
    nq = S // QB
    k_idx32 = k_idx.astype(jnp.float32)
    w32 = w_idx.astype(jnp.float32) * (IDX_HEADS ** -0.5 * IDX_DIM ** -0.5)
    split = lambda t: t.reshape(B, nq, QB, *t.shape[2:]).swapaxes(0, 1)
    gather_keys = jax.vmap(lambda kv, idx: kv[idx])
    kpos = jnp.arange(S)

    def one_block(args):
        qb, qib, wb, i = args
        t = i * QB + jnp.arange(QB)
        score = jnp.einsum('bqh,bqhs->bqs', wb,
                           jax.nn.relu(jnp.einsum('bqhd,bsd->bqhs', qib.astype(jnp.float32), k_idx32)))
        score = jnp.where(kpos[None, :] <= t[:, None], score, -jnp.inf)
        _, idx = lax.top_k(score, topk)
        valid = idx <= t[None, :, None]
        k_sel = gather_keys(k, idx)
        v_sel = gather_keys(v, idx)
        s = jnp.einsum('bqhd,bqkhd->bhqk', qb, k_sel).astype(jnp.float32) * HEAD_DIM ** -0.5
        s = jnp.where(valid[:, None], s, -jnp.inf)
        p = jax.nn.softmax(s, axis=-1).astype(v.dtype)
        return jnp.einsum('bhqk,bqkhd->bqhd', p, v_sel)

    out = lax.map(one_block, (split(q), split(q_idx), split(w32), jnp.arange(nq)))
    return out.swapaxes(0, 1).reshape(B, S, H * Dh)


def hier_moe(h, rg_w, rg_b, re_w, re_b, w1, w3, w2):
    T, D = h.shape
    g_logits = (h @ rg_w + rg_b).astype(jnp.float32)
    g_idx = jnp.argmax(g_logits, axis=-1)
    g_w = jnp.max(jax.nn.softmax(g_logits, axis=-1), axis=-1)
    e_all = (h @ re_w + re_b).astype(jnp.float32).reshape(T, N_GROUPS, EXPERTS_PER_GROUP)
    e_logits = jnp.take_along_axis(e_all, g_idx[:, None, None], axis=1)[:, 0]
    e_top, e_loc = lax.top_k(e_logits, EXPERT_TOPK)
    gates = g_w[:, None] * jax.nn.softmax(e_top, axis=-1)
    expert = g_idx[:, None] * EXPERTS_PER_GROUP + e_loc
    n_slots = T * EXPERT_TOPK
    flat_e = expert.reshape(-1)
    order = jnp.argsort(flat_e)
    sorted_e = flat_e[order]
    counts = jnp.bincount(flat_e, length=N_EXPERTS)
    padded = (counts + MOE_BLOCK - 1) // MOE_BLOCK * MOE_BLOCK
    pad_end = jnp.cumsum(padded)
    pad_start = pad_end - padded
    start = jnp.cumsum(counts) - counts
    dest = pad_start[sorted_e] + jnp.arange(n_slots) - start[sorted_e]
    P = n_slots + N_EXPERTS * MOE_BLOCK
    nblk = P // MOE_BLOCK
    buf = jnp.zeros((P, D), h.dtype).at[dest].set(h[order // EXPERT_TOPK])
    blk_e = jnp.minimum(jnp.searchsorted(pad_end, jnp.arange(nblk) * MOE_BLOCK, side='right'),
                        N_EXPERTS - 1)

    def expert_block(args):
        xb, e = args
        return (jax.nn.silu(xb @ w1[e]) * (xb @ w3[e])) @ w2[e]

    yb = lax.map(expert_block, (buf.reshape(nblk, MOE_BLOCK, D), blk_e)).reshape(P, D)
    y_slots = jnp.zeros((n_slots, D), h.dtype).at[order].set(yb[dest])
    return jnp.sum(y_slots.reshape(T, EXPERT_TOPK, D) * gates[..., None].astype(h.dtype), axis=1)


def hybrid_layer(x, c, ada_w, ada_b, n1g, w_in, conv_w, conv_b, ln_g, ln_b, mg, dg, w_out,
                 n2g, rgw, rgb, rew, reb, w1, w3, w2):
    B, S, D = x.shape
    mod = jax.nn.silu(c) @ ada_w + ada_b
    sh1, sc1, g1, sh2, sc2, g2 = [m[:, None, :] for m in jnp.split(mod, 6, axis=-1)]
    h = rms_norm(x, n1g) * (1 + sc1) + sh1
    proj = h @ w_in
    qm, km, vm, ca, cg, qd, kd, vd, qi, ki, wi = jnp.split(
        proj, np.cumsum(SPLIT_SIZES)[:-1].tolist(), axis=-1)
    heads = lambda t, n: t.reshape(B, S, n, HEAD_DIM)
    y_moba = moba_attention(heads(qm, MOBA_HEADS), heads(km, MOBA_HEADS), heads(vm, MOBA_HEADS))
    y_conv = conformer_conv(ca, cg, conv_w, conv_b, ln_g, ln_b)
    y_dsa = dsa_attention(heads(qd, DSA_HEADS), heads(kd, DSA_HEADS), heads(vd, DSA_HEADS),
                          qi.reshape(B, S, IDX_HEADS, IDX_DIM), ki, wi)
    mix = jnp.concatenate([rms_norm(y_moba, mg), y_conv, rms_norm(y_dsa, dg)], axis=-1)
    x = x + g1 * (mix @ w_out)
    h2 = rms_norm(x, n2g) * (1 + sc2) + sh2
    y = hier_moe(h2.reshape(B * S, D), rgw, rgb, rew, reb, w1, w3, w2).reshape(B, S, D)
    return x + g2 * y


def setup_inputs(seed: int = 0) -> dict:
    key = jax.random.key(seed)
    ks = jax.random.split(key, 24)
    L, D = DEPTH, D_MODEL
    nrm = lambda k, shape, s: jax.random.normal(k, shape, jnp.float32) * s
    return {
        "x": nrm(ks[0], (BATCH, SEQ, D), 1.0),
        "c": nrm(ks[1], (BATCH, D), 1.0),
        "ada_w": nrm(ks[2], (L, D, 6 * D), 0.5 * D ** -0.5),
        "ada_b": nrm(ks[3], (L, 6 * D), 0.01),
        "norm1_g": 1.0 + nrm(ks[4], (L, D), 0.01),
        "w_in": nrm(ks[5], (L, D, N_IN), D ** -0.5),
        "conv_w": nrm(ks[6], (L, CONV_WIDTH, CONV_CH), CONV_WIDTH ** -0.5),
        "conv_b": nrm(ks[7], (L, CONV_CH), 0.01),
        "conv_ln_g": 1.0 + nrm(ks[8], (L, CONV_CH), 0.01),
        "conv_ln_b": nrm(ks[9], (L, CONV_CH), 0.01),
        "moba_norm_g": 1.0 + nrm(ks[10], (L, MOBA_W), 0.01),
        "dsa_norm_g": 1.0 + nrm(ks[11], (L, DSA_W), 0.01),
        "w_out": nrm(ks[12], (L, MIX_W, D), MIX_W ** -0.5),
        "norm2_g": 1.0 + nrm(ks[13], (L, D), 0.01),
        "router_group_w": nrm(ks[14], (L, D, N_GROUPS), D ** -0.5),
        "router_group_b": nrm(ks[15], (L, N_GROUPS), 0.01),
        "router_expert_w": nrm(ks[16], (L, D, N_EXPERTS), D ** -0.5),
        "router_expert_b": nrm(ks[17], (L, N_EXPERTS), 0.01),
        "expert_w1": nrm(ks[18], (L, N_EXPERTS, D, D_EXPERT), D ** -0.5),
        "expert_w3": nrm(ks[19], (L, N_EXPERTS, D, D_EXPERT), D ** -0.5),
        "expert_w2": nrm(ks[20], (L, N_EXPERTS, D_EXPERT, D), D_EXPERT ** -0.5),
        "final_g": 1.0 + nrm(ks[21], (D,), 0.01),
    }


def reference(x, c, ada_w, ada_b, norm1_g, w_in, conv_w, conv_b, conv_ln_g, conv_ln_b,
              moba_norm_g, dsa_norm_g, w_out, norm2_g, router_group_w, router_group_b,
              router_expert_w, router_expert_b, expert_w1, expert_w3, expert_w2, final_g):
    for l in range(DEPTH):
        x = hybrid_layer(x, c, ada_w[l], ada_b[l], norm1_g[l], w_in[l], conv_w[l], conv_b[l],
                         conv_ln_g[l], conv_ln_b[l], moba_norm_g[l], dsa_norm_g[l], w_out[l],
                         norm2_g[l], router_group_w[l], router_group_b[l], router_expert_w[l],
                         router_expert_b[l], expert_w1[l], expert_w3[l], expert_w2[l])
    return rms_norm(x, final_g)
```

```cpp
#include <hip/hip_runtime.h>
#include <stdint.h>

#define DI __device__ __forceinline__
typedef unsigned short bf16_t;
typedef short bf16x8 __attribute__((ext_vector_type(8)));
typedef short s16x4 __attribute__((ext_vector_type(4)));
typedef float f32x4 __attribute__((ext_vector_type(4)));
typedef float f32x16 __attribute__((ext_vector_type(16)));
typedef unsigned u32x4 __attribute__((ext_vector_type(4)));
typedef unsigned u32x2 __attribute__((ext_vector_type(2)));
typedef float f32x2_t __attribute__((ext_vector_type(2)));
typedef __bf16 bf16x2_t __attribute__((ext_vector_type(2)));
#define LAS __attribute__((address_space(3)))

constexpr int NB = 4, S = 8192, T = NB * S, D = 1024;
constexpr int PLD = 3456;
constexpr int C_QM = 0, C_KM = 384, C_VM = 768, C_CA = 1152, C_CG = 1408, C_QD = 1664, C_KD = 2048, C_VD = 2432, C_QI = 2816, C_KI = 3328, C_WI = 3392;
constexpr int NIN = 3400;
constexpr float EPS = 1e-6f;
constexpr int NTHR = 512;

constexpr size_t MiB = 1u << 20;
constexpr size_t WS_CTL = 0;
constexpr size_t WS_MOD = 1 * MiB;
constexpr size_t WS_KMEAN = WS_MOD + 256 * 1024;
constexpr size_t WS_SELM = WS_KMEAN + 256 * 1024;
constexpr size_t WS_GATE = WS_SELM + 1 * MiB;
constexpr size_t WS_LOGIT = WS_GATE + 512 * 1024;
constexpr size_t WS_LIST = WS_LOGIT + 5 * MiB;
constexpr size_t WS_WINT = WS_LIST + 8 * MiB;
constexpr size_t WS_WOUTT = WS_WINT + 7 * MiB;
constexpr size_t WS_RT = WS_WOUTT + 2 * MiB;
constexpr size_t WS_W13T = WS_RT + 1 * MiB;
constexpr size_t WS_W2T = WS_W13T + 64 * MiB;
constexpr size_t WS_HB = WS_W2T + 32 * MiB;
constexpr size_t WS_BMT = WS_HB + 64 * MiB;
constexpr size_t WS_PROJ = WS_BMT + 32 * MiB;
constexpr size_t WS_ACT = WS_PROJ;
constexpr size_t WS_YS = WS_PROJ + 64 * MiB;
constexpr size_t WS_END = WS_PROJ + 216 * MiB;
constexpr int CW_CNT = 0;

DI float bf2f(bf16_t b) { return __uint_as_float(((unsigned)b) << 16); }
DI float bflo(unsigned u) { return __uint_as_float(u << 16); }
DI float bfhi(unsigned u) { return __uint_as_float(u & 0xffff0000u); }
DI unsigned cvtpk(float lo, float hi) { f32x2_t v = {lo, hi}; bf16x2_t b = __builtin_convertvector(v, bf16x2_t); return __builtin_bit_cast(unsigned, b); }
DI float fexp2(float x) { return __builtin_amdgcn_exp2f(x); }
DI float frcp(float x) { return __builtin_amdgcn_rcpf(x); }
DI float silu_f(float x) { return x / (1.f + __expf(-x)); }
DI float wave_sum(float v) {
#pragma unroll
  for (int o = 32; o >= 1; o >>= 1) v += __shfl_xor(v, o);
  return v;
}
#define MFMA16(a, b, c) __builtin_amdgcn_mfma_f32_16x16x32_bf16((a), (b), (c), 0, 0, 0)
#define MFMA32(a, b, c) __builtin_amdgcn_mfma_f32_32x32x16_bf16((a), (b), (c), 0, 0, 0)

__global__ void __launch_bounds__(NTHR) k_mod(const float* __restrict__ c, const float* __restrict__ ada_w, const float* __restrict__ ada_b, float* __restrict__ mod) {
  __shared__ float sc[4][1024];
  __shared__ float red[8][4][64];
  const int tid = threadIdx.x;
  for (int i = tid; i < 4096; i += NTHR) sc[i >> 10][i & 1023] = silu_f(c[i]);
  __syncthreads();
  for (int u = blockIdx.x; u < 2 * 96; u += gridDim.x) {
    const int l = u / 96, n = (u % 96) * 64 + (tid & 63), ks = tid >> 6;
    const float* w = ada_w + (size_t)l * 1024 * 6144 + n;
    float a0 = 0.f, a1 = 0.f, a2 = 0.f, a3 = 0.f;
#pragma unroll 8
    for (int k = ks * 128; k < ks * 128 + 128; ++k) {
      const float wv = w[(size_t)k * 6144];
      a0 += sc[0][k] * wv; a1 += sc[1][k] * wv; a2 += sc[2][k] * wv; a3 += sc[3][k] * wv;
    }
    red[ks][0][tid & 63] = a0; red[ks][1][tid & 63] = a1; red[ks][2][tid & 63] = a2; red[ks][3][tid & 63] = a3;
    __syncthreads();
    if (tid < 256) {
      const int b = tid >> 6, nn = tid & 63;
      float s = 0.f;
#pragma unroll
      for (int k = 0; k < 8; ++k) s += red[k][b][nn];
      const int ncol = (u % 96) * 64 + nn;
      mod[((size_t)l * 4 + b) * 6144 + ncol] = s + ada_b[(size_t)l * 6144 + ncol];
    }
    __syncthreads();
  }
}

struct TJob { const float* src; bf16_t* dst; int R, C, Cpad, grp, stride, off; };

DI void transpose_tile(const TJob& J, int tr, int tc, float (*tile)[65]) {
  const int tid = threadIdx.x;
#pragma unroll
  for (int p = 0; p < 2; ++p) {
    const int r = (tid >> 4) + p * 32, c4 = (tid & 15) * 4;
    const int gr = tr * 64 + r, gc = tc * 64 + c4;
    float4 v = make_float4(0.f, 0.f, 0.f, 0.f);
    if (gc + 3 < J.C) v = *(const float4*)(J.src + (size_t)gr * J.C + gc);
    else { float t4[4] = {0.f, 0.f, 0.f, 0.f}; for (int q = 0; q < 4; ++q) if (gc + q < J.C) t4[q] = J.src[(size_t)gr * J.C + gc + q]; v = make_float4(t4[0], t4[1], t4[2], t4[3]); }
    tile[r][c4 + 0] = v.x; tile[r][c4 + 1] = v.y; tile[r][c4 + 2] = v.z; tile[r][c4 + 3] = v.w;
  }
  __syncthreads();
  {
    const int n = tid >> 3, kc = tid & 7;
    const int gc = tc * 64 + n;
    if (gc < J.Cpad) {
      const int drow = (gc / J.grp) * J.stride + J.off + (gc % J.grp);
      u32x4 o;
      o.x = cvtpk(tile[kc * 8 + 0][n], tile[kc * 8 + 1][n]); o.y = cvtpk(tile[kc * 8 + 2][n], tile[kc * 8 + 3][n]);
      o.z = cvtpk(tile[kc * 8 + 4][n], tile[kc * 8 + 5][n]); o.w = cvtpk(tile[kc * 8 + 6][n], tile[kc * 8 + 7][n]);
      *(u32x4*)(J.dst + (size_t)drow * J.R + tr * 64 + kc * 8) = o;
    }
  }
  __syncthreads();
}

constexpr int PREP_UNITS = 864 + 256 + 32 * 384;
DI void prep_unit(int u, const float* w_in, const float* w_out, const float* w1, const float* w3, const float* w2,
                  bf16_t* winT, bf16_t* woutT, bf16_t* w13T, bf16_t* w2T, float (*tile)[65]) {
  TJob J; int tr, tc;
  if (u < 864) { J = TJob{w_in, winT, 1024, NIN, PLD, 1 << 30, 0, 0}; tr = u % 16; tc = u / 16; }
  else if (u < 1120) { u -= 864; J = TJob{w_out, woutT, 1024, 1024, 1024, 1 << 30, 0, 0}; tr = u % 16; tc = u / 16; }
  else {
    u -= 1120; const int e = u / 384; int r = u % 384;
    if (r < 128) { J = TJob{w1 + (size_t)e * 1024 * 512, w13T + (size_t)e * 1024 * 1024, 1024, 512, 512, 32, 64, 0}; tr = r % 16; tc = r / 16; }
    else if (r < 256) { r -= 128; J = TJob{w3 + (size_t)e * 1024 * 512, w13T + (size_t)e * 1024 * 1024, 1024, 512, 512, 32, 64, 32}; tr = r % 16; tc = r / 16; }
    else { r -= 256; J = TJob{w2 + (size_t)e * 512 * 1024, w2T + (size_t)e * 1024 * 512, 512, 1024, 1024, 1 << 30, 0, 0}; tr = r % 8; tc = r / 8; }
  }
  transpose_tile(J, tr, tc, tile);
}

__global__ void __launch_bounds__(NTHR) k_prep_w(const float* w_in, const float* w_out, const float* w1, const float* w3, const float* w2,
                                                 bf16_t* winT, bf16_t* woutT, bf16_t* w13T, bf16_t* w2T) {
  __shared__ float tile[64][65];
  for (int u = blockIdx.x; u < PREP_UNITS; u += gridDim.x) prep_unit(u, w_in, w_out, w1, w3, w2, winT, woutT, w13T, w2T, tile);
}

__global__ void __launch_bounds__(NTHR) k_prep_rt(const float* __restrict__ rgw, const float* __restrict__ rew, bf16_t* __restrict__ rt) {
  for (int i = blockIdx.x * NTHR + threadIdx.x; i < 128 * 1024; i += gridDim.x * NTHR) {
    const int n = i >> 10, k = i & 1023;
    float v = 0.f;
    if (n < 4) v = rgw[k * 4 + n]; else if (n < 36) v = rew[k * 32 + (n - 4)];
    rt[i] = (bf16_t)(cvtpk(v, 0.f) & 0xffffu);
  }
}

__global__ void __launch_bounds__(NTHR) k_rmsmod(const float* __restrict__ x, const float* __restrict__ g, const float* __restrict__ mod_sh, const float* __restrict__ mod_sc, bf16_t* __restrict__ h) {
  const int lane = threadIdx.x & 63, wid = threadIdx.x >> 6;
  for (int row = blockIdx.x * 8 + wid; row < T; row += gridDim.x * 8) {
    const int b = row >> 13;
    const float* xr = x + (size_t)row * D;
    float4 v[4]; float ss = 0.f;
#pragma unroll
    for (int i = 0; i < 4; ++i) { v[i] = *(const float4*)(xr + i * 256 + lane * 4); ss += v[i].x * v[i].x + v[i].y * v[i].y + v[i].z * v[i].z + v[i].w * v[i].w; }
    ss = wave_sum(ss);
    const float rstd = rsqrtf(ss * (1.f / 1024.f) + EPS);
#pragma unroll
    for (int i = 0; i < 4; ++i) {
      const int col = i * 256 + lane * 4;
      const float4 gg = *(const float4*)(g + col), sc = *(const float4*)(mod_sc + (size_t)b * 6144 + col), sh = *(const float4*)(mod_sh + (size_t)b * 6144 + col);
      const float o0 = v[i].x * rstd * gg.x * (1.f + sc.x) + sh.x, o1 = v[i].y * rstd * gg.y * (1.f + sc.y) + sh.y;
      const float o2 = v[i].z * rstd * gg.z * (1.f + sc.z) + sh.z, o3 = v[i].w * rstd * gg.w * (1.f + sc.w) + sh.w;
      u32x2 o; o.x = cvtpk(o0, o1); o.y = cvtpk(o2, o3);
      *(u32x2*)(h + (size_t)row * D + col) = o;
    }
  }
}

enum { GM_INPROJ = 0, GM_OUTPROJ = 1, GM_ROUTER = 2, GM_MOE1 = 3, GM_MOE2 = 4 };
struct GemmP {
  const bf16_t* A; const bf16_t* Bt; int lda; int K;
  bf16_t* Obf; int ldo;
  const float* xin; float* xout; const float* gvec;
  float* logits;
  const unsigned* list; const int* cnt; const float* gate;
};
constexpr int GEMM_LDS = 98304 + 1024;

template <int MODE>
DI void gemm_tile(char* lds, const GemmP& P, const bf16_t* __restrict__ Bt, int m0, int n0, int nvalid, const unsigned* lst, int ebase) {
  const int tid = threadIdx.x, lane = tid & 63, wid = tid >> 6, fr = lane & 15, fq = lane >> 4;
  const int wm = wid >> 1, wn = wid & 1;
  const int K = P.K;
  int* ridx = (int*)(lds + 98304);
  if (MODE == GM_MOE1) {
    if (tid < 256) { const int r = tid < nvalid ? tid : 0; ridx[tid] = (int)(lst[r] >> 1); }
    __syncthreads();
  }
  const bf16_t* ap[4]; int aoff[4];
#pragma unroll
  for (int i = 0; i < 4; ++i) {
    const int c = tid + NTHR * i, row = c >> 3, kc = c & 7;
    size_t grow;
    if (MODE == GM_MOE1) grow = (size_t)ridx[row];
    else if (MODE == GM_MOE2) grow = (size_t)(ebase + (row < nvalid ? row : 0));
    else grow = (size_t)(m0 + row);
    ap[i] = P.A + grow * P.lda + kc * 8;
    aoff[i] = row * 128 + ((kc ^ (row & 7)) << 4);
  }
  const bf16_t* bp[2]; int boff[2];
#pragma unroll
  for (int i = 0; i < 2; ++i) {
    const int c = tid + NTHR * i, row = c >> 3, kc = c & 7;
    bp[i] = Bt + (size_t)(n0 + row) * K + kc * 8;
    boff[i] = 32768 + row * 128 + ((kc ^ (row & 7)) << 4);
  }
  f32x4 acc[4][4];
#pragma unroll
  for (int i = 0; i < 4; ++i)
#pragma unroll
    for (int j = 0; j < 4; ++j) acc[i][j] = (f32x4){0.f, 0.f, 0.f, 0.f};
  u32x4 ra[4], rb[2];
#pragma unroll
  for (int i = 0; i < 4; ++i) ra[i] = *(const u32x4*)(ap[i]);
#pragma unroll
  for (int i = 0; i < 2; ++i) rb[i] = *(const u32x4*)(bp[i]);
#pragma unroll
  for (int i = 0; i < 4; ++i) *(u32x4*)(lds + aoff[i]) = ra[i];
#pragma unroll
  for (int i = 0; i < 2; ++i) *(u32x4*)(lds + boff[i]) = rb[i];
  __syncthreads();
  const int nk = K >> 6;
  const int arow = wm * 64 + fr, brow = wn * 64 + fr, sw = fr & 7;
  for (int kt = 0; kt < nk; ++kt) {
    const int cur = kt & 1;
    if (kt + 1 < nk) {
#pragma unroll
      for (int i = 0; i < 4; ++i) ra[i] = *(const u32x4*)(ap[i] + (kt + 1) * 64);
#pragma unroll
      for (int i = 0; i < 2; ++i) rb[i] = *(const u32x4*)(bp[i] + (kt + 1) * 64);
    }
    const char* sb = lds + cur * 49152;
#pragma unroll
    for (int s = 0; s < 2; ++s) {
      bf16x8 a[4], b[4];
      const int ko = ((s * 4 + fq) ^ sw) << 4;
#pragma unroll
      for (int i = 0; i < 4; ++i) a[i] = *(const bf16x8*)(sb + (arow + i * 16) * 128 + ko);
#pragma unroll
      for (int j = 0; j < 4; ++j) b[j] = *(const bf16x8*)(sb + 32768 + (brow + j * 16) * 128 + ko);
#pragma unroll
      for (int i = 0; i < 4; ++i)
#pragma unroll
        for (int j = 0; j < 4; ++j) acc[i][j] = MFMA16(b[j], a[i], acc[i][j]);
    }
    if (kt + 1 < nk) {
      char* nb = lds + (cur ^ 1) * 49152;
#pragma unroll
      for (int i = 0; i < 4; ++i) *(u32x4*)(nb + aoff[i]) = ra[i];
#pragma unroll
      for (int i = 0; i < 2; ++i) *(u32x4*)(nb + boff[i]) = rb[i];
    }
    __syncthreads();
  }
#pragma unroll
  for (int i = 0; i < 4; ++i) {
    const int ml = wm * 64 + i * 16 + fr;
    const int m = m0 + ml;
    if (MODE == GM_INPROJ) {
#pragma unroll
      for (int j = 0; j < 4; ++j) {
        const int n = n0 + wn * 64 + j * 16 + fq * 4;
        u32x2 o; o.x = cvtpk(acc[i][j][0], acc[i][j][1]); o.y = cvtpk(acc[i][j][2], acc[i][j][3]);
        *(u32x2*)(P.Obf + (size_t)m * P.ldo + n) = o;
      }
    } else if (MODE == GM_OUTPROJ) {
      const int b = m >> 13;
#pragma unroll
      for (int j = 0; j < 4; ++j) {
        const int n = n0 + wn * 64 + j * 16 + fq * 4;
        const float4 xi = *(const float4*)(P.xin + (size_t)m * D + n);
        const float4 gv = *(const float4*)(P.gvec + (size_t)b * 6144 + n);
        float4 o; o.x = xi.x + gv.x * acc[i][j][0]; o.y = xi.y + gv.y * acc[i][j][1]; o.z = xi.z + gv.z * acc[i][j][2]; o.w = xi.w + gv.w * acc[i][j][3];
        *(float4*)(P.xout + (size_t)m * D + n) = o;
      }
    } else if (MODE == GM_ROUTER) {
#pragma unroll
      for (int j = 0; j < 4; ++j) {
        const int n = n0 + wn * 64 + j * 16 + fq * 4;
        if (n < 36) { float4 o; o.x = acc[i][j][0]; o.y = acc[i][j][1]; o.z = acc[i][j][2]; o.w = acc[i][j][3]; *(float4*)(P.logits + (size_t)m * 36 + n) = o; }
      }
    } else if (MODE == GM_MOE1) {
      if (ml < nvalid) {
        const int jb = (n0 + wn * 64) >> 6;
#pragma unroll
        for (int j = 0; j < 2; ++j) {
          const int col = jb * 32 + j * 16 + fq * 4;
          float v[4];
#pragma unroll
          for (int q = 0; q < 4; ++q) v[q] = silu_f(acc[i][j][q]) * acc[i][j + 2][q];
          u32x2 o; o.x = cvtpk(v[0], v[1]); o.y = cvtpk(v[2], v[3]);
          *(u32x2*)(P.Obf + (size_t)(ebase + ml) * 512 + col) = o;
        }
      }
    } else if (MODE == GM_MOE2) {
      if (ml < nvalid) {
        const unsigned slot = lst[ml];
        const float gt = P.gate[slot];
#pragma unroll
        for (int j = 0; j < 4; ++j) {
          const int n = n0 + wn * 64 + j * 16 + fq * 4;
          u32x2 o; o.x = cvtpk(acc[i][j][0] * gt, acc[i][j][1] * gt); o.y = cvtpk(acc[i][j][2] * gt, acc[i][j][3] * gt);
          *(u32x2*)(P.Obf + (size_t)slot * 1024 + n) = o;
        }
      }
    }
  }
  __syncthreads();
}

template <int MODE>
__global__ void __launch_bounds__(NTHR) k_gemm(GemmP P, int ntm, int ntn) {
  extern __shared__ __attribute__((aligned(16))) char lds[];
  if (MODE == GM_MOE1 || MODE == GM_MOE2) {
    int total_mt = 0;
    for (int e = 0; e < 32; ++e) total_mt += (P.cnt[e] + 255) >> 8;
    const int total = total_mt * 8;
    for (int u = blockIdx.x; u < total; u += gridDim.x) {
      int e = 0, rem = u, ebase = 0;
      for (;;) { const int c = P.cnt[e]; const int te = ((c + 255) >> 8) * 8; if (rem < te) break; rem -= te; ebase += c; ++e; }
      const int ce = P.cnt[e], tme = (ce + 255) >> 8;
      const int nt = rem / tme, mt = rem % tme;
      const int nvalid = min(256, ce - mt * 256);
      const unsigned* lst = P.list + (size_t)e * 65536 + mt * 256;
      const bf16_t* Bt = P.Bt + (size_t)e * 1024 * P.K;
      gemm_tile<MODE>(lds, P, Bt, mt * 256, nt * 128, nvalid, lst, ebase + mt * 256);
    }
  } else {
    const int total = ntm * ntn;
    for (int u = blockIdx.x; u < total; u += gridDim.x) {
      const int nt = u / ntm, mt = u % ntm;
      gemm_tile<MODE>(lds, P, P.Bt, mt * 256, nt * 128, 256, nullptr, 0);
    }
  }
}

__global__ void __launch_bounds__(NTHR) k_kmean(const bf16_t* __restrict__ proj, float* __restrict__ kmean) {
  const int tid = threadIdx.x;
  for (int u = blockIdx.x; u < NB * 32; u += gridDim.x) {
    const int b = u >> 5, blk = u & 31;
    if (tid < 384) {
      const bf16_t* p = proj + (size_t)(b * S + blk * 256) * PLD + C_KM + tid;
      float s = 0.f;
      for (int r = 0; r < 256; ++r) s += bf2f(p[(size_t)r * PLD]);
      kmean[((size_t)(b * 6 + tid / 64) * 32 + blk) * 64 + (tid & 63)] = s * (1.f / 256.f);
    }
  }
}

__global__ void __launch_bounds__(NTHR) k_gate(const bf16_t* __restrict__ proj, const float* __restrict__ kmean, unsigned* __restrict__ selm) {
  const int tid = threadIdx.x;
  for (int u = blockIdx.x; u < T / 64; u += gridDim.x) {
    if (tid < 384) {
      const int tok = u * 64 + (tid & 63), head = tid >> 6;
      const int b = tok >> 13, t = tok & (S - 1), own = t >> 8;
      u32x4 q[8];
      const bf16_t* qp = proj + (size_t)tok * PLD + C_QM + head * 64;
#pragma unroll
      for (int i = 0; i < 8; ++i) q[i] = *(const u32x4*)(qp + i * 8);
      float v1 = -INFINITY, v2 = -INFINITY, v3 = -INFINITY; int i1 = -1, i2 = -1, i3 = -1;
      for (int j = 0; j < own; ++j) {
        const float* km = kmean + ((size_t)(b * 6 + head) * 32 + j) * 64;
        float g = 0.f;
#pragma unroll
        for (int i = 0; i < 8; ++i) {
          const float4 ka = *(const float4*)(km + i * 8), kb = *(const float4*)(km + i * 8 + 4);
          g += bflo(q[i].x) * ka.x + bfhi(q[i].x) * ka.y + bflo(q[i].y) * ka.z + bfhi(q[i].y) * ka.w;
          g += bflo(q[i].z) * kb.x + bfhi(q[i].z) * kb.y + bflo(q[i].w) * kb.z + bfhi(q[i].w) * kb.w;
        }
        if (g > v1) { v3 = v2; i3 = i2; v2 = v1; i2 = i1; v1 = g; i1 = j; }
        else if (g > v2) { v3 = v2; i3 = i2; v2 = g; i2 = j; }
        else if (g > v3) { v3 = g; i3 = j; }
      }
      unsigned m = 0;
      if (i1 >= 0) m |= 1u << i1;
      if (i2 >= 0) m |= 1u << i2;
      if (i3 >= 0) m |= 1u << i3;
      selm[(size_t)tok * 6 + head] = m;
    }
  }
}

constexpr int ATT_LDS = 32768;
constexpr float C2 = 0.125f * 1.4426950408889634f;
DI int crow(int r, int hi) { return (r & 3) + 8 * (r >> 2) + 4 * hi; }
typedef short v4i16_t __attribute__((ext_vector_type(4)));
DI s16x4 vtr(const LAS char* p) { return __builtin_bit_cast(s16x4, __builtin_amdgcn_ds_read_tr16_b64_v4i16((LAS v4i16_t*)p)); }

template <int MODE>
DI void attn_unit(char* lds, const bf16_t* __restrict__ proj, bf16_t* __restrict__ mix, const unsigned* __restrict__ selm, const uint2* __restrict__ bmt, int b, int h, int qb) {
  const int tid = threadIdx.x, lane = tid & 63, wid = tid >> 6, r32 = lane & 31, hi = lane >> 5;
  constexpr int QC = MODE ? C_QD : C_QM, KC = MODE ? C_KD : C_KM, VC = MODE ? C_VD : C_VM, OC = MODE ? 640 : 0;
  const int qrel = wid * 32 + r32;
  const int t = qb * 256 + qrel;
  const size_t tokq = (size_t)(b * S + t);
  bf16x8 qr[4];
  {
    const bf16_t* qp = proj + tokq * PLD + QC + h * 64 + hi * 8;
#pragma unroll
    for (int d0 = 0; d0 < 4; ++d0) {
      const u32x4 v = *(const u32x4*)(qp + d0 * 16);
      u32x4 o;
      o.x = cvtpk(bflo(v.x) * C2, bfhi(v.x) * C2); o.y = cvtpk(bflo(v.y) * C2, bfhi(v.y) * C2);
      o.z = cvtpk(bflo(v.z) * C2, bfhi(v.z) * C2); o.w = cvtpk(bflo(v.w) * C2, bfhi(v.w) * C2);
      qr[d0] = __builtin_bit_cast(bf16x8, o);
    }
  }
  unsigned sel = 0;
  if (MODE == 0) sel = selm[tokq * 6 + h];
  float m = -1e30f, l = 0.f;
  f32x16 o0, o1;
#pragma unroll
  for (int r = 0; r < 16; ++r) { o0[r] = 0.f; o1[r] = 0.f; }
  const int nt = 4 * qb + 4;
  const int skey = tid >> 3, sch = tid & 7;
  const bf16_t* kg = proj + (size_t)(b * S + skey) * PLD + KC + h * 64 + sch * 8;
  const bf16_t* vg = proj + (size_t)(b * S + skey) * PLD + VC + h * 64 + sch * 8;
  const int kso = skey * 128 + ((sch ^ (skey & 7)) << 4);
  const int vso = 8192 + (sch >> 2) * 4096 + skey * 64 + (sch & 3) * 16;
  const uint2* bmp = bmt + (size_t)(b * 128) * 8192 + t;
  u32x4 kr = *(const u32x4*)kg, vr = *(const u32x4*)vg;
  uint2 wcur = make_uint2(0u, 0u), wnext = make_uint2(0u, 0u);
  if (MODE == 1) wcur = bmp[0];
  *(u32x4*)(lds + kso) = kr; *(u32x4*)(lds + vso) = vr;
  __syncthreads();
  const LAS char* lds3 = (const LAS char*)lds;
  const int vb0 = 8192 + (4 * hi + ((lane & 15) >> 2)) * 64 + ((lane >> 4) & 1) * 32 + (lane & 3) * 8;
  const int ksw = r32 & 7;
  for (int kt = 0; kt < nt; ++kt) {
    const int cur = kt & 1;
    if (kt + 1 < nt) {
      kr = *(const u32x4*)(kg + (size_t)(kt + 1) * 64 * PLD); vr = *(const u32x4*)(vg + (size_t)(kt + 1) * 64 * PLD);
      if (MODE == 1) wnext = bmp[(size_t)(kt + 1) * 8192];
    }
    const char* kb = lds + cur * 16384;
    f32x16 p0, p1;
#pragma unroll
    for (int r = 0; r < 16; ++r) { p0[r] = 0.f; p1[r] = 0.f; }
#pragma unroll
    for (int d0 = 0; d0 < 4; ++d0) {
      const int co = ((2 * d0 + hi) ^ ksw) << 4;
      const bf16x8 ka = *(const bf16x8*)(kb + r32 * 128 + co);
      const bf16x8 kc = *(const bf16x8*)(kb + (r32 + 32) * 128 + co);
      p0 = MFMA32(ka, qr[d0], p0);
      p1 = MFMA32(kc, qr[d0], p1);
    }
    const float NEGBIG = -3.0e38f;
    if (MODE == 0) {
      const int j = kt >> 2;
      if (j < qb) {
        const bool on = (sel >> j) & 1u;
#pragma unroll
        for (int r = 0; r < 16; ++r) { p0[r] = on ? p0[r] : NEGBIG; p1[r] = on ? p1[r] : NEGBIG; }
      } else {
        const int kbase = (kt & 3) * 64 + 4 * hi;
#pragma unroll
        for (int r = 0; r < 16; ++r) {
          const int kv = kbase + (r & 3) + 8 * (r >> 2);
          if (kv > qrel) p0[r] = NEGBIG;
          if (kv + 32 > qrel) p1[r] = NEGBIG;
        }
      }
    } else {
      const unsigned w0 = wcur.x >> (4 * hi), w1 = wcur.y >> (4 * hi);
#pragma unroll
      for (int r = 0; r < 16; ++r) {
        const int pos = (r & 3) + 8 * (r >> 2);
        p0[r] = ((w0 >> pos) & 1u) ? p0[r] : NEGBIG;
        p1[r] = ((w1 >> pos) & 1u) ? p1[r] : NEGBIG;
      }
    }
    float mx = fmaxf(p0[0], p1[0]);
#pragma unroll
    for (int r = 1; r < 16; ++r) mx = fmaxf(mx, fmaxf(p0[r], p1[r]));
    mx = fmaxf(mx, __shfl_xor(mx, 32));
    const float mn = fmaxf(m, mx);
    const float alpha = fexp2(m - mn);
    m = mn;
    float ls = 0.f;
#pragma unroll
    for (int r = 0; r < 16; ++r) { p0[r] = fexp2(p0[r] - mn); p1[r] = fexp2(p1[r] - mn); ls += p0[r] + p1[r]; }
    l = l * alpha + ls;
#pragma unroll
    for (int r = 0; r < 16; ++r) { o0[r] *= alpha; o1[r] *= alpha; }
    bf16x8 pa[4];
#pragma unroll
    for (int ks = 0; ks < 2; ++ks) {
      u32x4 a, c;
      a.x = cvtpk(p0[8 * ks + 0], p0[8 * ks + 1]); a.y = cvtpk(p0[8 * ks + 2], p0[8 * ks + 3]); a.z = cvtpk(p0[8 * ks + 4], p0[8 * ks + 5]); a.w = cvtpk(p0[8 * ks + 6], p0[8 * ks + 7]);
      c.x = cvtpk(p1[8 * ks + 0], p1[8 * ks + 1]); c.y = cvtpk(p1[8 * ks + 2], p1[8 * ks + 3]); c.z = cvtpk(p1[8 * ks + 4], p1[8 * ks + 5]); c.w = cvtpk(p1[8 * ks + 6], p1[8 * ks + 7]);
      pa[ks] = __builtin_bit_cast(bf16x8, a); pa[ks + 2] = __builtin_bit_cast(bf16x8, c);
    }
    const LAS char* vb = lds3 + cur * 16384 + vb0;
#pragma unroll
    for (int ks = 0; ks < 4; ++ks) {
      const s16x4 l0 = vtr(vb + ks * 1024), h0 = vtr(vb + ks * 1024 + 512);
      const s16x4 l1 = vtr(vb + 4096 + ks * 1024), h1 = vtr(vb + 4096 + ks * 1024 + 512);
      const bf16x8 f0 = (bf16x8){l0[0], l0[1], l0[2], l0[3], h0[0], h0[1], h0[2], h0[3]};
      const bf16x8 f1 = (bf16x8){l1[0], l1[1], l1[2], l1[3], h1[0], h1[1], h1[2], h1[3]};
      o0 = MFMA32(f0, pa[ks], o0);
      o1 = MFMA32(f1, pa[ks], o1);
    }
    if (kt + 1 < nt) {
      char* nb = lds + (cur ^ 1) * 16384;
      *(u32x4*)(nb + kso) = kr; *(u32x4*)(nb + vso) = vr;
      wcur = wnext;
    }
    __syncthreads();
  }
  l += __shfl_xor(l, 32);
  const float inv = 1.f / l;
  bf16_t* op = mix + tokq * D + OC + h * 64 + 4 * hi;
#pragma unroll
  for (int g = 0; g < 4; ++g) {
    u32x2 a, c;
    a.x = cvtpk(o0[4 * g + 0] * inv, o0[4 * g + 1] * inv); a.y = cvtpk(o0[4 * g + 2] * inv, o0[4 * g + 3] * inv);
    c.x = cvtpk(o1[4 * g + 0] * inv, o1[4 * g + 1] * inv); c.y = cvtpk(o1[4 * g + 2] * inv, o1[4 * g + 3] * inv);
    *(u32x2*)(op + 8 * g) = a;
    *(u32x2*)(op + 32 + 8 * g) = c;
  }
}

template <int MODE>
__global__ void __launch_bounds__(NTHR) k_attn(const bf16_t* __restrict__ proj, bf16_t* __restrict__ mix, const unsigned* __restrict__ selm, const uint2* __restrict__ bmt) {
  extern __shared__ __attribute__((aligned(16))) char lds[];
  for (int u = blockIdx.x; u < NB * 6 * 32; u += gridDim.x) {
    const int qb = 31 - (u / 24), bh = u % 24;
    attn_unit<MODE>(lds, proj, mix, selm, bmt, bh / 6, bh % 6, qb);
  }
}

constexpr int SEL_CAP = 1024, SEL_G = 512, SEL_K = 256;
constexpr int SEL_LDS = 131072 + 256;
DI unsigned fkey(float f) { const unsigned u = __float_as_uint(f); return (u & 0x80000000u) ? ~u : (u | 0x80000000u); }

DI void sel_compact(uint2* rowbuf, int n, unsigned* cntp, unsigned* taup) {
  const int lane = threadIdx.x & 63;
  unsigned long long e[16];
#pragma unroll
  for (int i = 0; i < 16; ++i) { const int idx = lane + 64 * i; uint2 v = make_uint2(0u, 0u); if (idx < n) v = rowbuf[idx]; e[i] = ((unsigned long long)v.y << 32) | v.x; }
  unsigned long long theta = 0ull;
  for (int bit = 63; bit >= 0; --bit) {
    const unsigned long long cand = theta | (1ull << bit);
    int c = 0;
#pragma unroll
    for (int i = 0; i < 16; ++i) c += __popcll(__ballot(e[i] >= cand));
    if (c >= SEL_K) theta = cand;
    if (c == SEL_K) break;
  }
  int base = 0;
  const unsigned long long lt = (1ull << lane) - 1ull;
#pragma unroll
  for (int i = 0; i < 16; ++i) {
    const bool s = e[i] >= theta;
    const unsigned long long bal = __ballot(s);
    const int pos = base + __popcll(bal & lt);
    if (s && pos < SEL_K) rowbuf[pos] = make_uint2((unsigned)e[i], (unsigned)(e[i] >> 32));
    base += __popcll(bal);
  }
  if (lane == 0) { *cntp = SEL_K; *taup = (unsigned)(theta >> 32); }
}

DI void dsa_select_unit(char* lds, const bf16_t* __restrict__ proj, uint2* __restrict__ bmt, int b, int rg) {
  uint2* buf = (uint2*)lds;
  unsigned* cnt = (unsigned*)(lds + 131072);
  unsigned* tau = cnt + 16;
  const int tid = threadIdx.x, lane = tid & 63, wid = tid >> 6, fr = lane & 15, fq = lane >> 4;
  const int t0 = rg * 16, t = t0 + fr;
  if (tid < 16) { cnt[tid] = 0u; tau[tid] = 0u; }
  const bf16_t* qrow = proj + (size_t)(b * S + t) * PLD;
  bf16x8 qf[8][2]; float w[8];
#pragma unroll
  for (int hh = 0; hh < 8; ++hh) {
    qf[hh][0] = *(const bf16x8*)(qrow + C_QI + hh * 64 + fq * 8);
    qf[hh][1] = *(const bf16x8*)(qrow + C_QI + hh * 64 + 32 + fq * 8);
    w[hh] = bf2f(qrow[C_WI + hh]);
  }
  bf16x8 q9[2];
#pragma unroll
  for (int s = 0; s < 2; ++s) {
    float f[8];
#pragma unroll
    for (int j = 0; j < 8; ++j) {
      float a = 0.f;
#pragma unroll
      for (int hh = 0; hh < 8; ++hh) a += w[hh] * bf2f((bf16_t)qf[hh][s][j]);
      f[j] = a;
    }
    u32x4 o; o.x = cvtpk(f[0], f[1]); o.y = cvtpk(f[2], f[3]); o.z = cvtpk(f[4], f[5]); o.w = cvtpk(f[6], f[7]);
    q9[s] = __builtin_bit_cast(bf16x8, o);
  }
  __syncthreads();
  const int ntile = rg + 1;
  const int nround = (ntile + 31) >> 5;
  const bf16_t* kbase = proj + (size_t)(b * S + fr) * PLD + C_KI + fq * 8;
  for (int rd = 0; rd < nround; ++rd) {
    const unsigned tauv = tau[fr];
#pragma unroll 1
    for (int i = 0; i < 4; ++i) {
      const int kt = rd * 32 + i * 8 + wid;
      if (kt < ntile) {
        const bf16_t* kp = kbase + (size_t)kt * 16 * PLD;
        const bf16x8 k0 = *(const bf16x8*)kp, k1 = *(const bf16x8*)(kp + 32);
        const f32x4 z = (f32x4){0.f, 0.f, 0.f, 0.f};
        f32x4 acc = MFMA16(k0, q9[0], z);
        acc = MFMA16(k1, q9[1], acc);
#pragma unroll
        for (int hh = 0; hh < 8; ++hh) {
          f32x4 x = MFMA16(k0, qf[hh][0], z);
          x = MFMA16(k1, qf[hh][1], x);
#pragma unroll
          for (int r = 0; r < 4; ++r) acc[r] = fmaf(fabsf(x[r]), w[hh], acc[r]);
        }
#pragma unroll
        for (int r = 0; r < 4; ++r) {
          const int key = kt * 16 + fq * 4 + r;
          const unsigned uk = fkey(acc[r]);
          if (key <= t && uk > tauv) {
            const unsigned slot = atomicAdd(&cnt[fr], 1u);
            if (slot < (unsigned)SEL_CAP) buf[fr * SEL_CAP + slot] = make_uint2(~(unsigned)key, uk);
          }
        }
      }
    }
    __syncthreads();
    const bool last = (rd == nround - 1);
#pragma unroll 1
    for (int rr = 0; rr < 2; ++rr) {
      const int row = 2 * wid + rr;
      int n = (int)cnt[row]; if (n > SEL_CAP) n = SEL_CAP;
      if (n > (last ? SEL_K : SEL_CAP - SEL_G)) sel_compact(buf + row * SEL_CAP, n, &cnt[row], &tau[row]);
    }
    __syncthreads();
  }
#pragma unroll
  for (int i = 0; i < 8; ++i) { const int wd = tid + NTHR * i; *(unsigned*)(lds + (wd >> 8) * 8192 + 4096 + (wd & 255) * 4) = 0u; }
  __syncthreads();
  {
    const int row = tid >> 5;
    int n = (int)cnt[row]; if (n > SEL_K) n = SEL_K;
    unsigned* img = (unsigned*)(lds + row * 8192 + 4096);
#pragma unroll
    for (int i = 0; i < 8; ++i) {
      const int e = (tid & 31) + 32 * i;
      if (e < n) { const unsigned idx = ~buf[row * SEL_CAP + e].x; atomicOr(&img[idx >> 5], 1u << (idx & 31)); }
    }
  }
  __syncthreads();
  {
    const int ntw = 4 * (t0 >> 8) + 4;
    const int r = tid & 15;
    const unsigned* img = (const unsigned*)(lds + r * 8192 + 4096);
    for (int tile = tid >> 4; tile < ntw; tile += 32)
      bmt[((size_t)(b * 128 + tile)) * 8192 + t0 + r] = make_uint2(img[2 * tile], img[2 * tile + 1]);
  }
  __syncthreads();
}

__global__ void __launch_bounds__(NTHR) k_select(const bf16_t* __restrict__ proj, uint2* __restrict__ bmt) {
  extern __shared__ __attribute__((aligned(16))) char lds[];
  for (int u = blockIdx.x; u < NB * 512; u += gridDim.x) {
    const int rg = 511 - (u >> 2), b = u & 3;
    dsa_select_unit(lds, proj, bmt, b, rg);
  }
}

constexpr int MIX_LDS = 94 * 256 * 4;
__global__ void __launch_bounds__(NTHR) k_mixfin(const bf16_t* __restrict__ proj, bf16_t* __restrict__ mix, const float* __restrict__ conv_w, const float* __restrict__ conv_b,
                                                 const float* __restrict__ ln_g, const float* __restrict__ ln_b, const float* __restrict__ mg, const float* __restrict__ dg) {
  extern __shared__ __attribute__((aligned(16))) char lds[];
  float* ut = (float*)lds;
  const int tid = threadIdx.x, lane = tid & 63, wid = tid >> 6;
  for (int u = blockIdx.x; u < T / 64; u += gridDim.x) {
    const int tok0 = u * 64, b = tok0 >> 13, t0 = tok0 & (S - 1);
    for (int task = tid; task < 94 * 32; task += NTHR) {
      const int row = task >> 5, cc = (task & 31) * 8;
      const int tt = t0 - 30 + row;
      float uv[8] = {0.f, 0.f, 0.f, 0.f, 0.f, 0.f, 0.f, 0.f};
      if (tt >= 0) {
        const bf16_t* pr = proj + (size_t)(b * S + tt) * PLD;
        const u32x4 a = *(const u32x4*)(pr + C_CA + cc), g = *(const u32x4*)(pr + C_CG + cc);
        const float av[8] = {bflo(a.x), bfhi(a.x), bflo(a.y), bfhi(a.y), bflo(a.z), bfhi(a.z), bflo(a.w), bfhi(a.w)};
        const float gv[8] = {bflo(g.x), bfhi(g.x), bflo(g.y), bfhi(g.y), bflo(g.z), bfhi(g.z), bflo(g.w), bfhi(g.w)};
#pragma unroll
        for (int q = 0; q < 8; ++q) uv[q] = av[q] / (1.f + __expf(-gv[q]));
      }
      *(float4*)(ut + row * 256 + cc) = make_float4(uv[0], uv[1], uv[2], uv[3]);
      *(float4*)(ut + row * 256 + cc + 4) = make_float4(uv[4], uv[5], uv[6], uv[7]);
    }
    __syncthreads();
    const int c = tid & 255, half = tid >> 8;
    float cw[31];
#pragma unroll
    for (int w = 0; w < 31; ++w) cw[w] = conv_w[w * 256 + c];
    float y[32];
    const float cb = conv_b[c];
#pragma unroll
    for (int o = 0; o < 32; ++o) y[o] = cb;
#pragma unroll
    for (int rho = 0; rho < 62; ++rho) {
      const float uvv = ut[(half * 32 + rho) * 256 + c];
#pragma unroll
      for (int o = 0; o < 32; ++o) { if (rho - o >= 0 && rho - o <= 30) y[o] += uvv * cw[rho - o]; }
    }
    __syncthreads();
#pragma unroll
    for (int o = 0; o < 32; ++o) ut[(half * 32 + o) * 256 + c] = y[o];
    __syncthreads();
    {
      const float4 gg = *(const float4*)(ln_g + lane * 4), bb = *(const float4*)(ln_b + lane * 4);
      for (int i = 0; i < 8; ++i) {
        const int tl = wid * 8 + i;
        const float4 v = *(const float4*)(ut + tl * 256 + lane * 4);
        const float mu = wave_sum(v.x + v.y + v.z + v.w) * (1.f / 256.f);
        const float d0 = v.x - mu, d1 = v.y - mu, d2 = v.z - mu, d3 = v.w - mu;
        const float var = wave_sum(d0 * d0 + d1 * d1 + d2 * d2 + d3 * d3) * (1.f / 256.f);
        const float rs = rsqrtf(var + EPS);
        const float z0 = d0 * rs * gg.x + bb.x, z1 = d1 * rs * gg.y + bb.y, z2 = d2 * rs * gg.z + bb.z, z3 = d3 * rs * gg.w + bb.w;
        u32x2 o; o.x = cvtpk(silu_f(z0), silu_f(z1)); o.y = cvtpk(silu_f(z2), silu_f(z3));
        *(u32x2*)(mix + (size_t)(tok0 + tl) * D + 384 + lane * 4) = o;
      }
    }
    for (int i = 0; i < 8; ++i) {
      const int tl = wid * 8 + i;
      bf16_t* mr = mix + (size_t)(tok0 + tl) * D;
#pragma unroll
      for (int part = 0; part < 2; ++part) {
        bf16_t* pp = mr + part * 640;
        const float* gv = part ? dg : mg;
        const u32x2 a = *(const u32x2*)(pp + lane * 4);
        u32x2 c2 = (u32x2){0u, 0u};
        if (lane < 32) c2 = *(const u32x2*)(pp + 256 + lane * 4);
        const float a0 = bflo(a.x), a1 = bfhi(a.x), a2 = bflo(a.y), a3 = bfhi(a.y);
        const float c0 = bflo(c2.x), c1 = bfhi(c2.x), c2f = bflo(c2.y), c3 = bfhi(c2.y);
        const float ss = wave_sum(a0 * a0 + a1 * a1 + a2 * a2 + a3 * a3 + c0 * c0 + c1 * c1 + c2f * c2f + c3 * c3);
        const float rs = rsqrtf(ss * (1.f / 384.f) + EPS);
        const float4 g0 = *(const float4*)(gv + lane * 4);
        u32x2 o; o.x = cvtpk(a0 * rs * g0.x, a1 * rs * g0.y); o.y = cvtpk(a2 * rs * g0.z, a3 * rs * g0.w);
        *(u32x2*)(pp + lane * 4) = o;
        if (lane < 32) {
          const float4 g1 = *(const float4*)(gv + 256 + lane * 4);
          u32x2 o2; o2.x = cvtpk(c0 * rs * g1.x, c1 * rs * g1.y); o2.y = cvtpk(c2f * rs * g1.z, c3 * rs * g1.w);
          *(u32x2*)(pp + 256 + lane * 4) = o2;
        }
      }
    }
    __syncthreads();
  }
}

__global__ void __launch_bounds__(NTHR) k_route(const float* __restrict__ logits, const float* __restrict__ rgb, const float* __restrict__ reb, unsigned* __restrict__ list, int* __restrict__ cnt, float* __restrict__ gate) {
  __shared__ unsigned lcnt[32];
  __shared__ unsigned lbase[32];
  const int tid = threadIdx.x;
  for (int u = blockIdx.x; u < T / NTHR; u += gridDim.x) {
    if (tid < 32) lcnt[tid] = 0u;
    __syncthreads();
    const int tok = u * NTHR + tid;
    const float* lg = logits + (size_t)tok * 36;
    float gl[4];
#pragma unroll
    for (int i = 0; i < 4; ++i) gl[i] = lg[i] + rgb[i];
    int gi = 0; float gm = gl[0];
#pragma unroll
    for (int i = 1; i < 4; ++i) if (gl[i] > gm) { gm = gl[i]; gi = i; }
    float gs = 0.f;
#pragma unroll
    for (int i = 0; i < 4; ++i) gs += __expf(gl[i] - gm);
    const float gw = 1.f / gs;
    float e1 = -INFINITY, e2 = -INFINITY; int j1 = 0, j2 = 0;
    for (int j = 0; j < 8; ++j) {
      const float v = lg[4 + gi * 8 + j] + reb[gi * 8 + j];
      if (v > e1) { e2 = e1; j2 = j1; e1 = v; j1 = j; }
      else if (v > e2) { e2 = v; j2 = j; }
    }
    const float p2 = 1.f / (1.f + __expf(e1 - e2)), p1 = 1.f - p2;
    const int ex1 = gi * 8 + j1, ex2 = gi * 8 + j2;
    gate[tok * 2] = gw * p1; gate[tok * 2 + 1] = gw * p2;
    const unsigned pos1 = atomicAdd(&lcnt[ex1], 1u);
    const unsigned pos2 = atomicAdd(&lcnt[ex2], 1u);
    __syncthreads();
    if (tid < 32) lbase[tid] = (unsigned)atomicAdd(&cnt[tid], (int)lcnt[tid]);
    __syncthreads();
    list[(size_t)ex1 * 65536 + lbase[ex1] + pos1] = (unsigned)(tok * 2);
    list[(size_t)ex2 * 65536 + lbase[ex2] + pos2] = (unsigned)(tok * 2 + 1);
    __syncthreads();
  }
}

__global__ void __launch_bounds__(NTHR) k_combine(float* __restrict__ xio, const bf16_t* __restrict__ ys, const float* __restrict__ g2, int final_mode,
                                                  const float* __restrict__ g, const float* __restrict__ mod_sh, const float* __restrict__ mod_sc, bf16_t* __restrict__ h) {
  const int lane = threadIdx.x & 63, wid = threadIdx.x >> 6;
  for (int row = blockIdx.x * 8 + wid; row < T; row += gridDim.x * 8) {
    const int b = row >> 13;
    float* xr = xio + (size_t)row * D;
    const bf16_t* y0 = ys + (size_t)row * 2048;
    float4 v[4]; float ss = 0.f;
#pragma unroll
    for (int i = 0; i < 4; ++i) {
      const int col = i * 256 + lane * 4;
      v[i] = *(const float4*)(xr + col);
      const u32x2 a = *(const u32x2*)(y0 + col), c = *(const u32x2*)(y0 + 1024 + col);
      const float4 gg = *(const float4*)(g2 + (size_t)b * 6144 + col);
      v[i].x += gg.x * (bflo(a.x) + bflo(c.x)); v[i].y += gg.y * (bfhi(a.x) + bfhi(c.x));
      v[i].z += gg.z * (bflo(a.y) + bflo(c.y)); v[i].w += gg.w * (bfhi(a.y) + bfhi(c.y));
      ss += v[i].x * v[i].x + v[i].y * v[i].y + v[i].z * v[i].z + v[i].w * v[i].w;
    }
    ss = wave_sum(ss);
    const float rstd = rsqrtf(ss * (1.f / 1024.f) + EPS);
#pragma unroll
    for (int i = 0; i < 4; ++i) {
      const int col = i * 256 + lane * 4;
      const float4 gg = *(const float4*)(g + col);
      if (final_mode) {
        *(float4*)(xr + col) = make_float4(v[i].x * rstd * gg.x, v[i].y * rstd * gg.y, v[i].z * rstd * gg.z, v[i].w * rstd * gg.w);
      } else {
        *(float4*)(xr + col) = v[i];
        const float4 sc = *(const float4*)(mod_sc + (size_t)b * 6144 + col), sh = *(const float4*)(mod_sh + (size_t)b * 6144 + col);
        u32x2 o;
        o.x = cvtpk(v[i].x * rstd * gg.x * (1.f + sc.x) + sh.x, v[i].y * rstd * gg.y * (1.f + sc.y) + sh.y);
        o.y = cvtpk(v[i].z * rstd * gg.z * (1.f + sc.z) + sh.z, v[i].w * rstd * gg.w * (1.f + sc.w) + sh.w);
        *(u32x2*)(h + (size_t)row * D + col) = o;
      }
    }
  }
}

extern "C" void kernel_launch(void* const* d_in, const int* in_sizes, int n_in, void* d_out, int out_size, void* d_ws, size_t ws_size, hipStream_t stream) {
  if (ws_size < WS_END) return;
  const float* x = (const float*)d_in[0];
  const float* c = (const float*)d_in[1];
  const float* ada_w = (const float*)d_in[2];
  const float* ada_b = (const float*)d_in[3];
  const float* norm1_g = (const float*)d_in[4];
  const float* w_in = (const float*)d_in[5];
  const float* conv_w = (const float*)d_in[6];
  const float* conv_b = (const float*)d_in[7];
  const float* cln_g = (const float*)d_in[8];
  const float* cln_b = (const float*)d_in[9];
  const float* moba_g = (const float*)d_in[10];
  const float* dsa_g = (const float*)d_in[11];
  const float* w_out = (const float*)d_in[12];
  const float* norm2_g = (const float*)d_in[13];
  const float* rgw = (const float*)d_in[14];
  const float* rgb = (const float*)d_in[15];
  const float* rew = (const float*)d_in[16];
  const float* reb = (const float*)d_in[17];
  const float* w1 = (const float*)d_in[18];
  const float* w3 = (const float*)d_in[19];
  const float* w2 = (const float*)d_in[20];
  const float* final_g = (const float*)d_in[21];
  float* out = (float*)d_out;
  char* ws = (char*)d_ws;
  unsigned* ctl = (unsigned*)(ws + WS_CTL);
  float* mod = (float*)(ws + WS_MOD);
  float* kmean = (float*)(ws + WS_KMEAN);
  unsigned* selm = (unsigned*)(ws + WS_SELM);
  float* gate = (float*)(ws + WS_GATE);
  float* logits = (float*)(ws + WS_LOGIT);
  unsigned* list = (unsigned*)(ws + WS_LIST);
  bf16_t* winT = (bf16_t*)(ws + WS_WINT);
  bf16_t* woutT = (bf16_t*)(ws + WS_WOUTT);
  bf16_t* rt = (bf16_t*)(ws + WS_RT);
  bf16_t* w13T = (bf16_t*)(ws + WS_W13T);
  bf16_t* w2T = (bf16_t*)(ws + WS_W2T);
  bf16_t* hb = (bf16_t*)(ws + WS_HB);
  uint2* bmt = (uint2*)(ws + WS_BMT);
  bf16_t* proj = (bf16_t*)(ws + WS_PROJ);
  bf16_t* act = (bf16_t*)(ws + WS_ACT);
  bf16_t* ys = (bf16_t*)(ws + WS_YS);

  static bool attr_done = false;
  if (!attr_done) {
    hipFuncSetAttribute((const void*)k_gemm<GM_INPROJ>, hipFuncAttributeMaxDynamicSharedMemorySize, GEMM_LDS);
    hipFuncSetAttribute((const void*)k_gemm<GM_OUTPROJ>, hipFuncAttributeMaxDynamicSharedMemorySize, GEMM_LDS);
    hipFuncSetAttribute((const void*)k_gemm<GM_ROUTER>, hipFuncAttributeMaxDynamicSharedMemorySize, GEMM_LDS);
    hipFuncSetAttribute((const void*)k_gemm<GM_MOE1>, hipFuncAttributeMaxDynamicSharedMemorySize, GEMM_LDS);
    hipFuncSetAttribute((const void*)k_gemm<GM_MOE2>, hipFuncAttributeMaxDynamicSharedMemorySize, GEMM_LDS);
    hipFuncSetAttribute((const void*)k_select, hipFuncAttributeMaxDynamicSharedMemorySize, SEL_LDS);
    hipFuncSetAttribute((const void*)k_mixfin, hipFuncAttributeMaxDynamicSharedMemorySize, MIX_LDS);
    hipFuncSetAttribute((const void*)k_attn<0>, hipFuncAttributeMaxDynamicSharedMemorySize, ATT_LDS);
    hipFuncSetAttribute((const void*)k_attn<1>, hipFuncAttributeMaxDynamicSharedMemorySize, ATT_LDS);
    attr_done = true;
  }
  hipMemsetAsync(ws + WS_CTL, 0, 4096, stream);
  const int G = 256;
  k_mod<<<192, NTHR, 0, stream>>>(c, ada_w, ada_b, mod);

  for (int l = 0; l < 2; ++l) {
    const float* modl = mod + (size_t)l * 4 * 6144;
    k_prep_w<<<G * 4, NTHR, 0, stream>>>(w_in + (size_t)l * 1024 * NIN, w_out + (size_t)l * 1024 * 1024, w1 + (size_t)l * 32 * 1024 * 512, w3 + (size_t)l * 32 * 1024 * 512,
                                          w2 + (size_t)l * 32 * 512 * 1024, winT, woutT, w13T, w2T);
    k_prep_rt<<<64, NTHR, 0, stream>>>(rgw + (size_t)l * 4096, rew + (size_t)l * 32768, rt);
    if (l == 0) k_rmsmod<<<G * 2, NTHR, 0, stream>>>(x, norm1_g, modl + 0, modl + 1024, hb);
    {
      GemmP P{}; P.A = hb; P.Bt = winT; P.lda = 1024; P.K = 1024; P.Obf = proj; P.ldo = PLD;
      k_gemm<GM_INPROJ><<<G, NTHR, GEMM_LDS, stream>>>(P, T / 256, PLD / 128);
    }
    k_kmean<<<128, NTHR, 0, stream>>>(proj, kmean);
    k_gate<<<G * 2, NTHR, 0, stream>>>(proj, kmean, selm);
    k_select<<<G, NTHR, SEL_LDS, stream>>>(proj, bmt);
    k_attn<0><<<G, NTHR, ATT_LDS, stream>>>(proj, hb, selm, bmt);
    k_attn<1><<<G, NTHR, ATT_LDS, stream>>>(proj, hb, selm, bmt);
    k_mixfin<<<G, NTHR, MIX_LDS, stream>>>(proj, hb, conv_w + (size_t)l * 31 * 256, conv_b + l * 256, cln_g + l * 256, cln_b + l * 256, moba_g + l * 384, dsa_g + l * 384);
    {
      GemmP P{}; P.A = hb; P.Bt = woutT; P.lda = 1024; P.K = 1024; P.xin = (l == 0) ? x : out; P.xout = out; P.gvec = modl + 2048;
      k_gemm<GM_OUTPROJ><<<G, NTHR, GEMM_LDS, stream>>>(P, T / 256, 8);
    }
    k_rmsmod<<<G * 2, NTHR, 0, stream>>>(out, norm2_g + l * 1024, modl + 3072, modl + 4096, hb);
    {
      GemmP P{}; P.A = hb; P.Bt = rt; P.lda = 1024; P.K = 1024; P.logits = logits;
      k_gemm<GM_ROUTER><<<128, NTHR, GEMM_LDS, stream>>>(P, T / 256, 1);
    }
    int* cntl = (int*)(ctl + CW_CNT + l * 32);
    k_route<<<64, NTHR, 0, stream>>>(logits, rgb + l * 4, reb + l * 32, list, cntl, gate);
    {
      GemmP P{}; P.A = hb; P.Bt = w13T; P.lda = 1024; P.K = 1024; P.Obf = act; P.list = list; P.cnt = cntl; P.gate = gate;
      k_gemm<GM_MOE1><<<G, NTHR, GEMM_LDS, stream>>>(P, 0, 0);
    }
    {
      GemmP P{}; P.A = act; P.Bt = w2T; P.lda = 512; P.K = 512; P.Obf = ys; P.list = list; P.cnt = cntl; P.gate = gate;
      k_gemm<GM_MOE2><<<G, NTHR, GEMM_LDS, stream>>>(P, 0, 0);
    }
    if (l == 0) {
      const float* mod1 = mod + (size_t)4 * 6144;
      k_combine<<<G * 2, NTHR, 0, stream>>>(out, ys, modl + 5120, 0, norm1_g + 1024, mod1 + 0, mod1 + 1024, hb);
    } else {
      k_combine<<<G * 2, NTHR, 0, stream>>>(out, ys, modl + 5120, 1, final_g, nullptr, nullptr, nullptr);
    }
  }
}
```

```cpp
#include <hip/hip_runtime.h>
#include <hip/hip_cooperative_groups.h>
namespace cg = cooperative_groups;
#include <stdint.h>

#define DI __device__ __forceinline__
typedef unsigned short bf16_t;
typedef short bf16x8 __attribute__((ext_vector_type(8)));
typedef short s16x4 __attribute__((ext_vector_type(4)));
typedef float f32x4 __attribute__((ext_vector_type(4)));
typedef float f32x16 __attribute__((ext_vector_type(16)));
typedef unsigned u32x4 __attribute__((ext_vector_type(4)));
typedef unsigned u32x2 __attribute__((ext_vector_type(2)));
typedef float f32x2_t __attribute__((ext_vector_type(2)));
typedef __bf16 bf16x2_t __attribute__((ext_vector_type(2)));
#define LAS __attribute__((address_space(3)))

constexpr int NB = 4, S = 8192, T = NB * S, D = 1024;
constexpr int PLD = 3456;
constexpr int C_QM = 0, C_KM = 384, C_VM = 768, C_CA = 1152, C_CG = 1408, C_QD = 1664, C_KD = 2048, C_VD = 2432, C_QI = 2816, C_KI = 3328, C_WI = 3392;
constexpr int NIN = 3400;
constexpr float EPS = 1e-6f;
constexpr int NTHR = 512;

constexpr size_t MiB = 1u << 20;
constexpr size_t WS_CTL = 0;
constexpr size_t WS_MOD = 1 * MiB;
constexpr size_t WS_KMEAN = WS_MOD + 256 * 1024;
constexpr size_t WS_SELM = WS_KMEAN + 256 * 1024;
constexpr size_t WS_GATE = WS_SELM + 1 * MiB;
constexpr size_t WS_LOGIT = WS_GATE + 512 * 1024;
constexpr size_t WS_LIST = WS_LOGIT + 5 * MiB;
constexpr size_t WS_WINT = WS_LIST + 8 * MiB;
constexpr size_t WS_WOUTT = WS_WINT + 7 * MiB;
constexpr size_t WS_RT = WS_WOUTT + 2 * MiB;
constexpr size_t WS_W13T = WS_RT + 1 * MiB;
constexpr size_t WS_W2T = WS_W13T + 64 * MiB;
constexpr size_t WS_HB = WS_W2T + 32 * MiB;
constexpr size_t WS_BMT = WS_HB + 64 * MiB;
constexpr size_t WS_PROJ = WS_BMT + 32 * MiB;
constexpr size_t WS_ACT = WS_PROJ;
constexpr size_t WS_YS = WS_PROJ + 64 * MiB;
constexpr size_t WS_PARTO = WS_PROJ + 216 * MiB;
constexpr size_t WS_PARTML = WS_PARTO + 96 * MiB;
constexpr size_t WS_MLIST = WS_PARTML + 6 * MiB;
constexpr size_t WS_END = WS_MLIST + 24 * MiB;
constexpr int CW_CNT = 0;
constexpr int CW_Q = 64;
constexpr int CW_MC = 5120;

DI int otid() { int t = threadIdx.x; asm volatile("" : "+v"(t)); return t; }
DI void st_wt32(unsigned* p, unsigned v) { __hip_atomic_store(p, v, __ATOMIC_RELAXED, __HIP_MEMORY_SCOPE_AGENT); }
DI void st_wt64(unsigned long long* p, unsigned long long v) { __hip_atomic_store(p, v, __ATOMIC_RELAXED, __HIP_MEMORY_SCOPE_AGENT); }
DI float bf2f(bf16_t b) { return __uint_as_float(((unsigned)b) << 16); }
DI float bflo(unsigned u) { return __uint_as_float(u << 16); }
DI float bfhi(unsigned u) { return __uint_as_float(u & 0xffff0000u); }
DI unsigned cvtpk(float lo, float hi) { f32x2_t v = {lo, hi}; bf16x2_t b = __builtin_convertvector(v, bf16x2_t); return __builtin_bit_cast(unsigned, b); }
DI float fexp2(float x) { return __builtin_amdgcn_exp2f(x); }
DI float frcp(float x) { return __builtin_amdgcn_rcpf(x); }
DI float silu_f(float x) { return x * frcp(1.f + fexp2(x * -1.4426950408889634f)); }
DI float wave_sum(float v) {
#pragma unroll
  for (int o = 32; o >= 1; o >>= 1) v += __shfl_xor(v, o);
  return v;
}
#define DPP_STEP(OPF, v, ident, ctrl, rmask) v = OPF(v, (unsigned)__builtin_amdgcn_update_dpp((int)(ident), (int)(v), ctrl, rmask, 0xf, false))
DI unsigned opadd(unsigned a, unsigned b) { return a + b; }
DI unsigned opmin(unsigned a, unsigned b) { return min(a, b); }
DI unsigned opmax(unsigned a, unsigned b) { return max(a, b); }
DI unsigned scan_add(unsigned v) {
  DPP_STEP(opadd, v, 0u, 0x111, 0xf); DPP_STEP(opadd, v, 0u, 0x112, 0xf); DPP_STEP(opadd, v, 0u, 0x114, 0xf); DPP_STEP(opadd, v, 0u, 0x118, 0xf);
  DPP_STEP(opadd, v, 0u, 0x142, 0xa); DPP_STEP(opadd, v, 0u, 0x143, 0xc); return v;
}
DI unsigned red_add(unsigned v) { return (unsigned)__builtin_amdgcn_readlane((int)scan_add(v), 63); }
DI unsigned red_min(unsigned v) {
  DPP_STEP(opmin, v, 0xffffffffu, 0x111, 0xf); DPP_STEP(opmin, v, 0xffffffffu, 0x112, 0xf); DPP_STEP(opmin, v, 0xffffffffu, 0x114, 0xf); DPP_STEP(opmin, v, 0xffffffffu, 0x118, 0xf);
  DPP_STEP(opmin, v, 0xffffffffu, 0x142, 0xa); DPP_STEP(opmin, v, 0xffffffffu, 0x143, 0xc); return (unsigned)__builtin_amdgcn_readlane((int)v, 63);
}
DI unsigned red_max(unsigned v) {
  DPP_STEP(opmax, v, 0u, 0x111, 0xf); DPP_STEP(opmax, v, 0u, 0x112, 0xf); DPP_STEP(opmax, v, 0u, 0x114, 0xf); DPP_STEP(opmax, v, 0u, 0x118, 0xf);
  DPP_STEP(opmax, v, 0u, 0x142, 0xa); DPP_STEP(opmax, v, 0u, 0x143, 0xc); return (unsigned)__builtin_amdgcn_readlane((int)v, 63);
}
#define MFMA16(a, b, c) __builtin_amdgcn_mfma_f32_16x16x32_bf16((a), (b), (c), 0, 0, 0)
#define MFMA32(a, b, c) __builtin_amdgcn_mfma_f32_32x32x16_bf16((a), (b), (c), 0, 0, 0)

DI void mod_units(char* lds, int ubase, int nblk, const float* __restrict__ c, const float* __restrict__ ada_w, const float* __restrict__ ada_b, float* __restrict__ mod) {
  float (*sc)[1024] = (float (*)[1024])lds;
  float (*red)[4][64] = (float (*)[4][64])(lds + 16384);
  const int tid = otid();
  bool loaded = false;
  for (int u = ubase; u < 2 * 96; u += nblk) {
    if (!loaded) { for (int i = tid; i < 4096; i += NTHR) sc[i >> 10][i & 1023] = silu_f(c[i]); __syncthreads(); loaded = true; }
    const int l = u / 96, n = (u % 96) * 64 + (tid & 63), ks = tid >> 6;
    const float* w = ada_w + (size_t)l * 1024 * 6144 + n;
    float a0 = 0.f, a1 = 0.f, a2 = 0.f, a3 = 0.f;
#pragma unroll 8
    for (int k = ks * 128; k < ks * 128 + 128; ++k) {
      const float wv = w[(size_t)k * 6144];
      a0 += sc[0][k] * wv; a1 += sc[1][k] * wv; a2 += sc[2][k] * wv; a3 += sc[3][k] * wv;
    }
    red[ks][0][tid & 63] = a0; red[ks][1][tid & 63] = a1; red[ks][2][tid & 63] = a2; red[ks][3][tid & 63] = a3;
    __syncthreads();
    if (tid < 256) {
      const int b = tid >> 6, nn = tid & 63;
      float s = 0.f;
#pragma unroll
      for (int k = 0; k < 8; ++k) s += red[k][b][nn];
      const int ncol = (u % 96) * 64 + nn;
      mod[((size_t)l * 4 + b) * 6144 + ncol] = s + ada_b[(size_t)l * 6144 + ncol];
    }
    __syncthreads();
  }
}

struct TJob { const float* src; bf16_t* dst; int R, C, Cpad, grp, stride, off; };

DI void transpose_tile_wave(const TJob& J, int tr, int tc, float (*tile)[65], int lane) {
#pragma unroll 1
  for (int hf = 0; hf < 2; ++hf) {
    float4 v[8];
#pragma unroll
    for (int p = 0; p < 8; ++p) {
      const int r = (lane >> 4) + (hf * 8 + p) * 4, c4 = (lane & 15) * 4;
      const int gr = tr * 64 + r, gc = tc * 64 + c4;
      v[p] = make_float4(0.f, 0.f, 0.f, 0.f);
      if (gc + 3 < J.C) v[p] = *(const float4*)(J.src + (size_t)gr * J.C + gc);
      else { float t4[4] = {0.f, 0.f, 0.f, 0.f}; for (int q = 0; q < 4; ++q) if (gc + q < J.C) t4[q] = J.src[(size_t)gr * J.C + gc + q]; v[p] = make_float4(t4[0], t4[1], t4[2], t4[3]); }
    }
#pragma unroll
    for (int p = 0; p < 8; ++p) {
      const int r = (lane >> 4) + (hf * 8 + p) * 4, c4 = (lane & 15) * 4;
      tile[r][c4 + 0] = v[p].x; tile[r][c4 + 1] = v[p].y; tile[r][c4 + 2] = v[p].z; tile[r][c4 + 3] = v[p].w;
    }
  }
  __builtin_amdgcn_fence(__ATOMIC_RELEASE, "wavefront");
  __builtin_amdgcn_wave_barrier();
#pragma unroll
  for (int p = 0; p < 8; ++p) {
    const int n = (lane >> 3) + p * 8, kc = lane & 7;
    const int gc = tc * 64 + n;
    if (gc < J.Cpad) {
      const int drow = (gc / J.grp) * J.stride + J.off + (gc % J.grp);
      u32x4 o;
      o.x = cvtpk(tile[kc * 8 + 0][n], tile[kc * 8 + 1][n]); o.y = cvtpk(tile[kc * 8 + 2][n], tile[kc * 8 + 3][n]);
      o.z = cvtpk(tile[kc * 8 + 4][n], tile[kc * 8 + 5][n]); o.w = cvtpk(tile[kc * 8 + 6][n], tile[kc * 8 + 7][n]);
      *(u32x4*)(J.dst + (size_t)drow * J.R + tr * 64 + kc * 8) = o;
    }
  }
  __builtin_amdgcn_fence(__ATOMIC_RELEASE, "wavefront");
  __builtin_amdgcn_wave_barrier();
}

constexpr int WINT_ROWS = 3584;
constexpr int PREP_UNITS = 896 + 256 + 32 * 384;
DI void prep_unit(int u, const float* w_in, const float* w_out, const float* w1, const float* w3, const float* w2,
                  bf16_t* winT, bf16_t* woutT, bf16_t* w13T, bf16_t* w2T, float (*tile)[65], int lane) {
  TJob J; int tr, tc;
  if (u < 896) { J = TJob{w_in, winT, 1024, NIN, WINT_ROWS, 1 << 30, 0, 0}; tr = u % 16; tc = u / 16; }
  else if (u < 1152) { u -= 896; J = TJob{w_out, woutT, 1024, 1024, 1024, 1 << 30, 0, 0}; tr = u % 16; tc = u / 16; }
  else {
    u -= 1152; const int e = u / 384; int r = u % 384;
    if (r < 128) { J = TJob{w1 + (size_t)e * 1024 * 512, w13T + (size_t)e * 1024 * 1024, 1024, 512, 512, 32, 64, 0}; tr = r % 16; tc = r / 16; }
    else if (r < 256) { r -= 128; J = TJob{w3 + (size_t)e * 1024 * 512, w13T + (size_t)e * 1024 * 1024, 1024, 512, 512, 32, 64, 32}; tr = r % 16; tc = r / 16; }
    else { r -= 256; J = TJob{w2 + (size_t)e * 512 * 1024, w2T + (size_t)e * 1024 * 512, 512, 1024, 1024, 1 << 30, 0, 0}; tr = r % 8; tc = r / 8; }
  }
  transpose_tile_wave(J, tr, tc, tile, lane);
}

DI void prep_rt_unit(int u, const float* __restrict__ rgw, const float* __restrict__ rew, bf16_t* __restrict__ rt) {
#pragma unroll
  for (int q = 0; q < 4; ++q) {
    const int i = u * 2048 + q * NTHR + threadIdx.x;
    const int n = i >> 10, k = i & 1023;
    float v = 0.f;
    if (n < 4) v = rgw[k * 4 + n]; else if (n < 36) v = rew[k * 32 + (n - 4)];
    rt[i] = (bf16_t)(cvtpk(v, 0.f) & 0xffffu);
  }
}
constexpr int PREP_SMALL = 896 + 256;
constexpr int PREP_EXP_ITEMS = (32 * 384) / 8;
DI void prep_small_units(char* lds, int ubase, int nblk, const float* w_in, const float* w_out, const float* rgw, const float* rew, bf16_t* winT, bf16_t* woutT, bf16_t* rt) {
  const int tid = otid(), lane = tid & 63, wid = __builtin_amdgcn_readfirstlane(tid >> 6);
  float (*tile)[65] = (float (*)[65])(lds + wid * 16640);
  for (int u = ubase * 8 + wid; u < PREP_SMALL; u += nblk * 8) prep_unit(u, w_in, w_out, nullptr, nullptr, nullptr, winT, woutT, nullptr, nullptr, tile, lane);
  for (int u = ubase; u < 64; u += nblk) prep_rt_unit(u, rgw, rew, rt);
  __syncthreads();
}
DI void prep_exp_item(char* lds, int item, const float* w1, const float* w3, const float* w2, bf16_t* w13T, bf16_t* w2T) {
  const int tid = otid(), lane = tid & 63, wid = __builtin_amdgcn_readfirstlane(tid >> 6);
  float (*tile)[65] = (float (*)[65])(lds + wid * 16640);
  prep_unit(PREP_SMALL + item * 8 + wid, nullptr, nullptr, w1, w3, w2, nullptr, nullptr, w13T, w2T, tile, lane);
  __syncthreads();
}

DI void wave_sum4(float (&v)[4]) {
#pragma unroll
  for (int o = 32; o >= 1; o >>= 1) {
    float t[4];
#pragma unroll
    for (int r = 0; r < 4; ++r) t[r] = __shfl_xor(v[r], o);
#pragma unroll
    for (int r = 0; r < 4; ++r) v[r] += t[r];
  }
}
DI void rmsmod_phase(const float* __restrict__ x, const float* __restrict__ g, const float* __restrict__ mod_sh, const float* __restrict__ mod_sc, bf16_t* __restrict__ h) {
  const int tid_ = otid(); const int lane = tid_ & 63, wid = __builtin_amdgcn_readfirstlane(tid_ >> 6);
  for (int row0 = (blockIdx.x * 8 + wid) * 4; row0 < T; row0 += gridDim.x * 32) {
    const int b = row0 >> 13;
    float4 v[4][4]; float ss[4];
#pragma unroll
    for (int r = 0; r < 4; ++r) {
      const float* xr = x + (size_t)(row0 + r) * D;
      ss[r] = 0.f;
#pragma unroll
      for (int i = 0; i < 4; ++i) { v[r][i] = *(const float4*)(xr + i * 256 + lane * 4); }
    }
#pragma unroll
    for (int r = 0; r < 4; ++r)
#pragma unroll
      for (int i = 0; i < 4; ++i) ss[r] += v[r][i].x * v[r][i].x + v[r][i].y * v[r][i].y + v[r][i].z * v[r][i].z + v[r][i].w * v[r][i].w;
    wave_sum4(ss);
#pragma unroll
    for (int i = 0; i < 4; ++i) {
      const int col = i * 256 + lane * 4;
      const float4 gg = *(const float4*)(g + col), sc = *(const float4*)(mod_sc + (size_t)b * 6144 + col), sh = *(const float4*)(mod_sh + (size_t)b * 6144 + col);
#pragma unroll
      for (int r = 0; r < 4; ++r) {
        const float rstd = rsqrtf(ss[r] * (1.f / 1024.f) + EPS);
        const float o0 = v[r][i].x * rstd * gg.x * (1.f + sc.x) + sh.x, o1 = v[r][i].y * rstd * gg.y * (1.f + sc.y) + sh.y;
        const float o2 = v[r][i].z * rstd * gg.z * (1.f + sc.z) + sh.z, o3 = v[r][i].w * rstd * gg.w * (1.f + sc.w) + sh.w;
        u32x2 o; o.x = cvtpk(o0, o1); o.y = cvtpk(o2, o3);
        *(u32x2*)(h + (size_t)(row0 + r) * D + col) = o;
      }
    }
  }
}

enum { GM_INPROJ = 0, GM_OUTPROJ = 1, GM_ROUTER = 2, GM_MOE1 = 3, GM_MOE2 = 4 };
struct GemmP {
  const bf16_t* A; const bf16_t* Bt; int lda; int K;
  bf16_t* Obf; int ldo;
  const float* xin; float* xout; const float* gvec;
  float* logits;
  const unsigned* list; const int* cnt; const float* gate;
};
constexpr int GEMM_LDS = 98304 + 1024;

template <int MODE, int NJ, int VAR = 0>
DI void gemm_tile(char* lds, const GemmP& P, const bf16_t* __restrict__ Bt, int m0, int n0, int nvalid, const unsigned* lst, int ebase) {
  constexpr int BN = 32 * NJ, STG = 32768 + BN * 128, NBP = BN / 64;
  const int tid = otid(), lane = tid & 63, wid = __builtin_amdgcn_readfirstlane(tid >> 6), fr = lane & 15, fq = lane >> 4;
  const int wm = wid >> 1, wn = wid & 1;
  const int K = P.K;
  int* ridx = (int*)(lds + 2 * STG);
  if (MODE == GM_MOE1) {
    if (tid < 256) { const int r = tid < nvalid ? tid : 0; ridx[tid] = (int)(lst[r] >> 1); }
    __syncthreads();
  }
  const int prow = lane >> 3, pkc = (lane & 7) ^ (lane >> 3);
  const bf16_t* ap[4];
#pragma unroll
  for (int i = 0; i < 4; ++i) {
    const int row = 8 * (wid + 8 * i) + prow;
    size_t grow;
    if (MODE == GM_MOE1) grow = (size_t)ridx[row];
    else if (MODE == GM_MOE2) grow = (size_t)(ebase + (row < nvalid ? row : 0));
    else grow = (size_t)(m0 + row);
    ap[i] = P.A + grow * P.lda + pkc * 8;
  }
  const bf16_t* bp[NBP];
#pragma unroll
  for (int i = 0; i < NBP; ++i) {
    const int row = 8 * (wid + 8 * i) + prow;
    bp[i] = Bt + (size_t)(n0 + row) * K + pkc * 8;
  }
  f32x4 acc[4][NJ];
#pragma unroll
  for (int i = 0; i < 4; ++i)
#pragma unroll
    for (int j = 0; j < NJ; ++j) acc[i][j] = (f32x4){0.f, 0.f, 0.f, 0.f};
  LAS char* lds3 = (LAS char*)lds;
#define GEMM_STAGE(st, kt_) do { \
    _Pragma("unroll") for (int i = 0; i < 4; ++i) __builtin_amdgcn_global_load_lds((const unsigned*)(ap[i] + (kt_) * 64), (LAS unsigned*)(lds3 + (st) * STG + (wid + 8 * i) * 1024), 16, 0, 0); \
    _Pragma("unroll") for (int i = 0; i < NBP; ++i) __builtin_amdgcn_global_load_lds((const unsigned*)(bp[i] + (kt_) * 64), (LAS unsigned*)(lds3 + (st) * STG + 32768 + (wid + 8 * i) * 1024), 16, 0, 0); \
  } while (0)
#define GEMM_PIECE(st, kt_, q) do { \
    if ((q) < 4) __builtin_amdgcn_global_load_lds((const unsigned*)(ap[(q)] + (kt_) * 64), (LAS unsigned*)(lds3 + (st) * STG + (wid + 8 * (q)) * 1024), 16, 0, 0); \
    else if ((q) - 4 < NBP) __builtin_amdgcn_global_load_lds((const unsigned*)(bp[((q) - 4) < NBP ? (q) - 4 : 0] + (kt_) * 64), (LAS unsigned*)(lds3 + (st) * STG + 32768 + (wid + 8 * ((q) - 4)) * 1024), 16, 0, 0); \
  } while (0)
#define GEMM_LDA(i, base, ko) a[i] = *(const bf16x8*)((base) + (arow + (i) * 16) * 128 + (ko))
#define GEMM_LDB(j, base, ko) b[j] = *(const bf16x8*)((base) + 32768 + (brow + (j) * 16) * 128 + (ko))
#define GEMM_SB __builtin_amdgcn_sched_barrier(0)
#define GEMM_BLOCK(RL, DM, base, ko, st, kt_) do { \
    _Pragma("unroll") for (int j = 0; j < NJ; ++j) acc[0][j] = MFMA16(b[j], a[0], acc[0][j]); \
    if (RL) GEMM_LDA(0, base, ko); \
    if (DM) { GEMM_PIECE(st, kt_, 0); GEMM_PIECE(st, kt_, 1); } \
    GEMM_SB; \
    _Pragma("unroll") for (int j = 0; j < NJ; ++j) acc[1][j] = MFMA16(b[j], a[1], acc[1][j]); \
    if (RL) GEMM_LDA(1, base, ko); \
    if (DM) { GEMM_PIECE(st, kt_, 2); GEMM_PIECE(st, kt_, 3); } \
    GEMM_SB; \
    _Pragma("unroll") for (int j = 0; j < NJ; ++j) { \
      acc[2][j] = MFMA16(b[j], a[2], acc[2][j]); \
      acc[3][j] = MFMA16(b[j], a[3], acc[3][j]); \
      if (RL) GEMM_LDB(j, base, ko); \
      if (DM && (j & 1) == 0) GEMM_PIECE(st, kt_, 4 + (j >> 1)); \
      GEMM_SB; \
    } \
    if (RL) { GEMM_LDA(2, base, ko); GEMM_LDA(3, base, ko); } \
    GEMM_SB; \
  } while (0)
  const int nk = K >> 6;
  const int arow = wm * 64 + fr, brow = wn * (BN / 2) + fr, sw = fr & 7;
  const int ko0 = (fq ^ sw) << 4, ko1 = ((4 + fq) ^ sw) << 4;
  bf16x8 a[4], b[NJ];
  GEMM_STAGE(0, 0);
  asm volatile("s_waitcnt vmcnt(0)" ::: "memory");
  __syncthreads();
  if (VAR != 1) GEMM_STAGE(1, 1);
#pragma unroll
  for (int i = 0; i < 4; ++i) GEMM_LDA(i, lds, ko0);
#pragma unroll
  for (int j = 0; j < NJ; ++j) GEMM_LDB(j, lds, ko0);
  for (int kt = 0; kt < nk; ++kt) {
    const int cur = kt & 1;
    const char* sb = lds + cur * STG;
    const char* sn = lds + (cur ^ 1) * STG;
    GEMM_BLOCK(true, false, sb, ko1, 0, 0);
    asm volatile("s_waitcnt vmcnt(0) lgkmcnt(0)" ::: "memory");
    __syncthreads();
    const int kn = min(kt + 2, nk - 1);
    GEMM_BLOCK(true, VAR != 1, sn, ko0, cur, kn);
  }
  asm volatile("s_waitcnt vmcnt(0)" ::: "memory");
#undef GEMM_BLOCK
#undef GEMM_SB
#undef GEMM_LDA
#undef GEMM_LDB
#undef GEMM_PIECE
#undef GEMM_STAGE
  const int nw0 = n0 + wn * (BN / 2);
#pragma unroll
  for (int i = 0; i < 4; ++i) {
    const int ml = wm * 64 + i * 16 + fr;
    const int m = m0 + ml;
    if (MODE == GM_INPROJ) {
#pragma unroll
      for (int j = 0; j < NJ; ++j) {
        const int n = nw0 + j * 16 + fq * 4;
        if (n < P.ldo) {
          u32x2 o; o.x = cvtpk(acc[i][j][0], acc[i][j][1]); o.y = cvtpk(acc[i][j][2], acc[i][j][3]);
          *(u32x2*)(P.Obf + (size_t)m * P.ldo + n) = o;
        }
      }
    } else if (MODE == GM_OUTPROJ) {
      const int b = m >> 13;
#pragma unroll
      for (int j = 0; j < NJ; ++j) {
        const int n = nw0 + j * 16 + fq * 4;
        const float4 xi = *(const float4*)(P.xin + (size_t)m * D + n);
        const float4 gv = *(const float4*)(P.gvec + (size_t)b * 6144 + n);
        float4 o; o.x = xi.x + gv.x * acc[i][j][0]; o.y = xi.y + gv.y * acc[i][j][1]; o.z = xi.z + gv.z * acc[i][j][2]; o.w = xi.w + gv.w * acc[i][j][3];
        *(float4*)(P.xout + (size_t)m * D + n) = o;
      }
    } else if (MODE == GM_ROUTER) {
#pragma unroll
      for (int j = 0; j < NJ; ++j) {
        const int n = nw0 + j * 16 + fq * 4;
        if (n < 36) { float4 o; o.x = acc[i][j][0]; o.y = acc[i][j][1]; o.z = acc[i][j][2]; o.w = acc[i][j][3]; *(float4*)(P.logits + (size_t)m * 36 + n) = o; }
      }
    } else if (MODE == GM_MOE1) {
      if (ml < nvalid) {
#pragma unroll
        for (int jb2 = 0; jb2 < NJ / 4; ++jb2) {
          const int jb = (nw0 >> 6) + jb2;
#pragma unroll
          for (int j = 0; j < 2; ++j) {
            const int col = jb * 32 + j * 16 + fq * 4;
            float v[4];
#pragma unroll
            for (int q = 0; q < 4; ++q) v[q] = silu_f(acc[i][4 * jb2 + j][q]) * acc[i][4 * jb2 + j + 2][q];
            u32x2 o; o.x = cvtpk(v[0], v[1]); o.y = cvtpk(v[2], v[3]);
            *(u32x2*)(P.Obf + (size_t)(ebase + ml) * 512 + col) = o;
          }
        }
      }
    } else if (MODE == GM_MOE2) {
      if (ml < nvalid) {
        const unsigned slot = lst[ml];
        const float gt = P.gate[slot];
#pragma unroll
        for (int j = 0; j < NJ; ++j) {
          const int n = nw0 + j * 16 + fq * 4;
          u32x2 o; o.x = cvtpk(acc[i][j][0] * gt, acc[i][j][1] * gt); o.y = cvtpk(acc[i][j][2] * gt, acc[i][j][3] * gt);
          *(u32x2*)(P.Obf + (size_t)slot * 1024 + n) = o;
        }
      }
    }
  }
  __syncthreads();
}

template <int MODE, int NJ, int VAR = 0>
DI void gemm_phase(char* lds, const GemmP& P, int ntm, int ntn) {
  constexpr int BN = 32 * NJ;
  const int xcd = blockIdx.x & 7, bi = blockIdx.x >> 3, nbx = gridDim.x >> 3;
  const bool xo = (gridDim.x & 7) == 0;
  if (MODE == GM_MOE1 || MODE == GM_MOE2) {
    constexpr int NNT = 1024 / BN;
    if (xo) {
      int ce[4], tm[4], eb[4];
      {
        int acc_ = 0, q = 0;
#pragma unroll
        for (int k = 0; k < 4; ++k) {
          const int e = xcd + 8 * k;
          for (; q < e; ++q) acc_ += P.cnt[q];
          eb[k] = acc_; ce[k] = P.cnt[e]; tm[k] = (ce[k] + 255) >> 8;
        }
      }
      const int total = (tm[0] + tm[1] + tm[2] + tm[3]) * NNT;
      const int nfull = (total / nbx) * nbx;
      const int nhalf = (NJ == 8) ? 2 * (total - nfull) : 0;
      for (int it = bi; it < nfull + ((NJ == 8) ? nhalf : total - nfull); it += nbx) {
        const bool half = (NJ == 8) && it >= nfull;
        const int j = half ? nfull + ((it - nfull) >> 1) : it;
        int k = 0, r = j;
        if (r >= tm[0] * NNT) { r -= tm[0] * NNT; k = 1; if (r >= tm[1] * NNT) { r -= tm[1] * NNT; k = 2; if (r >= tm[2] * NNT) { r -= tm[2] * NNT; k = 3; } } }
        const int cek = k == 0 ? ce[0] : k == 1 ? ce[1] : k == 2 ? ce[2] : ce[3];
        const int ebk = k == 0 ? eb[0] : k == 1 ? eb[1] : k == 2 ? eb[2] : eb[3];
        const int e = xcd + 8 * k, mt = r / NNT, nt = r % NNT;
        const int nvalid = min(256, cek - mt * 256);
        const unsigned* lst = P.list + (size_t)e * 65536 + mt * 256;
        const bf16_t* Bt = P.Bt + (size_t)e * 1024 * P.K;
        if (half) gemm_tile<MODE, (NJ == 8) ? 4 : NJ, VAR>(lds, P, Bt, mt * 256, nt * BN + ((it - nfull) & 1) * (BN / 2), nvalid, lst, ebk + mt * 256);
        else gemm_tile<MODE, NJ, VAR>(lds, P, Bt, mt * 256, nt * BN, nvalid, lst, ebk + mt * 256);
      }
    } else {
      int total_mt = 0;
      for (int e = 0; e < 32; ++e) total_mt += (P.cnt[e] + 255) >> 8;
      const int total = total_mt * NNT;
      for (int u = blockIdx.x; u < total; u += gridDim.x) {
        int e = 0, rem = u, ebase = 0;
        for (;;) { const int c = P.cnt[e]; const int te = ((c + 255) >> 8) * NNT; if (rem < te) break; rem -= te; ebase += c; ++e; }
        const int ce = P.cnt[e], tme = (ce + 255) >> 8;
        const int nt = rem / tme, mt = rem % tme;
        const int nvalid = min(256, ce - mt * 256);
        const unsigned* lst = P.list + (size_t)e * 65536 + mt * 256;
        const bf16_t* Bt = P.Bt + (size_t)e * 1024 * P.K;
        gemm_tile<MODE, NJ, VAR>(lds, P, Bt, mt * 256, nt * BN, nvalid, lst, ebase + mt * 256);
      }
    }
  } else if (xo && (ntm & 7) == 0) {
    const int per = (ntm >> 3) * ntn;
    for (int j = bi; j < per; j += nbx) {
      const int mt = xcd + 8 * (j / ntn), nt = j % ntn;
      gemm_tile<MODE, NJ, VAR>(lds, P, P.Bt, mt * 256, nt * BN, 256, nullptr, 0);
    }
  } else {
    const int total = ntm * ntn;
    for (int u = blockIdx.x; u < total; u += gridDim.x) {
      const int nt = u / ntm, mt = u % ntm;
      gemm_tile<MODE, NJ, VAR>(lds, P, P.Bt, mt * 256, nt * BN, 256, nullptr, 0);
    }
  }
}

DI void kmean_unit(char* lds, int u, const bf16_t* __restrict__ proj, float* __restrict__ kmean) {
  float* red = (float*)lds;
  const int tid = otid();
  const int b = u >> 5, blk = u & 31;
  const int cc = tid % 48, rg = tid / 48;
  if (rg < 10) {
    const bf16_t* p = proj + (size_t)(b * S + blk * 256) * PLD + C_KM + cc * 8;
    float acc[8] = {0.f, 0.f, 0.f, 0.f, 0.f, 0.f, 0.f, 0.f};
#pragma unroll 13
    for (int r = rg; r < 256; r += 10) {
      const u32x4 v = *(const u32x4*)(p + (size_t)r * PLD);
      acc[0] += bflo(v.x); acc[1] += bfhi(v.x); acc[2] += bflo(v.y); acc[3] += bfhi(v.y);
      acc[4] += bflo(v.z); acc[5] += bfhi(v.z); acc[6] += bflo(v.w); acc[7] += bfhi(v.w);
    }
#pragma unroll
    for (int q = 0; q < 8; ++q) red[rg * 384 + cc * 8 + q] = acc[q];
  }
  __syncthreads();
  if (tid < 384) {
    float sm = 0.f;
#pragma unroll
    for (int g = 0; g < 10; ++g) sm += red[g * 384 + tid];
    kmean[((size_t)(b * 6 + tid / 64) * 32 + blk) * 64 + (tid & 63)] = sm * (1.f / 256.f);
  }
  __syncthreads();
}

constexpr int ATT_LDS = 32768;
constexpr float C2 = 0.125f * 1.4426950408889634f;
DI float max3f(float a, float b, float c) { return __builtin_fmaxf(__builtin_fmaxf(a, b), c); }
DI int crow(int r, int hi) { return (r & 3) + 8 * (r >> 2) + 4 * hi; }
typedef short v4i16_t __attribute__((ext_vector_type(4)));
DI s16x4 vtr(const LAS char* p) { return __builtin_bit_cast(s16x4, __builtin_amdgcn_ds_read_tr16_b64_v4i16((LAS v4i16_t*)p)); }

constexpr int ATT_ST = 65536;
struct AttState { float m, l; f32x16 o0, o1; };

template <int MODE>
DI void attn_stage(char* lds, int bufoff, const bf16_t* __restrict__ proj, int b, int h, int key0, int lane, int wid) {
  constexpr int KC = (MODE == 1) ? C_KD : C_KM, VC = (MODE == 1) ? C_VD : C_VM;
  LAS char* l3 = (LAS char*)lds + bufoff;
  const bf16_t* ks = proj + (size_t)(b * S + key0 + 8 * wid + (lane >> 3)) * PLD + KC + h * 64 + (((lane & 7) ^ (lane >> 3)) << 3);
  const bf16_t* vs = proj + (size_t)(b * S + key0 + 16 * (wid & 3) + (lane >> 2)) * PLD + VC + h * 64 + (wid >> 2) * 32 + ((lane & 3) << 3);
#pragma unroll
  for (int tt = 0; tt < 4; ++tt) {
    __builtin_amdgcn_global_load_lds((const unsigned*)(ks + (size_t)tt * 64 * PLD), (LAS unsigned*)(l3 + tt * 16384 + wid * 1024), 16, 0, 0);
    __builtin_amdgcn_global_load_lds((const unsigned*)(vs + (size_t)tt * 64 * PLD), (LAS unsigned*)(l3 + tt * 16384 + 8192 + (wid >> 2) * 4096 + (wid & 3) * 1024), 16, 0, 0);
  }
}

template <int MODE>
DI void attn_tile(char* lds, int tbuf, const bf16x8 (&qr)[4], AttState& st, uint2 w, int ktl, int qrel, int r32, int hi, int lane) {
  constexpr float THR = 8.f;
  const float NEGBIG = -3.0e38f;
  const char* kb = lds + tbuf;
  const int ksw = r32 & 7;
  f32x16 p0, p1;
  {
    f32x16 zz;
#pragma unroll
    for (int r = 0; r < 16; ++r) zz[r] = 0.f;
    const unsigned nmb = cvtpk(-st.m, 0.f);
    const bf16x8 kone = __builtin_bit_cast(bf16x8, (u32x4){hi ? 0u : 0x3F80u, 0u, 0u, 0u});
    const bf16x8 qm = __builtin_bit_cast(bf16x8, (u32x4){nmb, 0u, 0u, 0u});
    p0 = MFMA32(kone, qm, zz);
    p1 = MFMA32(kone, qm, zz);
  }
#pragma unroll
  for (int d0 = 0; d0 < 4; ++d0) {
    const int co = ((2 * d0 + hi) ^ ksw) << 4;
    const bf16x8 ka = *(const bf16x8*)(kb + r32 * 128 + co);
    const bf16x8 kc = *(const bf16x8*)(kb + (r32 + 32) * 128 + co);
    p0 = MFMA32(ka, qr[d0], p0);
    p1 = MFMA32(kc, qr[d0], p1);
  }
  if (MODE == 0) {
    const int kbase = ktl * 64 + 4 * hi;
#pragma unroll
    for (int r = 0; r < 16; ++r) {
      const int kv = kbase + (r & 3) + 8 * (r >> 2);
      if (kv > qrel) p0[r] = NEGBIG;
      if (kv + 32 > qrel) p1[r] = NEGBIG;
    }
  }
  float mxa = max3f(p0[0], p0[1], p1[0]), mxb = max3f(p0[2], p0[3], p1[1]);
  mxa = max3f(mxa, p1[2], p1[3]);
#pragma unroll
  for (int r = 4; r < 16; r += 4) { mxa = max3f(mxa, p0[r], p0[r + 1]); mxb = max3f(mxb, p0[r + 2], p0[r + 3]); mxa = max3f(mxa, p1[r], p1[r + 1]); mxb = max3f(mxb, p1[r + 2], p1[r + 3]); }
  float mx = fmaxf(mxa, mxb);
  mx = fmaxf(mx, __shfl_xor(mx, 32));
  if (__any(mx > THR)) {
    asm volatile("; rescale (rare)" ::: "memory");
    const float d0_ = (mx > THR) ? mx : 0.f;
    const float mnew = __uint_as_float(cvtpk(st.m + d0_, 0.f) << 16);
    const float d = mnew - st.m;
    st.m = mnew;
    const float alpha = fexp2(-d);
#pragma unroll
    for (int r = 0; r < 16; ++r) { st.o0[r] *= alpha; st.o1[r] *= alpha; p0[r] -= d; p1[r] -= d; }
    st.l *= alpha;
  }
#pragma unroll
  for (int r = 0; r < 16; ++r) { p0[r] = fexp2(p0[r]); p1[r] = fexp2(p1[r]); }
  if (MODE == 1) {
    const unsigned w0 = w.x >> (4 * hi), w1 = w.y >> (4 * hi);
#define DSA_MASK1(R, POS) { int k0_, k1_; asm("v_bfe_i32 %0, %1, " #POS ", 1" : "=v"(k0_) : "v"(w0)); asm("v_bfe_i32 %0, %1, " #POS ", 1" : "=v"(k1_) : "v"(w1)); \
      p0[R] = __uint_as_float(__float_as_uint(p0[R]) & (unsigned)k0_); p1[R] = __uint_as_float(__float_as_uint(p1[R]) & (unsigned)k1_); }
    DSA_MASK1(0, 0) DSA_MASK1(1, 1) DSA_MASK1(2, 2) DSA_MASK1(3, 3) DSA_MASK1(4, 8) DSA_MASK1(5, 9) DSA_MASK1(6, 10) DSA_MASK1(7, 11)
    DSA_MASK1(8, 16) DSA_MASK1(9, 17) DSA_MASK1(10, 18) DSA_MASK1(11, 19) DSA_MASK1(12, 24) DSA_MASK1(13, 25) DSA_MASK1(14, 26) DSA_MASK1(15, 27)
#undef DSA_MASK1
  }
  {
    typedef float f32x2 __attribute__((ext_vector_type(2)));
    f32x2 t[8];
#pragma unroll
    for (int k = 0; k < 8; ++k) t[k] = (f32x2){p0[2 * k], p0[2 * k + 1]} + (f32x2){p1[2 * k], p1[2 * k + 1]};
#pragma unroll
    for (int k = 0; k < 4; ++k) t[k] += t[k + 4];
    t[0] += t[2]; t[1] += t[3];
    t[0] += t[1];
    st.l += t[0].x + t[0].y;
  }
  bf16x8 pa[4];
#pragma unroll
  for (int ks = 0; ks < 2; ++ks) {
    u32x4 a, c;
    a.x = cvtpk(p0[8 * ks + 0], p0[8 * ks + 1]); a.y = cvtpk(p0[8 * ks + 2], p0[8 * ks + 3]); a.z = cvtpk(p0[8 * ks + 4], p0[8 * ks + 5]); a.w = cvtpk(p0[8 * ks + 6], p0[8 * ks + 7]);
    c.x = cvtpk(p1[8 * ks + 0], p1[8 * ks + 1]); c.y = cvtpk(p1[8 * ks + 2], p1[8 * ks + 3]); c.z = cvtpk(p1[8 * ks + 4], p1[8 * ks + 5]); c.w = cvtpk(p1[8 * ks + 6], p1[8 * ks + 7]);
    pa[ks] = __builtin_bit_cast(bf16x8, a); pa[ks + 2] = __builtin_bit_cast(bf16x8, c);
  }
  const LAS char* vb = (const LAS char*)lds + tbuf + 8192 + (4 * hi + ((lane & 15) >> 2)) * 64 + ((lane >> 4) & 1) * 32 + (lane & 3) * 8;
#pragma unroll
  for (int ks = 0; ks < 4; ++ks) {
    const s16x4 l0 = vtr(vb + ks * 1024), h0 = vtr(vb + ks * 1024 + 512);
    const s16x4 l1 = vtr(vb + 4096 + ks * 1024), h1 = vtr(vb + 4096 + ks * 1024 + 512);
    const bf16x8 f0 = (bf16x8){l0[0], l0[1], l0[2], l0[3], h0[0], h0[1], h0[2], h0[3]};
    const bf16x8 f1 = (bf16x8){l1[0], l1[1], l1[2], l1[3], h1[0], h1[1], h1[2], h1[3]};
    st.o0 = MFMA32(f0, pa[ks], st.o0);
    st.o1 = MFMA32(f1, pa[ks], st.o1);
  }
}

DI void attn_load_q(const bf16_t* __restrict__ qp, bf16x8 (&qr)[4]) {
#pragma unroll
  for (int d0 = 0; d0 < 4; ++d0) {
    const u32x4 v = *(const u32x4*)(qp + d0 * 16);
    u32x4 o;
    o.x = cvtpk(bflo(v.x) * C2, bfhi(v.x) * C2); o.y = cvtpk(bflo(v.y) * C2, bfhi(v.y) * C2);
    o.z = cvtpk(bflo(v.z) * C2, bfhi(v.z) * C2); o.w = cvtpk(bflo(v.w) * C2, bfhi(v.w) * C2);
    qr[d0] = __builtin_bit_cast(bf16x8, o);
  }
}
DI void attn_store(bf16_t* op, const AttState& st, float inv) {
#pragma unroll
  for (int g = 0; g < 4; ++g) {
    u32x2 a, c;
    a.x = cvtpk(st.o0[4 * g + 0] * inv, st.o0[4 * g + 1] * inv); a.y = cvtpk(st.o0[4 * g + 2] * inv, st.o0[4 * g + 3] * inv);
    c.x = cvtpk(st.o1[4 * g + 0] * inv, st.o1[4 * g + 1] * inv); c.y = cvtpk(st.o1[4 * g + 2] * inv, st.o1[4 * g + 3] * inv);
    *(u32x2*)(op + 8 * g) = a;
    *(u32x2*)(op + 32 + 8 * g) = c;
  }
}

DI void attn_dsa_unit(char* lds, const bf16_t* __restrict__ proj, bf16_t* __restrict__ mix, const uint2* __restrict__ bmt, int b, int h, int qb) {
  const int tid = otid(), lane = tid & 63, wid = __builtin_amdgcn_readfirstlane(tid >> 6), r32 = lane & 31, hi = lane >> 5;
  const int qrel = wid * 32 + r32, t = qb * 256 + qrel;
  const size_t tokq = (size_t)(b * S + t);
  bf16x8 qr[4];
  attn_load_q(proj + tokq * PLD + C_QD + h * 64 + hi * 8, qr);
  AttState st; st.m = 0.f; st.l = 0.f;
#pragma unroll
  for (int r = 0; r < 16; ++r) { st.o0[r] = 0.f; st.o1[r] = 0.f; }
  const uint2* bmp = bmt + (size_t)(b * 128) * 8192 + t;
  uint2 wn[4];
#pragma unroll
  for (int tt = 0; tt < 4; ++tt) wn[tt] = bmp[(size_t)tt * 8192];
  attn_stage<1>(lds, 0, proj, b, h, 0, lane, wid);
  const int ns = qb + 1;
  for (int s = 0; s < ns; ++s) {
    uint2 wc[4];
#pragma unroll
    for (int tt = 0; tt < 4; ++tt) wc[tt] = wn[tt];
    asm volatile("s_waitcnt vmcnt(0)" ::: "memory");
    __syncthreads();
    if (s + 1 < ns) {
#pragma unroll
      for (int tt = 0; tt < 4; ++tt) wn[tt] = bmp[(size_t)(4 * (s + 1) + tt) * 8192];
      attn_stage<1>(lds, ((s + 1) & 1) * ATT_ST, proj, b, h, (s + 1) * 256, lane, wid);
    }
#pragma unroll
    for (int tt = 0; tt < 4; ++tt) attn_tile<1>(lds, (s & 1) * ATT_ST + tt * 16384, qr, st, wc[tt], 0, qrel, r32, hi, lane);
  }
  float l = st.l; l += __shfl_xor(l, 32);
  attn_store(mix + tokq * D + 640 + h * 64 + 4 * hi, st, 1.f / l);
  __syncthreads();
}

DI void attn_own_unit(char* lds, const bf16_t* __restrict__ proj, bf16_t* __restrict__ part_o, float2* __restrict__ part_ml, int b, int h, int qb) {
  const int tid = otid(), lane = tid & 63, wid = __builtin_amdgcn_readfirstlane(tid >> 6), r32 = lane & 31, hi = lane >> 5;
  const int qrel = wid * 32 + r32, t = qb * 256 + qrel;
  const size_t tokq = (size_t)(b * S + t);
  attn_stage<0>(lds, 0, proj, b, h, qb * 256, lane, wid);
  bf16x8 qr[4];
  attn_load_q(proj + tokq * PLD + C_QM + h * 64 + hi * 8, qr);
  AttState st; st.m = 0.f; st.l = 0.f;
#pragma unroll
  for (int r = 0; r < 16; ++r) { st.o0[r] = 0.f; st.o1[r] = 0.f; }
  asm volatile("s_waitcnt vmcnt(0)" ::: "memory");
  __syncthreads();
#pragma unroll
  for (int tt = 0; tt < 4; ++tt) attn_tile<0>(lds, tt * 16384, qr, st, make_uint2(0u, 0u), tt, qrel, r32, hi, lane);
  float l = st.l; l += __shfl_xor(l, 32);
  const size_t pi = (tokq * 6 + h) * 4 + 3;
  if (hi == 0) st_wt64((unsigned long long*)&part_ml[pi], ((unsigned long long)__float_as_uint(l) << 32) | __float_as_uint(st.m));
  attn_store(part_o + pi * 64 + 4 * hi, st, 1.f / l);
  __syncthreads();
}

DI void attn_gather_unit(char* lds, const bf16_t* __restrict__ proj, bf16_t* __restrict__ part_o, float2* __restrict__ part_ml, int b, int h, int j, const unsigned* __restrict__ lst, int nent) {
  const int tid = otid(), lane = tid & 63, wid = __builtin_amdgcn_readfirstlane(tid >> 6), r32 = lane & 31, hi = lane >> 5;
  attn_stage<2>(lds, 0, proj, b, h, j * 256, lane, wid);
  asm volatile("s_waitcnt vmcnt(0)" ::: "memory");
  __syncthreads();
  const int ntile = (nent + 31) >> 5;
  for (int qt = wid; qt < ntile; qt += 8) {
    const int qi = qt * 32 + r32;
    const bool valid = qi < nent;
    const unsigned e = lst[valid ? qi : 0];
    const int t = (int)(e & 0x1FFFu), pslot = (int)(e >> 13);
    const size_t tokq = (size_t)(b * S + t);
    bf16x8 qr[4];
    attn_load_q(proj + tokq * PLD + C_QM + h * 64 + hi * 8, qr);
    AttState st; st.m = 0.f; st.l = 0.f;
#pragma unroll
    for (int r = 0; r < 16; ++r) { st.o0[r] = 0.f; st.o1[r] = 0.f; }
#pragma unroll
    for (int tt = 0; tt < 4; ++tt) attn_tile<2>(lds, tt * 16384, qr, st, make_uint2(0u, 0u), 0, 0, r32, hi, lane);
    float l = st.l; l += __shfl_xor(l, 32);
    if (valid) {
      const size_t pi = (tokq * 6 + h) * 4 + pslot;
      if (hi == 0) st_wt64((unsigned long long*)&part_ml[pi], ((unsigned long long)__float_as_uint(l) << 32) | __float_as_uint(st.m));
      attn_store(part_o + pi * 64 + 4 * hi, st, 1.f / l);
    }
  }
  __syncthreads();
}

DI void gate_unit(char* lds, int u, const bf16_t* __restrict__ proj, const float* __restrict__ kmean, unsigned* __restrict__ mcnt, unsigned* __restrict__ mlist) {
  unsigned* lc = (unsigned*)lds;
  unsigned* lb = lc + 192;
  float* kml = (float*)(lds + 2048);
  const int tid = otid();
  if (tid < 192) lc[tid] = 0u;
  const int tok = u * 64 + (tid & 63), head = __builtin_amdgcn_readfirstlane(tid >> 6);
  const int b = tok >> 13, t = tok & (S - 1), own = t >> 8;
  for (int i = tid; i < 6 * 32 * 16; i += NTHR) {
    const int jb = (i >> 4) & 31;
    if (jb < own) *(float4*)(kml + i * 4) = *(const float4*)(kmean + (size_t)b * 6 * 32 * 64 + i * 4);
  }
  __syncthreads();
  int sj[3] = {-1, -1, -1}; unsigned sp[3] = {0u, 0u, 0u};
  if (tid < 384) {
    u32x4 q[8];
    const bf16_t* qp = proj + (size_t)tok * PLD + C_QM + head * 64;
#pragma unroll
    for (int i = 0; i < 8; ++i) q[i] = *(const u32x4*)(qp + i * 8);
    float v1 = -INFINITY, v2 = -INFINITY, v3 = -INFINITY; int i1 = -1, i2 = -1, i3 = -1;
    for (int j = 0; j < own; ++j) {
      const float* km = kml + (head * 32 + j) * 64;
      float g = 0.f;
#pragma unroll
      for (int i = 0; i < 8; ++i) {
        const float4 ka = *(const float4*)(km + i * 8), kb = *(const float4*)(km + i * 8 + 4);
        g += bflo(q[i].x) * ka.x + bfhi(q[i].x) * ka.y + bflo(q[i].y) * ka.z + bfhi(q[i].y) * ka.w;
        g += bflo(q[i].z) * kb.x + bfhi(q[i].z) * kb.y + bflo(q[i].w) * kb.z + bfhi(q[i].w) * kb.w;
      }
      if (g > v1) { v3 = v2; i3 = i2; v2 = v1; i2 = i1; v1 = g; i1 = j; }
      else if (g > v2) { v3 = v2; i3 = i2; v2 = g; i2 = j; }
      else if (g > v3) { v3 = g; i3 = j; }
    }
    sj[0] = i1; sj[1] = i2; sj[2] = i3;
#pragma unroll
    for (int p = 0; p < 3; ++p) if (sj[p] >= 0) sp[p] = atomicAdd(&lc[head * 32 + sj[p]], 1u);
  }
  __syncthreads();
  if (tid < 192 && lc[tid]) lb[tid] = atomicAdd(&mcnt[(b * 6 + (tid >> 5)) * 32 + (tid & 31)], lc[tid]);
  __syncthreads();
  if (tid < 384) {
#pragma unroll
    for (int p = 0; p < 3; ++p) if (sj[p] >= 0) {
      const int c = (b * 6 + head) * 32 + sj[p];
      st_wt32(&mlist[(size_t)c * 8192 + lb[head * 32 + sj[p]] + sp[p]], (unsigned)t | ((unsigned)p << 13));
    }
  }
  __syncthreads();
}

DI void conv_unit(char* lds, int u, const bf16_t* __restrict__ proj, bf16_t* __restrict__ mix, const float* __restrict__ conv_w, const float* __restrict__ conv_b,
                  const float* __restrict__ ln_g, const float* __restrict__ ln_b);
DI void attn_queue_phase(char* lds, const bf16_t* proj, bf16_t* mix, const uint2* bmt, bf16_t* part_o, float2* part_ml, const unsigned* mcnt, const unsigned* mlist, unsigned* qhead,
                         const float* w1, const float* w3, const float* w2, bf16_t* w13T, bf16_t* w2T,
                         const float* conv_w, const float* conv_b, const float* ln_g, const float* ln_b) {
  unsigned* pfx = (unsigned*)(lds + 133120);
  unsigned* qw = (unsigned*)(lds + 133120 + 3328);
  const int tid = otid(), lane = tid & 63;
  if (tid < 64) {
    unsigned loc[12]; unsigned sum = 0u;
#pragma unroll
    for (int i = 0; i < 12; ++i) { loc[i] = (mcnt[tid * 12 + i] + 2047u) >> 11; sum += loc[i]; }
    unsigned run = scan_add(sum) - sum;
    if (lane == 0) pfx[0] = 0u;
#pragma unroll
    for (int i = 0; i < 12; ++i) { run += loc[i]; pfx[tid * 12 + i + 1] = run; }
  }
  __syncthreads();
  const int nsp = (int)pfx[768];
  const int natt = 768 + nsp + 768;
  const int nconv = T / 64;
  const int total = natt + nconv + PREP_EXP_ITEMS;
  int qlast = 0;
  for (;;) {
    if (tid == 0) qw[0] = atomicAdd(qhead, 1u);
    __syncthreads();
    const int q = (int)qw[0];
    __syncthreads();
    if (q >= natt) { qlast = q; break; }
    if (q < 768) {
      const int qb = 31 - q / 24, bh = q % 24;
      attn_dsa_unit(lds, proj, mix, bmt, bh / 6, bh % 6, qb);
    } else if (q < 768 + nsp) {
      const unsigned item = (unsigned)(q - 768);
      int lo = 0, hi = 768;
      while (hi - lo > 1) { const int mid = (lo + hi) >> 1; if (pfx[mid] <= item) lo = mid; else hi = mid; }
      const int c = lo, chunk = (int)(item - pfx[c]);
      const int nent = min(2048, (int)mcnt[c] - chunk * 2048);
      attn_gather_unit(lds, proj, part_o, part_ml, c / 192, (c >> 5) % 6, c & 31, mlist + (size_t)c * 8192 + chunk * 2048, nent);
    } else {
      const int o = q - 768 - nsp, qb = 31 - o / 24, bh = o % 24;
      attn_own_unit(lds, proj, part_o, part_ml, bh / 6, bh % 6, qb);
    }
  }
  for (int q = qlast; q < total;) {
    if (q < natt + nconv) conv_unit(lds, q - natt, proj, mix, conv_w, conv_b, ln_g, ln_b);
    else prep_exp_item(lds, q - natt - nconv, w1, w3, w2, w13T, w2T);
    if (tid == 0) qw[0] = atomicAdd(qhead, 1u);
    __syncthreads();
    q = (int)qw[0];
    __syncthreads();
  }
}

constexpr int SEL_CAP = 1024, SEL_G = 512, SEL_K = 256;
constexpr int SEL_LDS = 131072 + 512 + 4096;
DI unsigned fkey(float f) { const unsigned u = __float_as_uint(f); return (u & 0x80000000u) ? ~u : (u | 0x80000000u); }

DI float fkey_inv(unsigned k) { const unsigned u = (k & 0x80000000u) ? (k & 0x7fffffffu) : ~k; return __uint_as_float(u); }
DI int sbin(float s, float lo, float sc) { return min(63, __float2int_rd((s - lo) * sc)); }
DI int hist_scan(const unsigned* h, int lane, int K) {
  const unsigned Sx = scan_add(h[63 - lane]);
  const unsigned long long m = __ballot(Sx >= (unsigned)K);
  return m ? (63 - (int)__builtin_ctzll(m)) : -1;
}
DI void sel_row_maint(uint2* rowbuf, unsigned* cntp, float* taup, unsigned* hist, bool last, int K = SEL_K, bool thr = false) {
  const int lane = otid() & 63;
  int n = (int)*cntp; if (n > SEL_CAP) n = SEL_CAP;
  const int lim = thr ? K - 1 : (last ? SEL_K : (SEL_CAP - SEL_G));
  if (thr && n <= lim) { if (lane == 0) { *cntp = 0u; *taup = -INFINITY; } }
  if (n > lim) {
    unsigned ky[16], kx[16];
    unsigned kmin = 0xffffffffu, kmax = 0u;
#pragma unroll
    for (int i = 0; i < 16; ++i) {
      const int idx = lane + 64 * i; uint2 v = make_uint2(0u, 0u);
      if (64 * i < n) { if (idx < n) { v = rowbuf[idx]; kmin = min(kmin, v.y); kmax = max(kmax, v.y); } }
      ky[i] = v.y; kx[i] = v.x;
    }
    kmin = red_min(kmin); kmax = red_max(kmax);
    const float lo = fkey_inv(kmin), range = fkey_inv(kmax) - lo, sc = range > 0.f ? 64.f / range : 0.f;
    hist[lane] = 0u;
    int bn[16];
#pragma unroll
    for (int i = 0; i < 16; ++i) { const int idx = lane + 64 * i; bn[i] = -1; if (64 * i < n) { if (idx < n) { bn[i] = max(0, sbin(fkey_inv(ky[i]), lo, sc)); atomicAdd(&hist[bn[i]], 1u); } } }
    const int L = hist_scan(hist, lane, K);
    unsigned ka = 0xffffffffu, kb = 0xffffffffu;
    int ckeep = 0;
#pragma unroll
    for (int i = 0; i < 16; ++i) { if (64 * i < n) { if (bn[i] >= L) { ka = min(ka, ky[i]); ++ckeep; } if (bn[i] > L) kb = min(kb, ky[i]); } }
    ka = red_min(ka); kb = red_min(kb); ckeep = (int)red_add((unsigned)ckeep);
    if (thr) { if (lane == 0) { *cntp = 0u; *taup = fkey_inv(ka); } return; }
    unsigned theta = ka, phi = 0u;
    int nsel = ckeep;
    if (last || ckeep > SEL_CAP - SEL_G) {
      unsigned av = ka, hi = (kb != 0xffffffffu) ? kb - 1u : kmax;
      int ca = -1;
      while (av < hi) {
        const unsigned d = hi - av, mid = av + (d >> 1) + (d & 1u);
        int c = 0;
#pragma unroll
        for (int i = 0; i < 16; ++i) { if (64 * i < n) c += __popcll(__ballot(ky[i] >= mid)); }
        if (c >= SEL_K) { av = mid; ca = c; } else hi = mid - 1u;
        if (c == SEL_K) break;
      }
      theta = av;
      if (ca != SEL_K) {
        int cgt = 0;
#pragma unroll
        for (int i = 0; i < 16; ++i) cgt += __popcll(__ballot(ky[i] > theta));
        const int need = SEL_K - cgt;
        for (int bit = 31; bit >= 0; --bit) {
          const unsigned cand = phi | (1u << bit);
          int c = 0;
#pragma unroll
          for (int i = 0; i < 16; ++i) c += __popcll(__ballot(ky[i] == theta && kx[i] >= cand));
          if (c >= need) phi = cand;
          if (c == need) break;
        }
      }
      nsel = SEL_K;
    }
    const unsigned long long lt = (1ull << lane) - 1ull;
    int base = 0;
#pragma unroll
    for (int i = 0; i < 16; ++i) {
      if (64 * i < n) {
        const bool sl = (ky[i] > theta) || (ky[i] == theta && kx[i] >= phi);
        const unsigned long long bal = __ballot(sl);
        const int pos = base + __popcll(bal & lt);
        if (sl && pos < SEL_CAP) rowbuf[pos] = make_uint2(kx[i], ky[i]);
        base += __popcll(bal);
      }
    }
    if (lane == 0) { *cntp = (unsigned)nsel; *taup = fkey_inv(theta); }
  }
}

constexpr int SEL_CTL = 131072, SEL_HIST = 131072 + 512;
template <int SM>
DI void dsa_select_unit(char* lds, const bf16_t* __restrict__ proj, uint2* __restrict__ bmt, int b, int rg) {
  uint2* buf = (uint2*)lds;
  unsigned* cnt = (unsigned*)(lds + SEL_CTL);
  float* tauf = (float*)(cnt + 16);
  unsigned* flag = cnt + 32;
  unsigned* hist = (unsigned*)(lds + SEL_HIST);
  const int tid = otid(), lane = tid & 63, wid = __builtin_amdgcn_readfirstlane(tid >> 6), fr = lane & 15, fq = lane >> 4;
  const int t0 = rg * 16, t = t0 + fr;
  if (tid < 16) { cnt[tid] = 0u; tauf[tid] = -INFINITY; }
  if (tid == 0) flag[0] = 0u;
  const bf16_t* qrow = proj + (size_t)(b * S + t) * PLD;
  bf16x8 qf[8][2]; float w[8];
#pragma unroll
  for (int hh = 0; hh < 8; ++hh) {
    qf[hh][0] = *(const bf16x8*)(qrow + C_QI + hh * 64 + fq * 8);
    qf[hh][1] = *(const bf16x8*)(qrow + C_QI + hh * 64 + 32 + fq * 8);
    w[hh] = bf2f(qrow[C_WI + hh]);
  }
  const int ntile = rg + 1;
  const bf16_t* kbase = proj + (size_t)(b * S + fr) * PLD + C_KI + fq * 8;
  bf16x8 q9[2];
#pragma unroll
  for (int s = 0; s < 2; ++s) {
    float f[8];
#pragma unroll
    for (int j = 0; j < 8; ++j) {
      float a = 0.f;
#pragma unroll
      for (int hh = 0; hh < 8; ++hh) a += w[hh] * bf2f((bf16_t)qf[hh][s][j]);
      f[j] = a;
    }
    u32x4 o; o.x = cvtpk(f[0], f[1]); o.y = cvtpk(f[2], f[3]); o.z = cvtpk(f[4], f[5]); o.w = cvtpk(f[6], f[7]);
    q9[s] = __builtin_bit_cast(bf16x8, o);
  }
  unsigned dmask = 0u;
#pragma unroll
  for (int r = 0; r < 4; ++r) dmask |= (fq * 4 + r <= fr) ? (1u << r) : 0u;
  __syncthreads();
  auto stream = [&](int first, int step, int kend, float tv) {
    bf16x8 kf[4][2];
#pragma unroll
    for (int i = 0; i < 4; ++i) {
      const int kt = first + i * step;
      if (kt < kend) { const bf16_t* kp = kbase + (size_t)kt * 16 * PLD; kf[i][0] = *(const bf16x8*)kp; kf[i][1] = *(const bf16x8*)(kp + 32); }
    }
    for (int kb0 = first; kb0 < kend; kb0 += 4 * step) {
      bf16x8 kn[4][2];
#pragma unroll
      for (int i = 0; i < 4; ++i) {
        const int kt = kb0 + (4 + i) * step;
        if (kt < kend) { const bf16_t* kp = kbase + (size_t)kt * 16 * PLD; kn[i][0] = *(const bf16x8*)kp; kn[i][1] = *(const bf16x8*)(kp + 32); }
      }
      f32x4 sv[4];
      unsigned pmask = 0u;
      {
        const f32x4 z = (f32x4){0.f, 0.f, 0.f, 0.f};
        f32x4 xb[3];
        f32x4 acc = z;
#define SEL_PAIR(n) do { const int i_ = (n) / 9, j_ = (n) % 9; \
          const f32x4 t_ = MFMA16(kf[i_][0], j_ ? qf[j_ ? j_ - 1 : 0][0] : q9[0], z); \
          xb[(n) % 3] = MFMA16(kf[i_][1], j_ ? qf[j_ ? j_ - 1 : 0][1] : q9[1], t_); } while (0)
        SEL_PAIR(0); SEL_PAIR(1);
#pragma unroll
        for (int n = 0; n < 36; ++n) {
          if (n + 2 < 36) SEL_PAIR(n + 2);
          __builtin_amdgcn_sched_barrier(0);
          const int i = n / 9, j = n % 9;
          if (j == 0) acc = xb[n % 3];
          else {
#pragma unroll
            for (int r = 0; r < 4; ++r) { float v = fmaf(fabsf(xb[n % 3][r]), w[j - 1], acc[r]); asm volatile("" : "+v"(v)); acc[r] = v; }
          }
          if (j == 8) {
            const int kt = kb0 + i * step;
            sv[i] = acc;
            if (SM == 1) { asm volatile("" :: "v"(acc[0]), "v"(acc[1]), "v"(acc[2]), "v"(acc[3])); }
            else {
              const unsigned allow = (kt < kend) ? ((kt == ntile - 1) ? dmask : 0xfu) : 0u;
              unsigned pm = 0u;
#pragma unroll
              for (int r = 0; r < 4; ++r) pm |= (acc[r] >= tv) ? (1u << r) : 0u;
              pmask |= (pm & allow) << (i * 4);
            }
          }
          __builtin_amdgcn_sched_barrier(0);
        }
#undef SEL_PAIR
      }
      if (SM != 1) {
        const int np = __popc(pmask);
        unsigned slot = 0u;
        if (np) slot = atomicAdd(&cnt[fr], (unsigned)np);
        uint2* rb = buf + fr * SEL_CAP;
#pragma unroll
        for (int i = 0; i < 4; ++i) {
          const int kt = kb0 + i * step;
#pragma unroll
          for (int r = 0; r < 4; ++r) {
            if ((pmask >> (i * 4 + r)) & 1u) {
              const int key = kt * 16 + fq * 4 + r;
              if (slot < (unsigned)SEL_CAP) rb[slot] = make_uint2(~(unsigned)key, fkey(sv[i][r]));
              ++slot;
            }
          }
        }
      }
#pragma unroll
      for (int i = 0; i < 4; ++i) { kf[i][0] = kn[i][0]; kf[i][1] = kn[i][1]; }
    }
  };
  bool done = false;
  if (SM == 0 || SM == 3) {
    if (ntile > 64) {
      stream(8 * wid, 64, ntile, -INFINITY);
      __syncthreads();
#pragma unroll 1
      for (int rr = 0; rr < 2; ++rr) {
        const int row = 2 * wid + rr;
        const int ns = (int)cnt[row], nrow = t0 + row + 1;
        const int K = min(ns, (2 * SEL_K * ns + nrow - 1) / nrow);
        sel_row_maint(buf + row * SEL_CAP, &cnt[row], &tauf[row], hist + wid * 64, false, max(K, 1), true);
      }
      __syncthreads();
      stream(wid, 8, ntile, tauf[fr]);
      __syncthreads();
      if (tid < 16) { const unsigned c = cnt[tid]; if (c < (unsigned)SEL_K || c > (unsigned)SEL_CAP) atomicOr(&flag[0], 1u); }
      __syncthreads();
      done = (flag[0] == 0u);
      if (done) {
#pragma unroll 1
        for (int rr = 0; rr < 2; ++rr) { const int row = 2 * wid + rr; sel_row_maint(buf + row * SEL_CAP, &cnt[row], &tauf[row], hist + wid * 64, true); }
      }
      __syncthreads();
      if (!done && tid < 16) { cnt[tid] = 0u; tauf[tid] = -INFINITY; }
      __syncthreads();
    }
  }
  if (!done) {
    const int nround = (ntile + 31) >> 5;
    for (int rd = 0; rd < nround; ++rd) {
      stream(rd * 32 + wid, 8, min(ntile, rd * 32 + 32), tauf[fr]);
      __syncthreads();
      const bool last = (rd == nround - 1);
      if (SM == 1 || SM == 2) continue;
#pragma unroll 1
      for (int rr = 0; rr < 2; ++rr) {
        const int row = 2 * wid + rr;
        sel_row_maint(buf + row * SEL_CAP, &cnt[row], &tauf[row], hist + wid * 64, last);
      }
      __syncthreads();
    }
  }
  if (SM != 0) { __syncthreads(); return; }
#pragma unroll
  for (int i = 0; i < 8; ++i) { const int wd = tid + NTHR * i; *(unsigned*)(lds + (wd >> 8) * 8192 + 4096 + (wd & 255) * 4) = 0u; }
  __syncthreads();
  {
    const int row = tid >> 5;
    int n = (int)cnt[row]; if (n > SEL_K) n = SEL_K;
    unsigned* img = (unsigned*)(lds + row * 8192 + 4096);
#pragma unroll
    for (int i = 0; i < 8; ++i) {
      const int e = (tid & 31) + 32 * i;
      if (e < n) { const unsigned idx = ~buf[row * SEL_CAP + e].x; atomicOr(&img[idx >> 5], 1u << (idx & 31)); }
    }
  }
  __syncthreads();
  {
    const int ntw = 4 * (t0 >> 8) + 4;
    const int r = tid & 15;
    const unsigned* img = (const unsigned*)(lds + r * 8192 + 4096);
    for (int tile = tid >> 4; tile < ntw; tile += 32)
      bmt[((size_t)(b * 128 + tile)) * 8192 + t0 + r] = make_uint2(img[2 * tile], img[2 * tile + 1]);
  }
  __syncthreads();
}

constexpr int MIX_LDS = 94 * 256 * 4;
DI void conv_unit(char* lds, int u, const bf16_t* __restrict__ proj, bf16_t* __restrict__ mix, const float* __restrict__ conv_w, const float* __restrict__ conv_b,
                  const float* __restrict__ ln_g, const float* __restrict__ ln_b) {
  float* ut = (float*)lds;
  const int tid = otid(), lane = tid & 63, wid = __builtin_amdgcn_readfirstlane(tid >> 6);
  {
    const int tok0 = u * 64, b = tok0 >> 13, t0 = tok0 & (S - 1);
#pragma unroll
    for (int it = 0; it < 6; ++it) {
      const int task = tid + it * NTHR;
      if (task >= 94 * 32) break;
      const int row = task >> 5, cc = (task & 31) * 8;
      const int tt = t0 - 30 + row;
      float uv[8] = {0.f, 0.f, 0.f, 0.f, 0.f, 0.f, 0.f, 0.f};
      if (tt >= 0) {
        const bf16_t* pr = proj + (size_t)(b * S + tt) * PLD;
        const u32x4 a = *(const u32x4*)(pr + C_CA + cc), g = *(const u32x4*)(pr + C_CG + cc);
        const float av[8] = {bflo(a.x), bfhi(a.x), bflo(a.y), bfhi(a.y), bflo(a.z), bfhi(a.z), bflo(a.w), bfhi(a.w)};
        const float gv[8] = {bflo(g.x), bfhi(g.x), bflo(g.y), bfhi(g.y), bflo(g.z), bfhi(g.z), bflo(g.w), bfhi(g.w)};
#pragma unroll
        for (int q = 0; q < 8; ++q) uv[q] = av[q] * frcp(1.f + fexp2(gv[q] * -1.4426950408889634f));
      }
      *(float4*)(ut + row * 256 + cc) = make_float4(uv[0], uv[1], uv[2], uv[3]);
      *(float4*)(ut + row * 256 + cc + 4) = make_float4(uv[4], uv[5], uv[6], uv[7]);
    }
    __syncthreads();
    const int c = tid & 255, half = __builtin_amdgcn_readfirstlane(tid >> 8);
    float cw[31];
#pragma unroll
    for (int w = 0; w < 31; ++w) cw[w] = conv_w[w * 256 + c];
    float y[32];
    const float cb = conv_b[c];
#pragma unroll
    for (int o = 0; o < 32; ++o) y[o] = cb;
#pragma unroll
    for (int rho = 0; rho < 62; ++rho) {
      const float uvv = ut[(half * 32 + rho) * 256 + c];
#pragma unroll
      for (int o = 0; o < 32; ++o) { if (rho - o >= 0 && rho - o <= 30) y[o] += uvv * cw[rho - o]; }
    }
    __syncthreads();
#pragma unroll
    for (int o = 0; o < 32; ++o) ut[(half * 32 + o) * 256 + c] = y[o];
    __syncthreads();
    {
      const float4 gg = *(const float4*)(ln_g + lane * 4), bb = *(const float4*)(ln_b + lane * 4);
#pragma unroll 1
      for (int i4 = 0; i4 < 8; i4 += 4) {
        float4 v[4]; float sm[4], vr[4];
#pragma unroll
        for (int r = 0; r < 4; ++r) { v[r] = *(const float4*)(ut + (wid * 8 + i4 + r) * 256 + lane * 4); sm[r] = v[r].x + v[r].y + v[r].z + v[r].w; }
        wave_sum4(sm);
#pragma unroll
        for (int r = 0; r < 4; ++r) {
          const float mu = sm[r] * (1.f / 256.f);
          v[r].x -= mu; v[r].y -= mu; v[r].z -= mu; v[r].w -= mu;
          vr[r] = v[r].x * v[r].x + v[r].y * v[r].y + v[r].z * v[r].z + v[r].w * v[r].w;
        }
        wave_sum4(vr);
#pragma unroll
        for (int r = 0; r < 4; ++r) {
          const float rs = rsqrtf(vr[r] * (1.f / 256.f) + EPS);
          const float z0 = v[r].x * rs * gg.x + bb.x, z1 = v[r].y * rs * gg.y + bb.y, z2 = v[r].z * rs * gg.z + bb.z, z3 = v[r].w * rs * gg.w + bb.w;
          u32x2 o; o.x = cvtpk(silu_f(z0), silu_f(z1)); o.y = cvtpk(silu_f(z2), silu_f(z3));
          *(u32x2*)(mix + (size_t)(tok0 + wid * 8 + i4 + r) * D + 384 + lane * 4) = o;
        }
      }
    }
    __syncthreads();
  }
}

DI void mixfin_phase(bf16_t* __restrict__ mix, const float* __restrict__ mg, const float* __restrict__ dg, const bf16_t* __restrict__ part_o, const float2* __restrict__ part_ml) {
  const int tid = otid(), lane = tid & 63, wid = __builtin_amdgcn_readfirstlane(tid >> 6);
  for (int u = blockIdx.x; u < T / 64; u += gridDim.x) {
    const int tok0 = u * 64, t0 = tok0 & (S - 1);
    {
      const int nsel = min(3, t0 >> 8);
#pragma unroll 4
      for (int i = 0; i < 8; ++i) {
        const int tl = wid * 8 + i;
        const size_t tok = (size_t)(tok0 + tl);
        bf16_t* mr = mix + tok * D;
        float av[8] = {0.f, 0.f, 0.f, 0.f, 0.f, 0.f, 0.f, 0.f};
#pragma unroll
        for (int ch = 0; ch < 2; ++ch) {
          if (ch == 0 || lane < 32) {
            const int col = ch * 256 + lane * 4, hh = col >> 6, d0 = col & 63;
            const size_t pb = (tok * 6 + hh) * 4;
            const float2 ml3 = part_ml[pb + 3];
            float2 mls[3]; float M = ml3.x;
#pragma unroll
            for (int p = 0; p < 3; ++p) { mls[p] = make_float2(-1e30f, 0.f); if (p < nsel) { mls[p] = part_ml[pb + p]; M = fmaxf(M, mls[p].x); } }
            float wsum = 0.f, acc4[4] = {0.f, 0.f, 0.f, 0.f};
#pragma unroll
            for (int p = 0; p < 4; ++p) {
              if (p == 3 || p < nsel) {
                const float2 mlp = (p == 3) ? ml3 : mls[p < 3 ? p : 0];
                const float wgt = mlp.y * fexp2(mlp.x - M);
                const u32x2 ov = *(const u32x2*)(part_o + (pb + p) * 64 + d0);
                wsum += wgt;
                acc4[0] += wgt * bflo(ov.x); acc4[1] += wgt * bfhi(ov.x); acc4[2] += wgt * bflo(ov.y); acc4[3] += wgt * bfhi(ov.y);
              }
            }
            const float iw = 1.f / wsum;
#pragma unroll
            for (int q = 0; q < 4; ++q) av[ch * 4 + q] = acc4[q] * iw;
          }
        }
        {
          const float ss = wave_sum(av[0] * av[0] + av[1] * av[1] + av[2] * av[2] + av[3] * av[3] + av[4] * av[4] + av[5] * av[5] + av[6] * av[6] + av[7] * av[7]);
          const float rs = rsqrtf(ss * (1.f / 384.f) + EPS);
          const float4 g0 = *(const float4*)(mg + lane * 4);
          u32x2 o; o.x = cvtpk(av[0] * rs * g0.x, av[1] * rs * g0.y); o.y = cvtpk(av[2] * rs * g0.z, av[3] * rs * g0.w);
          *(u32x2*)(mr + lane * 4) = o;
          if (lane < 32) {
            const float4 g1 = *(const float4*)(mg + 256 + lane * 4);
            u32x2 o2; o2.x = cvtpk(av[4] * rs * g1.x, av[5] * rs * g1.y); o2.y = cvtpk(av[6] * rs * g1.z, av[7] * rs * g1.w);
            *(u32x2*)(mr + 256 + lane * 4) = o2;
          }
        }
        {
          bf16_t* pp = mr + 640;
          const u32x2 a = *(const u32x2*)(pp + lane * 4);
          u32x2 c2 = (u32x2){0u, 0u};
          if (lane < 32) c2 = *(const u32x2*)(pp + 256 + lane * 4);
          const float a0 = bflo(a.x), a1 = bfhi(a.x), a2 = bflo(a.y), a3 = bfhi(a.y);
          const float c0 = bflo(c2.x), c1 = bfhi(c2.x), c2f = bflo(c2.y), c3 = bfhi(c2.y);
          const float ss = wave_sum(a0 * a0 + a1 * a1 + a2 * a2 + a3 * a3 + c0 * c0 + c1 * c1 + c2f * c2f + c3 * c3);
          const float rs = rsqrtf(ss * (1.f / 384.f) + EPS);
          const float4 g0 = *(const float4*)(dg + lane * 4);
          u32x2 o; o.x = cvtpk(a0 * rs * g0.x, a1 * rs * g0.y); o.y = cvtpk(a2 * rs * g0.z, a3 * rs * g0.w);
          *(u32x2*)(pp + lane * 4) = o;
          if (lane < 32) {
            const float4 g1 = *(const float4*)(dg + 256 + lane * 4);
            u32x2 o2; o2.x = cvtpk(c0 * rs * g1.x, c1 * rs * g1.y); o2.y = cvtpk(c2f * rs * g1.z, c3 * rs * g1.w);
            *(u32x2*)(pp + 256 + lane * 4) = o2;
          }
        }
      }
    }
    __syncthreads();
  }
}

DI void route_phase(char* lds, const float* __restrict__ logits, const float* __restrict__ rgb, const float* __restrict__ reb, unsigned* __restrict__ list, int* __restrict__ cnt, float* __restrict__ gate) {
  unsigned* lcnt = (unsigned*)lds;
  unsigned* lbase = lcnt + 32;
  const int tid = otid();
  for (int u = blockIdx.x; u < T / NTHR; u += gridDim.x) {
    if (tid < 32) lcnt[tid] = 0u;
    __syncthreads();
    const int tok = u * NTHR + tid;
    const float* lg = logits + (size_t)tok * 36;
    float gl[4];
#pragma unroll
    for (int i = 0; i < 4; ++i) gl[i] = lg[i] + rgb[i];
    int gi = 0; float gm = gl[0];
#pragma unroll
    for (int i = 1; i < 4; ++i) if (gl[i] > gm) { gm = gl[i]; gi = i; }
    float gs = 0.f;
#pragma unroll
    for (int i = 0; i < 4; ++i) gs += __expf(gl[i] - gm);
    const float gw = 1.f / gs;
    float e1 = -INFINITY, e2 = -INFINITY; int j1 = 0, j2 = 0;
    for (int j = 0; j < 8; ++j) {
      const float v = lg[4 + gi * 8 + j] + reb[gi * 8 + j];
      if (v > e1) { e2 = e1; j2 = j1; e1 = v; j1 = j; }
      else if (v > e2) { e2 = v; j2 = j; }
    }
    const float p2 = 1.f / (1.f + __expf(e1 - e2)), p1 = 1.f - p2;
    const int ex1 = gi * 8 + j1, ex2 = gi * 8 + j2;
    gate[tok * 2] = gw * p1; gate[tok * 2 + 1] = gw * p2;
    const unsigned pos1 = atomicAdd(&lcnt[ex1], 1u);
    const unsigned pos2 = atomicAdd(&lcnt[ex2], 1u);
    __syncthreads();
    if (tid < 32) lbase[tid] = (unsigned)atomicAdd(&cnt[tid], (int)lcnt[tid]);
    __syncthreads();
    st_wt32(&list[(size_t)ex1 * 65536 + lbase[ex1] + pos1], (unsigned)(tok * 2));
    st_wt32(&list[(size_t)ex2 * 65536 + lbase[ex2] + pos2], (unsigned)(tok * 2 + 1));
    __syncthreads();
  }
}

DI void combine_phase(float* __restrict__ xio, const bf16_t* __restrict__ ys, const float* __restrict__ g2, int final_mode,
                      const float* __restrict__ g, const float* __restrict__ mod_sh, const float* __restrict__ mod_sc, bf16_t* __restrict__ h) {
  const int tid_ = otid(); const int lane = tid_ & 63, wid = __builtin_amdgcn_readfirstlane(tid_ >> 6);
  for (int row0 = (blockIdx.x * 8 + wid) * 2; row0 < T; row0 += gridDim.x * 16) {
    const int b = row0 >> 13;
    float4 v[2][4]; float ssa[4] = {0.f, 0.f, 0.f, 0.f};
    u32x2 ya[2][4], yc[2][4];
#pragma unroll
    for (int r = 0; r < 2; ++r) {
      const float* xr = xio + (size_t)(row0 + r) * D;
      const bf16_t* y0 = ys + (size_t)(row0 + r) * 2048;
#pragma unroll
      for (int i = 0; i < 4; ++i) {
        const int col = i * 256 + lane * 4;
        v[r][i] = *(const float4*)(xr + col);
        ya[r][i] = *(const u32x2*)(y0 + col); yc[r][i] = *(const u32x2*)(y0 + 1024 + col);
      }
    }
#pragma unroll
    for (int i = 0; i < 4; ++i) {
      const int col = i * 256 + lane * 4;
      const float4 gg = *(const float4*)(g2 + (size_t)b * 6144 + col);
#pragma unroll
      for (int r = 0; r < 2; ++r) {
        v[r][i].x += gg.x * (bflo(ya[r][i].x) + bflo(yc[r][i].x)); v[r][i].y += gg.y * (bfhi(ya[r][i].x) + bfhi(yc[r][i].x));
        v[r][i].z += gg.z * (bflo(ya[r][i].y) + bflo(yc[r][i].y)); v[r][i].w += gg.w * (bfhi(ya[r][i].y) + bfhi(yc[r][i].y));
        ssa[r] += v[r][i].x * v[r][i].x + v[r][i].y * v[r][i].y + v[r][i].z * v[r][i].z + v[r][i].w * v[r][i].w;
      }
    }
    wave_sum4(ssa);
#pragma unroll
    for (int i = 0; i < 4; ++i) {
      const int col = i * 256 + lane * 4;
      const float4 gg = *(const float4*)(g + col);
      float4 sc = make_float4(0.f, 0.f, 0.f, 0.f), sh = sc;
      if (!final_mode) { sc = *(const float4*)(mod_sc + (size_t)b * 6144 + col); sh = *(const float4*)(mod_sh + (size_t)b * 6144 + col); }
#pragma unroll
      for (int r = 0; r < 2; ++r) {
        const float rstd = rsqrtf(ssa[r] * (1.f / 1024.f) + EPS);
        float* xr = xio + (size_t)(row0 + r) * D;
        if (final_mode) {
          *(float4*)(xr + col) = make_float4(v[r][i].x * rstd * gg.x, v[r][i].y * rstd * gg.y, v[r][i].z * rstd * gg.z, v[r][i].w * rstd * gg.w);
        } else {
          *(float4*)(xr + col) = v[r][i];
          u32x2 o;
          o.x = cvtpk(v[r][i].x * rstd * gg.x * (1.f + sc.x) + sh.x, v[r][i].y * rstd * gg.y * (1.f + sc.y) + sh.y);
          o.y = cvtpk(v[r][i].z * rstd * gg.z * (1.f + sc.z) + sh.z, v[r][i].w * rstd * gg.w * (1.f + sc.w) + sh.w);
          *(u32x2*)(h + (size_t)(row0 + r) * D + col) = o;
        }
      }
    }
  }
}

#define XB_TMO      128
#define XB_XCNT(j)  (256  + 64 * (j))
#define XB_XSUB(j)  (1280 + 64 * (j))
#define XB_XGEN(j)  (2304 + 64 * (j))
#define XB_TOP      3328
#define XB_TOPGEN   3392
#define XCD_BAR_WORDS 3456
#define XB_SPIN_CAP (1u << 18)
DI unsigned xb_ld(unsigned* p) { return __hip_atomic_load(p, __ATOMIC_RELAXED, __HIP_MEMORY_SCOPE_AGENT); }
DI unsigned xb_add(unsigned* p, unsigned v) { return __hip_atomic_fetch_add(p, v, __ATOMIC_RELAXED, __HIP_MEMORY_SCOPE_AGENT); }
DI unsigned xb_xcc_id() { return (unsigned)__builtin_amdgcn_s_getreg((3 << 11) | 20) & 0xFu; }
#define XB_SPIN(cond, bar) do { unsigned _sp = 0; while (cond) { __builtin_amdgcn_s_sleep(1); \
    if ((++_sp & 255u) == 0u) { if (xb_ld(&(bar)[XB_TMO])) break; if (_sp > XB_SPIN_CAP) { atomicAdd(&(bar)[XB_TMO], 1u); break; } } } } while (0)
struct XcdBarrier { unsigned* bar; unsigned x; volatile LAS unsigned* st; };
DI XcdBarrier xcd_barrier_post(unsigned* bar, volatile LAS unsigned* st) {
  XcdBarrier b; b.bar = bar; b.x = xb_xcc_id(); b.st = st;
  if (threadIdx.x == 0) (void)xb_add(&bar[XB_XCNT(b.x)], 1u);
  return b;
}
DI void xcd_barrier_complete(unsigned* bar, unsigned x, unsigned& nloc, unsigned& nx) {
  const unsigned G = gridDim.x * gridDim.y * gridDim.z;
  unsigned sum, cnt, mine, sp = 0u;
  for (;;) {
    sum = 0u; cnt = 0u; mine = 0u;
#pragma unroll
    for (unsigned j = 0; j < 16; ++j) { const unsigned c = xb_ld(&bar[XB_XCNT(j)]); sum += c; cnt += (c > 0u) ? 1u : 0u; mine = (j == x) ? c : mine; }
    if (sum == G) break;
    __builtin_amdgcn_s_sleep(1);
    if ((++sp & 255u) == 0u) { if (xb_ld(&bar[XB_TMO])) break; if (sp > XB_SPIN_CAP) { atomicAdd(&bar[XB_TMO], 1u); break; } }
  }
  nloc = mine > 0u ? mine : 1u; nx = cnt > 0u ? cnt : 1u;
}
DI void xcd_barrier(const XcdBarrier& b) {
  asm volatile("s_waitcnt vmcnt(0)" ::: "memory");
  __syncthreads();
  if (threadIdx.x == 0) {
    unsigned* bar = b.bar;
    __builtin_amdgcn_s_waitcnt(0);
    unsigned nloc = b.st[0], nx = b.st[1];
    if (nloc == 0u) { xcd_barrier_complete(bar, b.x, nloc, nx); b.st[0] = nloc; b.st[1] = nx; }
    const unsigned old = xb_add(&bar[XB_XSUB(b.x)], 1u);
    const unsigned gen = old / nloc;
    if (old + 1u == (gen + 1u) * nloc) {
      __builtin_amdgcn_fence(__ATOMIC_RELEASE, "");
      asm volatile("s_waitcnt vmcnt(0)" ::: "memory");
      const unsigned og = xb_add(&bar[XB_TOP], 1u);
      const unsigned tg = og / nx;
      if (og + 1u == (tg + 1u) * nx) xb_add(&bar[XB_TOPGEN], 1u);
      else XB_SPIN(xb_ld(&bar[XB_TOPGEN]) == tg, bar);
      __builtin_amdgcn_fence(__ATOMIC_ACQUIRE, "");
      xb_add(&bar[XB_XGEN(b.x)], 1u);
      asm volatile("s_waitcnt vmcnt(0)" ::: "memory");
    } else {
      XB_SPIN(xb_ld(&bar[XB_XGEN(b.x)]) == gen, bar);
      __builtin_amdgcn_fence(__ATOMIC_ACQUIRE, "");
      asm volatile("s_waitcnt vmcnt(0)" ::: "memory");
    }
  }
  __syncthreads();
}

struct MegaP {
  const float *x, *c, *ada_w, *ada_b, *norm1_g, *w_in, *conv_w, *conv_b, *cln_g, *cln_b, *moba_g, *dsa_g, *w_out, *norm2_g, *rgw, *rgb, *rew, *reb, *w1, *w3, *w2, *final_g;
  float* out; char* ws;
};
constexpr int LDS_BST = 139264;
constexpr int MEGA_LDS = LDS_BST + 16;
constexpr int CW_BAR = 1024;
#ifndef PROBE
#define PROBE 0
#endif
#define NREP(k) ((PROBE == (k)) ? 2 : 1)

__global__ void __launch_bounds__(NTHR) mega(MegaP p) {
  extern __shared__ __attribute__((aligned(16))) char lds[];
  cg::grid_group grid = cg::this_grid();
  char* ws = p.ws;
  unsigned* ctl = (unsigned*)(ws + WS_CTL);
  float* mod = (float*)(ws + WS_MOD);
  float* kmean = (float*)(ws + WS_KMEAN);
  float* gate = (float*)(ws + WS_GATE);
  float* logits = (float*)(ws + WS_LOGIT);
  unsigned* list = (unsigned*)(ws + WS_LIST);
  bf16_t* winT = (bf16_t*)(ws + WS_WINT);
  bf16_t* woutT = (bf16_t*)(ws + WS_WOUTT);
  bf16_t* rt = (bf16_t*)(ws + WS_RT);
  bf16_t* w13T = (bf16_t*)(ws + WS_W13T);
  bf16_t* w2T = (bf16_t*)(ws + WS_W2T);
  bf16_t* hb = (bf16_t*)(ws + WS_HB);
  uint2* bmt = (uint2*)(ws + WS_BMT);
  bf16_t* proj = (bf16_t*)(ws + WS_PROJ);
  bf16_t* act = (bf16_t*)(ws + WS_ACT);
  bf16_t* ys = (bf16_t*)(ws + WS_YS);
  bf16_t* part_o = (bf16_t*)(ws + WS_PARTO);
  float2* part_ml = (float2*)(ws + WS_PARTML);
  unsigned* mlist = (unsigned*)(ws + WS_MLIST);
  float* out = p.out;
  const int nblk = gridDim.x, bid = blockIdx.x;
  volatile LAS unsigned* bst = (volatile LAS unsigned*)(LAS char*)(lds + LDS_BST);
  if (threadIdx.x < 2) bst[threadIdx.x] = 0u;
  __syncthreads();
  const XcdBarrier xb = xcd_barrier_post(ctl + CW_BAR, bst);
#define GSYNC() xcd_barrier(xb)
  grid.sync();

  {
    const int mb = nblk - 1 - bid;
    mod_units(lds, mb, nblk, p.c, p.ada_w, p.ada_b, mod);
    prep_small_units(lds, bid, nblk, p.w_in, p.w_out, p.rgw, p.rew, winT, woutT, rt);
  }
  GSYNC();
  rmsmod_phase(p.x, p.norm1_g, mod + 0, mod + 1024, hb);
  GSYNC();

  for (int l = 0; l < 2; ++l) {
    char* wsl = p.ws; asm volatile("" : "+s"(wsl));
    unsigned* ctl = (unsigned*)(wsl + WS_CTL);
    float* mod = (float*)(wsl + WS_MOD);
    float* kmean = (float*)(wsl + WS_KMEAN);
    float* gate = (float*)(wsl + WS_GATE);
    float* logits = (float*)(wsl + WS_LOGIT);
    unsigned* list = (unsigned*)(wsl + WS_LIST);
    bf16_t* winT = (bf16_t*)(wsl + WS_WINT);
    bf16_t* woutT = (bf16_t*)(wsl + WS_WOUTT);
    bf16_t* rt = (bf16_t*)(wsl + WS_RT);
    bf16_t* w13T = (bf16_t*)(wsl + WS_W13T);
    bf16_t* w2T = (bf16_t*)(wsl + WS_W2T);
    bf16_t* hb = (bf16_t*)(wsl + WS_HB);
    uint2* bmt = (uint2*)(wsl + WS_BMT);
    bf16_t* proj = (bf16_t*)(wsl + WS_PROJ);
    bf16_t* act = (bf16_t*)(wsl + WS_ACT);
    bf16_t* ys = (bf16_t*)(wsl + WS_YS);
    bf16_t* part_o = (bf16_t*)(wsl + WS_PARTO);
    float2* part_ml = (float2*)(wsl + WS_PARTML);
    unsigned* mlist = (unsigned*)(wsl + WS_MLIST);
    const float* modl = mod + (size_t)l * 4 * 6144;
    if (PROBE == 13) { GemmP P{}; P.A = hb; P.Bt = winT; P.lda = 1024; P.K = 1024; P.Obf = proj; P.ldo = PLD; gemm_phase<GM_INPROJ, 8, 1>(lds, P, T / 256, 14); GSYNC(); }
    if (PROBE == 14) { GemmP P{}; P.A = hb; P.Bt = winT; P.lda = 1024; P.K = 1024; P.Obf = proj; P.ldo = PLD; gemm_phase<GM_INPROJ, 8, 2>(lds, P, T / 256, 14); GSYNC(); }
    for (int rep = 0; rep < NREP(1); ++rep) {
      { GemmP P{}; P.A = hb; P.Bt = winT; P.lda = 1024; P.K = 1024; P.Obf = proj; P.ldo = PLD; gemm_phase<GM_INPROJ, 8>(lds, P, T / 256, 14); }
      GSYNC();
    }
    for (int u = bid; u < NB * 32; u += nblk) kmean_unit(lds, u, proj, kmean);
    GSYNC();
    unsigned* mcnt = ctl + CW_MC + l * 768;
    if (PROBE >= 10 && PROBE <= 12) {
      for (int u = bid; u < NB * 512; u += nblk) dsa_select_unit<(PROBE >= 10 && PROBE <= 12) ? PROBE - 9 : 1>(lds, proj, bmt, u & 3, 511 - (u >> 2));
      GSYNC();
    }
    for (int rep = 0; rep < NREP(2); ++rep) {
      for (int u = bid; u < NB * 512 + T / 64; u += nblk) {
        if (u < NB * 512) dsa_select_unit<0>(lds, proj, bmt, u & 3, 511 - (u >> 2));
        else if (rep == 0) gate_unit(lds, u - NB * 512, proj, kmean, mcnt, mlist);
      }
      GSYNC();
    }
    if (PROBE == 3) {
      attn_queue_phase(lds, proj, hb, bmt, part_o, part_ml, mcnt, mlist, ctl + CW_Q + 2 + l, p.w1 + (size_t)l * 32 * 1024 * 512, p.w3 + (size_t)l * 32 * 1024 * 512, p.w2 + (size_t)l * 32 * 512 * 1024, w13T, w2T,
                     p.conv_w + (size_t)l * 31 * 256, p.conv_b + l * 256, p.cln_g + l * 256, p.cln_b + l * 256);
      GSYNC();
    }
    attn_queue_phase(lds, proj, hb, bmt, part_o, part_ml, mcnt, mlist, ctl + CW_Q + l, p.w1 + (size_t)l * 32 * 1024 * 512, p.w3 + (size_t)l * 32 * 1024 * 512, p.w2 + (size_t)l * 32 * 512 * 1024, w13T, w2T,
                     p.conv_w + (size_t)l * 31 * 256, p.conv_b + l * 256, p.cln_g + l * 256, p.cln_b + l * 256);
    GSYNC();
    mixfin_phase(hb, p.moba_g + l * 384, p.dsa_g + l * 384, part_o, part_ml);
    GSYNC();
    { GemmP P{}; P.A = hb; P.Bt = woutT; P.lda = 1024; P.K = 1024; P.xin = (l == 0) ? p.x : out; P.xout = out; P.gvec = modl + 2048; gemm_phase<GM_OUTPROJ, 8>(lds, P, T / 256, 4); }
    GSYNC();
    for (int rep = 0; rep < NREP(4); ++rep) {
      rmsmod_phase(out, p.norm2_g + l * 1024, modl + 3072, modl + 4096, hb);
      GSYNC();
    }
    for (int rep = 0; rep < NREP(5); ++rep) {
      { GemmP P{}; P.A = hb; P.Bt = rt; P.lda = 1024; P.K = 1024; P.logits = logits; gemm_phase<GM_ROUTER, 4>(lds, P, T / 256, 1); }
      GSYNC();
    }
    int* cntl = (int*)(ctl + CW_CNT + l * 32);
    route_phase(lds, logits, p.rgb + l * 4, p.reb + l * 32, list, cntl, gate);
    GSYNC();
    for (int rep = 0; rep < NREP(6); ++rep) {
      { GemmP P{}; P.A = hb; P.Bt = w13T; P.lda = 1024; P.K = 1024; P.Obf = act; P.list = list; P.cnt = cntl; P.gate = gate; gemm_phase<GM_MOE1, 8>(lds, P, 0, 0); }
      GSYNC();
    }
    for (int rep = 0; rep < NREP(7); ++rep) {
      { GemmP P{}; P.A = act; P.Bt = w2T; P.lda = 512; P.K = 512; P.Obf = ys; P.list = list; P.cnt = cntl; P.gate = gate; gemm_phase<GM_MOE2, 8>(lds, P, 0, 0); }
      GSYNC();
    }
    for (int rep = 0; rep < NREP(9) - 1; ++rep) { GSYNC(); GSYNC(); GSYNC(); GSYNC(); GSYNC(); GSYNC(); GSYNC(); GSYNC(); GSYNC(); GSYNC(); }
    if (l == 0) {
      const float* mod1 = mod + (size_t)4 * 6144;
      combine_phase(out, ys, modl + 5120, 0, p.norm1_g + 1024, mod1 + 0, mod1 + 1024, hb);
      prep_small_units(lds, bid, nblk, p.w_in + (size_t)1024 * NIN, p.w_out + (size_t)1024 * 1024, p.rgw + 4096, p.rew + 32768, winT, woutT, rt);
      GSYNC();
    } else {
      combine_phase(out, ys, modl + 5120, 1, p.final_g, nullptr, nullptr, nullptr);
    }
  }
}

extern "C" void kernel_launch(void* const* d_in, const int* in_sizes, int n_in, void* d_out, int out_size, void* d_ws, size_t ws_size, hipStream_t stream) {
  if (ws_size < WS_END) return;
  MegaP p{};
  p.x = (const float*)d_in[0]; p.c = (const float*)d_in[1]; p.ada_w = (const float*)d_in[2]; p.ada_b = (const float*)d_in[3]; p.norm1_g = (const float*)d_in[4];
  p.w_in = (const float*)d_in[5]; p.conv_w = (const float*)d_in[6]; p.conv_b = (const float*)d_in[7]; p.cln_g = (const float*)d_in[8]; p.cln_b = (const float*)d_in[9];
  p.moba_g = (const float*)d_in[10]; p.dsa_g = (const float*)d_in[11]; p.w_out = (const float*)d_in[12]; p.norm2_g = (const float*)d_in[13]; p.rgw = (const float*)d_in[14];
  p.rgb = (const float*)d_in[15]; p.rew = (const float*)d_in[16]; p.reb = (const float*)d_in[17]; p.w1 = (const float*)d_in[18]; p.w3 = (const float*)d_in[19];
  p.w2 = (const float*)d_in[20]; p.final_g = (const float*)d_in[21];
  p.out = (float*)d_out; p.ws = (char*)d_ws;
  static int grid_blocks = 0;
  if (!grid_blocks) {
    int dev = 0, cus = 0, per_cu = 0;
    (void)hipGetDevice(&dev);
    (void)hipDeviceGetAttribute(&cus, hipDeviceAttributeMultiprocessorCount, dev);
    (void)hipFuncSetAttribute((const void*)mega, hipFuncAttributeMaxDynamicSharedMemorySize, MEGA_LDS);
    (void)hipOccupancyMaxActiveBlocksPerMultiprocessor(&per_cu, (const void*)mega, NTHR, MEGA_LDS);
    if (per_cu < 1) per_cu = 1;
    if (per_cu > 1) per_cu = 1;
    grid_blocks = cus * per_cu;
  }
  (void)hipMemsetAsync((char*)d_ws + WS_CTL, 0, 32768, stream);
  void* args[] = {&p};
  (void)hipLaunchCooperativeKernel((const void*)mega, dim3(grid_blocks), dim3(NTHR), args, MEGA_LDS, stream);
}
```

```cpp
#include <hip/hip_runtime.h>
#include <hip/hip_cooperative_groups.h>
namespace cg = cooperative_groups;
#include <stdint.h>

#define DI __device__ __forceinline__
typedef unsigned short bf16_t;
typedef short bf16x8 __attribute__((ext_vector_type(8)));
typedef short s16x4 __attribute__((ext_vector_type(4)));
typedef float f32x4 __attribute__((ext_vector_type(4)));
typedef float f32x16 __attribute__((ext_vector_type(16)));
typedef unsigned u32x4 __attribute__((ext_vector_type(4)));
typedef unsigned u32x2 __attribute__((ext_vector_type(2)));
typedef float f32x2_t __attribute__((ext_vector_type(2)));
typedef __bf16 bf16x2_t __attribute__((ext_vector_type(2)));
#define LAS __attribute__((address_space(3)))

constexpr int NB = 4, S = 8192, T = NB * S, D = 1024;
constexpr int PLD = 3456;
constexpr int C_QM = 0, C_KM = 384, C_VM = 768, C_CA = 1152, C_CG = 1408, C_QD = 1664, C_KD = 2048, C_VD = 2432, C_QI = 2816, C_KI = 3328, C_WI = 3392;
constexpr int NIN = 3400;
constexpr float EPS = 1e-6f;
constexpr int NTHR = 512;

constexpr size_t MiB = 1u << 20;
constexpr size_t WS_CTL = 0;
constexpr size_t WS_MOD = 1 * MiB;
constexpr size_t WS_KMEAN = WS_MOD + 256 * 1024;
constexpr size_t WS_SELM = WS_KMEAN + 256 * 1024;
constexpr size_t WS_GATE = WS_SELM + 1 * MiB;
constexpr size_t WS_LOGIT = WS_GATE + 512 * 1024;
constexpr size_t WS_LIST = WS_LOGIT + 5 * MiB;
constexpr size_t WS_WINT = WS_LIST + 8 * MiB;
constexpr size_t WS_WOUTT = WS_WINT + 7 * MiB;
constexpr size_t WS_RT = WS_WOUTT + 2 * MiB;
constexpr size_t WS_W13T = WS_RT + 1 * MiB;
constexpr size_t WS_W2T = WS_W13T + 64 * MiB;
constexpr size_t WS_HB = WS_W2T + 32 * MiB;
constexpr size_t WS_BMT = WS_HB + 64 * MiB;
constexpr size_t WS_PROJ = WS_BMT + 32 * MiB;
constexpr size_t WS_ACT = WS_PROJ;
constexpr size_t WS_YS = WS_PROJ + 64 * MiB;
constexpr size_t WS_PARTO = WS_PROJ + 216 * MiB;
constexpr size_t WS_PARTML = WS_PARTO + 96 * MiB;
constexpr size_t WS_MLIST = WS_PARTML + 6 * MiB;
constexpr size_t WS_END = WS_MLIST + 24 * MiB;
constexpr int CW_CNT = 0;
constexpr int CW_Q = 64;
constexpr int CW_MC = 5120;

DI int otid() { int t = threadIdx.x; asm volatile("" : "+v"(t)); return t; }
DI void st_wt32(unsigned* p, unsigned v) { __hip_atomic_store(p, v, __ATOMIC_RELAXED, __HIP_MEMORY_SCOPE_AGENT); }
DI void st_wt64(unsigned long long* p, unsigned long long v) { __hip_atomic_store(p, v, __ATOMIC_RELAXED, __HIP_MEMORY_SCOPE_AGENT); }
DI float bf2f(bf16_t b) { return __uint_as_float(((unsigned)b) << 16); }
DI float bflo(unsigned u) { return __uint_as_float(u << 16); }
DI float bfhi(unsigned u) { return __uint_as_float(u & 0xffff0000u); }
DI unsigned cvtpk(float lo, float hi) { f32x2_t v = {lo, hi}; bf16x2_t b = __builtin_convertvector(v, bf16x2_t); return __builtin_bit_cast(unsigned, b); }
DI float fexp2(float x) { return __builtin_amdgcn_exp2f(x); }
DI float frcp(float x) { return __builtin_amdgcn_rcpf(x); }
DI float silu_f(float x) { return x * frcp(1.f + fexp2(x * -1.4426950408889634f)); }
DI float wave_sum(float v) {
#pragma unroll
  for (int o = 32; o >= 1; o >>= 1) v += __shfl_xor(v, o);
  return v;
}
#define DPP_STEP(OPF, v, ident, ctrl, rmask) v = OPF(v, (unsigned)__builtin_amdgcn_update_dpp((int)(ident), (int)(v), ctrl, rmask, 0xf, false))
DI unsigned opadd(unsigned a, unsigned b) { return a + b; }
DI unsigned opmin(unsigned a, unsigned b) { return min(a, b); }
DI unsigned opmax(unsigned a, unsigned b) { return max(a, b); }
DI unsigned scan_add(unsigned v) {
  DPP_STEP(opadd, v, 0u, 0x111, 0xf); DPP_STEP(opadd, v, 0u, 0x112, 0xf); DPP_STEP(opadd, v, 0u, 0x114, 0xf); DPP_STEP(opadd, v, 0u, 0x118, 0xf);
  DPP_STEP(opadd, v, 0u, 0x142, 0xa); DPP_STEP(opadd, v, 0u, 0x143, 0xc); return v;
}
DI unsigned red_add(unsigned v) { return (unsigned)__builtin_amdgcn_readlane((int)scan_add(v), 63); }
DI unsigned red_min(unsigned v) {
  DPP_STEP(opmin, v, 0xffffffffu, 0x111, 0xf); DPP_STEP(opmin, v, 0xffffffffu, 0x112, 0xf); DPP_STEP(opmin, v, 0xffffffffu, 0x114, 0xf); DPP_STEP(opmin, v, 0xffffffffu, 0x118, 0xf);
  DPP_STEP(opmin, v, 0xffffffffu, 0x142, 0xa); DPP_STEP(opmin, v, 0xffffffffu, 0x143, 0xc); return (unsigned)__builtin_amdgcn_readlane((int)v, 63);
}
DI unsigned red_max(unsigned v) {
  DPP_STEP(opmax, v, 0u, 0x111, 0xf); DPP_STEP(opmax, v, 0u, 0x112, 0xf); DPP_STEP(opmax, v, 0u, 0x114, 0xf); DPP_STEP(opmax, v, 0u, 0x118, 0xf);
  DPP_STEP(opmax, v, 0u, 0x142, 0xa); DPP_STEP(opmax, v, 0u, 0x143, 0xc); return (unsigned)__builtin_amdgcn_readlane((int)v, 63);
}
#define MFMA16(a, b, c) __builtin_amdgcn_mfma_f32_16x16x32_bf16((a), (b), (c), 0, 0, 0)
#define MFMA32(a, b, c) __builtin_amdgcn_mfma_f32_32x32x16_bf16((a), (b), (c), 0, 0, 0)

DI void mod_units(char* lds, int ubase, int nblk, const float* __restrict__ c, const float* __restrict__ ada_w, const float* __restrict__ ada_b, float* __restrict__ mod) {
  float (*sc)[1024] = (float (*)[1024])lds;
  float (*red)[4][64] = (float (*)[4][64])(lds + 16384);
  const int tid = otid();
  bool loaded = false;
  for (int u = ubase; u < 2 * 96; u += nblk) {
    if (!loaded) { for (int i = tid; i < 4096; i += NTHR) sc[i >> 10][i & 1023] = silu_f(c[i]); __syncthreads(); loaded = true; }
    const int l = u / 96, n = (u % 96) * 64 + (tid & 63), ks = tid >> 6;
    const float* w = ada_w + (size_t)l * 1024 * 6144 + n;
    float a0 = 0.f, a1 = 0.f, a2 = 0.f, a3 = 0.f;
#pragma unroll 8
    for (int k = ks * 128; k < ks * 128 + 128; ++k) {
      const float wv = w[(size_t)k * 6144];
      a0 += sc[0][k] * wv; a1 += sc[1][k] * wv; a2 += sc[2][k] * wv; a3 += sc[3][k] * wv;
    }
    red[ks][0][tid & 63] = a0; red[ks][1][tid & 63] = a1; red[ks][2][tid & 63] = a2; red[ks][3][tid & 63] = a3;
    __syncthreads();
    if (tid < 256) {
      const int b = tid >> 6, nn = tid & 63;
      float s = 0.f;
#pragma unroll
      for (int k = 0; k < 8; ++k) s += red[k][b][nn];
      const int ncol = (u % 96) * 64 + nn;
      mod[((size_t)l * 4 + b) * 6144 + ncol] = s + ada_b[(size_t)l * 6144 + ncol];
    }
    __syncthreads();
  }
}

struct TJob { const float* src; bf16_t* dst; int R, C, Cpad, grp, stride, off; };

DI void transpose_tile_wave(const TJob& J, int tr, int tc, float (*tile)[65], int lane) {
#pragma unroll 1
  for (int hf = 0; hf < 2; ++hf) {
    float4 v[8];
#pragma unroll
    for (int p = 0; p < 8; ++p) {
      const int r = (lane >> 4) + (hf * 8 + p) * 4, c4 = (lane & 15) * 4;
      const int gr = tr * 64 + r, gc = tc * 64 + c4;
      v[p] = make_float4(0.f, 0.f, 0.f, 0.f);
      if (gc + 3 < J.C) v[p] = *(const float4*)(J.src + (size_t)gr * J.C + gc);
      else { float t4[4] = {0.f, 0.f, 0.f, 0.f}; for (int q = 0; q < 4; ++q) if (gc + q < J.C) t4[q] = J.src[(size_t)gr * J.C + gc + q]; v[p] = make_float4(t4[0], t4[1], t4[2], t4[3]); }
    }
#pragma unroll
    for (int p = 0; p < 8; ++p) {
      const int r = (lane >> 4) + (hf * 8 + p) * 4, c4 = (lane & 15) * 4;
      tile[r][c4 + 0] = v[p].x; tile[r][c4 + 1] = v[p].y; tile[r][c4 + 2] = v[p].z; tile[r][c4 + 3] = v[p].w;
    }
  }
  __builtin_amdgcn_fence(__ATOMIC_RELEASE, "wavefront");
  __builtin_amdgcn_wave_barrier();
#pragma unroll
  for (int p = 0; p < 8; ++p) {
    const int n = (lane >> 3) + p * 8, kc = lane & 7;
    const int gc = tc * 64 + n;
    if (gc < J.Cpad) {
      const int drow = (gc / J.grp) * J.stride + J.off + (gc % J.grp);
      u32x4 o;
      o.x = cvtpk(tile[kc * 8 + 0][n], tile[kc * 8 + 1][n]); o.y = cvtpk(tile[kc * 8 + 2][n], tile[kc * 8 + 3][n]);
      o.z = cvtpk(tile[kc * 8 + 4][n], tile[kc * 8 + 5][n]); o.w = cvtpk(tile[kc * 8 + 6][n], tile[kc * 8 + 7][n]);
      *(u32x4*)(J.dst + (size_t)drow * J.R + tr * 64 + kc * 8) = o;
    }
  }
  __builtin_amdgcn_fence(__ATOMIC_RELEASE, "wavefront");
  __builtin_amdgcn_wave_barrier();
}

constexpr int WINT_ROWS = 3584;
constexpr int PREP_UNITS = 896 + 256 + 32 * 384;
DI void prep_unit(int u, const float* w_in, const float* w_out, const float* w1, const float* w3, const float* w2,
                  bf16_t* winT, bf16_t* woutT, bf16_t* w13T, bf16_t* w2T, float (*tile)[65], int lane) {
  TJob J; int tr, tc;
  if (u < 896) { J = TJob{w_in, winT, 1024, NIN, WINT_ROWS, 1 << 30, 0, 0}; tr = u % 16; tc = u / 16; }
  else if (u < 1152) { u -= 896; J = TJob{w_out, woutT, 1024, 1024, 1024, 1 << 30, 0, 0}; tr = u % 16; tc = u / 16; }
  else {
    u -= 1152; const int e = u / 384; int r = u % 384;
    if (r < 128) { J = TJob{w1 + (size_t)e * 1024 * 512, w13T + (size_t)e * 1024 * 1024, 1024, 512, 512, 32, 64, 0}; tr = r % 16; tc = r / 16; }
    else if (r < 256) { r -= 128; J = TJob{w3 + (size_t)e * 1024 * 512, w13T + (size_t)e * 1024 * 1024, 1024, 512, 512, 32, 64, 32}; tr = r % 16; tc = r / 16; }
    else { r -= 256; J = TJob{w2 + (size_t)e * 512 * 1024, w2T + (size_t)e * 1024 * 512, 512, 1024, 1024, 1 << 30, 0, 0}; tr = r % 8; tc = r / 8; }
  }
  transpose_tile_wave(J, tr, tc, tile, lane);
}

DI void prep_rt_unit(int u, const float* __restrict__ rgw, const float* __restrict__ rew, bf16_t* __restrict__ rt) {
#pragma unroll
  for (int q = 0; q < 4; ++q) {
    const int i = u * 2048 + q * NTHR + threadIdx.x;
    const int n = i >> 10, k = i & 1023;
    float v = 0.f;
    if (n < 4) v = rgw[k * 4 + n]; else if (n < 36) v = rew[k * 32 + (n - 4)];
    rt[i] = (bf16_t)(cvtpk(v, 0.f) & 0xffffu);
  }
}
constexpr int PREP_SMALL = 896 + 256;
constexpr int PREP_EXP_ITEMS = (32 * 384) / 8;
DI void prep_small_units(char* lds, int ubase, int nblk, const float* w_in, const float* w_out, const float* rgw, const float* rew, bf16_t* winT, bf16_t* woutT, bf16_t* rt) {
  const int tid = otid(), lane = tid & 63, wid = tid >> 6;
  float (*tile)[65] = (float (*)[65])(lds + wid * 16640);
  for (int u = ubase * 8 + wid; u < PREP_SMALL; u += nblk * 8) prep_unit(u, w_in, w_out, nullptr, nullptr, nullptr, winT, woutT, nullptr, nullptr, tile, lane);
  for (int u = ubase; u < 64; u += nblk) prep_rt_unit(u, rgw, rew, rt);
  __syncthreads();
}
DI void prep_exp_item(char* lds, int item, const float* w1, const float* w3, const float* w2, bf16_t* w13T, bf16_t* w2T) {
  const int tid = otid(), lane = tid & 63, wid = tid >> 6;
  float (*tile)[65] = (float (*)[65])(lds + wid * 16640);
  prep_unit(PREP_SMALL + item * 8 + wid, nullptr, nullptr, w1, w3, w2, nullptr, nullptr, w13T, w2T, tile, lane);
  __syncthreads();
}

DI void wave_sum4(float (&v)[4]) {
#pragma unroll
  for (int o = 32; o >= 1; o >>= 1) {
    float t[4];
#pragma unroll
    for (int r = 0; r < 4; ++r) t[r] = __shfl_xor(v[r], o);
#pragma unroll
    for (int r = 0; r < 4; ++r) v[r] += t[r];
  }
}
DI void rmsmod_phase(const float* __restrict__ x, const float* __restrict__ g, const float* __restrict__ mod_sh, const float* __restrict__ mod_sc, bf16_t* __restrict__ h) {
  const int tid_ = otid(); const int lane = tid_ & 63, wid = tid_ >> 6;
  for (int row0 = (blockIdx.x * 8 + wid) * 4; row0 < T; row0 += gridDim.x * 32) {
    const int b = row0 >> 13;
    float4 v[4][4]; float ss[4];
#pragma unroll
    for (int r = 0; r < 4; ++r) {
      const float* xr = x + (size_t)(row0 + r) * D;
      ss[r] = 0.f;
#pragma unroll
      for (int i = 0; i < 4; ++i) { v[r][i] = *(const float4*)(xr + i * 256 + lane * 4); }
    }
#pragma unroll
    for (int r = 0; r < 4; ++r)
#pragma unroll
      for (int i = 0; i < 4; ++i) ss[r] += v[r][i].x * v[r][i].x + v[r][i].y * v[r][i].y + v[r][i].z * v[r][i].z + v[r][i].w * v[r][i].w;
    wave_sum4(ss);
#pragma unroll
    for (int i = 0; i < 4; ++i) {
      const int col = i * 256 + lane * 4;
      const float4 gg = *(const float4*)(g + col), sc = *(const float4*)(mod_sc + (size_t)b * 6144 + col), sh = *(const float4*)(mod_sh + (size_t)b * 6144 + col);
#pragma unroll
      for (int r = 0; r < 4; ++r) {
        const float rstd = rsqrtf(ss[r] * (1.f / 1024.f) + EPS);
        const float o0 = v[r][i].x * rstd * gg.x * (1.f + sc.x) + sh.x, o1 = v[r][i].y * rstd * gg.y * (1.f + sc.y) + sh.y;
        const float o2 = v[r][i].z * rstd * gg.z * (1.f + sc.z) + sh.z, o3 = v[r][i].w * rstd * gg.w * (1.f + sc.w) + sh.w;
        u32x2 o; o.x = cvtpk(o0, o1); o.y = cvtpk(o2, o3);
        *(u32x2*)(h + (size_t)(row0 + r) * D + col) = o;
      }
    }
  }
}

enum { GM_INPROJ = 0, GM_OUTPROJ = 1, GM_ROUTER = 2, GM_MOE1 = 3, GM_MOE2 = 4 };
struct GemmP {
  const bf16_t* A; const bf16_t* Bt; int lda; int K;
  bf16_t* Obf; int ldo;
  const float* xin; float* xout; const float* gvec;
  float* logits;
  const unsigned* list; const int* cnt; const float* gate;
};
constexpr int GEMM_LDS = 98304 + 1024;

template <int MODE, int NJ, int VAR = 0>
DI void gemm_tile(char* lds, const GemmP& P, const bf16_t* __restrict__ Bt, int m0, int n0, int nvalid, const unsigned* lst, int ebase) {
  constexpr int BN = 32 * NJ, STG = 32768 + BN * 128, NBP = BN / 64;
  const int tid = otid(), lane = tid & 63, wid = __builtin_amdgcn_readfirstlane(tid >> 6), fr = lane & 15, fq = lane >> 4;
  const int wm = wid >> 1, wn = wid & 1;
  const int K = P.K;
  int* ridx = (int*)(lds + 2 * STG);
  if (MODE == GM_MOE1) {
    if (tid < 256) { const int r = tid < nvalid ? tid : 0; ridx[tid] = (int)(lst[r] >> 1); }
    __syncthreads();
  }
  const int prow = lane >> 3, pkc = (lane & 7) ^ (lane >> 3);
  const bf16_t* ap[4];
#pragma unroll
  for (int i = 0; i < 4; ++i) {
    const int row = 8 * (wid + 8 * i) + prow;
    size_t grow;
    if (MODE == GM_MOE1) grow = (size_t)ridx[row];
    else if (MODE == GM_MOE2) grow = (size_t)(ebase + (row < nvalid ? row : 0));
    else grow = (size_t)(m0 + row);
    ap[i] = P.A + grow * P.lda + pkc * 8;
  }
  const bf16_t* bp[NBP];
#pragma unroll
  for (int i = 0; i < NBP; ++i) {
    const int row = 8 * (wid + 8 * i) + prow;
    bp[i] = Bt + (size_t)(n0 + row) * K + pkc * 8;
  }
  f32x4 acc[4][NJ];
#pragma unroll
  for (int i = 0; i < 4; ++i)
#pragma unroll
    for (int j = 0; j < NJ; ++j) acc[i][j] = (f32x4){0.f, 0.f, 0.f, 0.f};
  LAS char* lds3 = (LAS char*)lds;
#define GEMM_STAGE(st, kt_) do { \
    _Pragma("unroll") for (int i = 0; i < 4; ++i) __builtin_amdgcn_global_load_lds((const unsigned*)(ap[i] + (kt_) * 64), (LAS unsigned*)(lds3 + (st) * STG + (wid + 8 * i) * 1024), 16, 0, 0); \
    _Pragma("unroll") for (int i = 0; i < NBP; ++i) __builtin_amdgcn_global_load_lds((const unsigned*)(bp[i] + (kt_) * 64), (LAS unsigned*)(lds3 + (st) * STG + 32768 + (wid + 8 * i) * 1024), 16, 0, 0); \
  } while (0)
#define GEMM_PIECE(st, kt_, q) do { \
    if ((q) < 4) __builtin_amdgcn_global_load_lds((const unsigned*)(ap[(q)] + (kt_) * 64), (LAS unsigned*)(lds3 + (st) * STG + (wid + 8 * (q)) * 1024), 16, 0, 0); \
    else if ((q) - 4 < NBP) __builtin_amdgcn_global_load_lds((const unsigned*)(bp[((q) - 4) < NBP ? (q) - 4 : 0] + (kt_) * 64), (LAS unsigned*)(lds3 + (st) * STG + 32768 + (wid + 8 * ((q) - 4)) * 1024), 16, 0, 0); \
  } while (0)
#define GEMM_LDA(i, base, ko) a[i] = *(const bf16x8*)((base) + (arow + (i) * 16) * 128 + (ko))
#define GEMM_LDB(j, base, ko) b[j] = *(const bf16x8*)((base) + 32768 + (brow + (j) * 16) * 128 + (ko))
#define GEMM_SB __builtin_amdgcn_sched_barrier(0)
#define GEMM_BLOCK(RL, DM, base, ko, st, kt_) do { \
    _Pragma("unroll") for (int j = 0; j < NJ; ++j) acc[0][j] = MFMA16(b[j], a[0], acc[0][j]); \
    if (RL) GEMM_LDA(0, base, ko); \
    if (DM) { GEMM_PIECE(st, kt_, 0); GEMM_PIECE(st, kt_, 1); } \
    GEMM_SB; \
    _Pragma("unroll") for (int j = 0; j < NJ; ++j) acc[1][j] = MFMA16(b[j], a[1], acc[1][j]); \
    if (RL) GEMM_LDA(1, base, ko); \
    if (DM) { GEMM_PIECE(st, kt_, 2); GEMM_PIECE(st, kt_, 3); } \
    GEMM_SB; \
    _Pragma("unroll") for (int j = 0; j < NJ; ++j) { \
      acc[2][j] = MFMA16(b[j], a[2], acc[2][j]); \
      acc[3][j] = MFMA16(b[j], a[3], acc[3][j]); \
      if (RL) GEMM_LDB(j, base, ko); \
      if (DM && (j & 1) == 0) GEMM_PIECE(st, kt_, 4 + (j >> 1)); \
      GEMM_SB; \
    } \
    if (RL) { GEMM_LDA(2, base, ko); GEMM_LDA(3, base, ko); } \
    GEMM_SB; \
  } while (0)
  const int nk = K >> 6;
  const int arow = wm * 64 + fr, brow = wn * (BN / 2) + fr, sw = fr & 7;
  const int ko0 = (fq ^ sw) << 4, ko1 = ((4 + fq) ^ sw) << 4;
  bf16x8 a[4], b[NJ];
  GEMM_STAGE(0, 0);
  asm volatile("s_waitcnt vmcnt(0)" ::: "memory");
  __syncthreads();
  if (VAR != 1) GEMM_STAGE(1, 1);
#pragma unroll
  for (int i = 0; i < 4; ++i) GEMM_LDA(i, lds, ko0);
#pragma unroll
  for (int j = 0; j < NJ; ++j) GEMM_LDB(j, lds, ko0);
  for (int kt = 0; kt < nk; ++kt) {
    const int cur = kt & 1;
    const char* sb = lds + cur * STG;
    const char* sn = lds + (cur ^ 1) * STG;
    GEMM_BLOCK(true, false, sb, ko1, 0, 0);
    asm volatile("s_waitcnt vmcnt(0) lgkmcnt(0)" ::: "memory");
    __syncthreads();
    const int kn = min(kt + 2, nk - 1);
    GEMM_BLOCK(true, VAR != 1, sn, ko0, cur, kn);
  }
  asm volatile("s_waitcnt vmcnt(0)" ::: "memory");
#undef GEMM_BLOCK
#undef GEMM_SB
#undef GEMM_LDA
#undef GEMM_LDB
#undef GEMM_PIECE
#undef GEMM_STAGE
  const int nw0 = n0 + wn * (BN / 2);
#pragma unroll
  for (int i = 0; i < 4; ++i) {
    const int ml = wm * 64 + i * 16 + fr;
    const int m = m0 + ml;
    if (MODE == GM_INPROJ) {
#pragma unroll
      for (int j = 0; j < NJ; ++j) {
        const int n = nw0 + j * 16 + fq * 4;
        if (n < P.ldo) {
          u32x2 o; o.x = cvtpk(acc[i][j][0], acc[i][j][1]); o.y = cvtpk(acc[i][j][2], acc[i][j][3]);
          *(u32x2*)(P.Obf + (size_t)m * P.ldo + n) = o;
        }
      }
    } else if (MODE == GM_OUTPROJ) {
      const int b = m >> 13;
#pragma unroll
      for (int j = 0; j < NJ; ++j) {
        const int n = nw0 + j * 16 + fq * 4;
        const float4 xi = *(const float4*)(P.xin + (size_t)m * D + n);
        const float4 gv = *(const float4*)(P.gvec + (size_t)b * 6144 + n);
        float4 o; o.x = xi.x + gv.x * acc[i][j][0]; o.y = xi.y + gv.y * acc[i][j][1]; o.z = xi.z + gv.z * acc[i][j][2]; o.w = xi.w + gv.w * acc[i][j][3];
        *(float4*)(P.xout + (size_t)m * D + n) = o;
      }
    } else if (MODE == GM_ROUTER) {
#pragma unroll
      for (int j = 0; j < NJ; ++j) {
        const int n = nw0 + j * 16 + fq * 4;
        if (n < 36) { float4 o; o.x = acc[i][j][0]; o.y = acc[i][j][1]; o.z = acc[i][j][2]; o.w = acc[i][j][3]; *(float4*)(P.logits + (size_t)m * 36 + n) = o; }
      }
    } else if (MODE == GM_MOE1) {
      if (ml < nvalid) {
#pragma unroll
        for (int jb2 = 0; jb2 < NJ / 4; ++jb2) {
          const int jb = (nw0 >> 6) + jb2;
#pragma unroll
          for (int j = 0; j < 2; ++j) {
            const int col = jb * 32 + j * 16 + fq * 4;
            float v[4];
#pragma unroll
            for (int q = 0; q < 4; ++q) v[q] = silu_f(acc[i][4 * jb2 + j][q]) * acc[i][4 * jb2 + j + 2][q];
            u32x2 o; o.x = cvtpk(v[0], v[1]); o.y = cvtpk(v[2], v[3]);
            *(u32x2*)(P.Obf + (size_t)(ebase + ml) * 512 + col) = o;
          }
        }
      }
    } else if (MODE == GM_MOE2) {
      if (ml < nvalid) {
        const unsigned slot = lst[ml];
        const float gt = P.gate[slot];
#pragma unroll
        for (int j = 0; j < NJ; ++j) {
          const int n = nw0 + j * 16 + fq * 4;
          u32x2 o; o.x = cvtpk(acc[i][j][0] * gt, acc[i][j][1] * gt); o.y = cvtpk(acc[i][j][2] * gt, acc[i][j][3] * gt);
          *(u32x2*)(P.Obf + (size_t)slot * 1024 + n) = o;
        }
      }
    }
  }
  __syncthreads();
}

template <int MODE, int NJ, int VAR = 0>
DI void gemm_phase(char* lds, const GemmP& P, int ntm, int ntn) {
  constexpr int BN = 32 * NJ;
  const int xcd = blockIdx.x & 7, bi = blockIdx.x >> 3, nbx = gridDim.x >> 3;
  const bool xo = (gridDim.x & 7) == 0;
  if (MODE == GM_MOE1 || MODE == GM_MOE2) {
    constexpr int NNT = 1024 / BN;
    if (xo) {
      int ce[4], tm[4], eb[4];
      {
        int acc_ = 0, q = 0;
#pragma unroll
        for (int k = 0; k < 4; ++k) {
          const int e = xcd + 8 * k;
          for (; q < e; ++q) acc_ += P.cnt[q];
          eb[k] = acc_; ce[k] = P.cnt[e]; tm[k] = (ce[k] + 255) >> 8;
        }
      }
      const int total = (tm[0] + tm[1] + tm[2] + tm[3]) * NNT;
      const int nfull = (total / nbx) * nbx;
      const int nhalf = (NJ == 8) ? 2 * (total - nfull) : 0;
      for (int it = bi; it < nfull + ((NJ == 8) ? nhalf : total - nfull); it += nbx) {
        const bool half = (NJ == 8) && it >= nfull;
        const int j = half ? nfull + ((it - nfull) >> 1) : it;
        int k = 0, r = j;
        if (r >= tm[0] * NNT) { r -= tm[0] * NNT; k = 1; if (r >= tm[1] * NNT) { r -= tm[1] * NNT; k = 2; if (r >= tm[2] * NNT) { r -= tm[2] * NNT; k = 3; } } }
        const int cek = k == 0 ? ce[0] : k == 1 ? ce[1] : k == 2 ? ce[2] : ce[3];
        const int ebk = k == 0 ? eb[0] : k == 1 ? eb[1] : k == 2 ? eb[2] : eb[3];
        const int e = xcd + 8 * k, mt = r / NNT, nt = r % NNT;
        const int nvalid = min(256, cek - mt * 256);
        const unsigned* lst = P.list + (size_t)e * 65536 + mt * 256;
        const bf16_t* Bt = P.Bt + (size_t)e * 1024 * P.K;
        if (half) gemm_tile<MODE, (NJ == 8) ? 4 : NJ, VAR>(lds, P, Bt, mt * 256, nt * BN + ((it - nfull) & 1) * (BN / 2), nvalid, lst, ebk + mt * 256);
        else gemm_tile<MODE, NJ, VAR>(lds, P, Bt, mt * 256, nt * BN, nvalid, lst, ebk + mt * 256);
      }
    } else {
      int total_mt = 0;
      for (int e = 0; e < 32; ++e) total_mt += (P.cnt[e] + 255) >> 8;
      const int total = total_mt * NNT;
      for (int u = blockIdx.x; u < total; u += gridDim.x) {
        int e = 0, rem = u, ebase = 0;
        for (;;) { const int c = P.cnt[e]; const int te = ((c + 255) >> 8) * NNT; if (rem < te) break; rem -= te; ebase += c; ++e; }
        const int ce = P.cnt[e], tme = (ce + 255) >> 8;
        const int nt = rem / tme, mt = rem % tme;
        const int nvalid = min(256, ce - mt * 256);
        const unsigned* lst = P.list + (size_t)e * 65536 + mt * 256;
        const bf16_t* Bt = P.Bt + (size_t)e * 1024 * P.K;
        gemm_tile<MODE, NJ, VAR>(lds, P, Bt, mt * 256, nt * BN, nvalid, lst, ebase + mt * 256);
      }
    }
  } else if (xo && (ntm & 7) == 0) {
    const int per = (ntm >> 3) * ntn;
    for (int j = bi; j < per; j += nbx) {
      const int mt = xcd + 8 * (j / ntn), nt = j % ntn;
      gemm_tile<MODE, NJ, VAR>(lds, P, P.Bt, mt * 256, nt * BN, 256, nullptr, 0);
    }
  } else {
    const int total = ntm * ntn;
    for (int u = blockIdx.x; u < total; u += gridDim.x) {
      const int nt = u / ntm, mt = u % ntm;
      gemm_tile<MODE, NJ, VAR>(lds, P, P.Bt, mt * 256, nt * BN, 256, nullptr, 0);
    }
  }
}

DI void kmean_unit(char* lds, int u, const bf16_t* __restrict__ proj, float* __restrict__ kmean) {
  float* red = (float*)lds;
  const int tid = otid();
  const int b = u >> 5, blk = u & 31;
  const int cc = tid % 48, rg = tid / 48;
  if (rg < 10) {
    const bf16_t* p = proj + (size_t)(b * S + blk * 256) * PLD + C_KM + cc * 8;
    float acc[8] = {0.f, 0.f, 0.f, 0.f, 0.f, 0.f, 0.f, 0.f};
#pragma unroll 13
    for (int r = rg; r < 256; r += 10) {
      const u32x4 v = *(const u32x4*)(p + (size_t)r * PLD);
      acc[0] += bflo(v.x); acc[1] += bfhi(v.x); acc[2] += bflo(v.y); acc[3] += bfhi(v.y);
      acc[4] += bflo(v.z); acc[5] += bfhi(v.z); acc[6] += bflo(v.w); acc[7] += bfhi(v.w);
    }
#pragma unroll
    for (int q = 0; q < 8; ++q) red[rg * 384 + cc * 8 + q] = acc[q];
  }
  __syncthreads();
  if (tid < 384) {
    float sm = 0.f;
#pragma unroll
    for (int g = 0; g < 10; ++g) sm += red[g * 384 + tid];
    kmean[((size_t)(b * 6 + tid / 64) * 32 + blk) * 64 + (tid & 63)] = sm * (1.f / 256.f);
  }
  __syncthreads();
}

constexpr int ATT_LDS = 32768;
constexpr float C2 = 0.125f * 1.4426950408889634f;
DI float max3f(float a, float b, float c) { return __builtin_fmaxf(__builtin_fmaxf(a, b), c); }
DI int crow(int r, int hi) { return (r & 3) + 8 * (r >> 2) + 4 * hi; }
typedef short v4i16_t __attribute__((ext_vector_type(4)));
DI s16x4 vtr(const LAS char* p) { return __builtin_bit_cast(s16x4, __builtin_amdgcn_ds_read_tr16_b64_v4i16((LAS v4i16_t*)p)); }

constexpr int ATT_ST = 65536;
struct AttState { float m, l; f32x16 o0, o1; };

template <int MODE>
DI void attn_stage(char* lds, int bufoff, const bf16_t* __restrict__ proj, int b, int h, int key0, int lane, int wid) {
  constexpr int KC = (MODE == 1) ? C_KD : C_KM, VC = (MODE == 1) ? C_VD : C_VM;
  LAS char* l3 = (LAS char*)lds + bufoff;
  const bf16_t* ks = proj + (size_t)(b * S + key0 + 8 * wid + (lane >> 3)) * PLD + KC + h * 64 + (((lane & 7) ^ (lane >> 3)) << 3);
  const bf16_t* vs = proj + (size_t)(b * S + key0 + 16 * (wid & 3) + (lane >> 2)) * PLD + VC + h * 64 + (wid >> 2) * 32 + ((lane & 3) << 3);
#pragma unroll
  for (int tt = 0; tt < 4; ++tt) {
    __builtin_amdgcn_global_load_lds((const unsigned*)(ks + (size_t)tt * 64 * PLD), (LAS unsigned*)(l3 + tt * 16384 + wid * 1024), 16, 0, 0);
    __builtin_amdgcn_global_load_lds((const unsigned*)(vs + (size_t)tt * 64 * PLD), (LAS unsigned*)(l3 + tt * 16384 + 8192 + (wid >> 2) * 4096 + (wid & 3) * 1024), 16, 0, 0);
  }
}

template <int MODE>
DI void attn_tile(char* lds, int tbuf, const bf16x8 (&qr)[4], AttState& st, uint2 w, int ktl, int qrel, int r32, int hi, int lane) {
  constexpr float THR = 8.f;
  const float NEGBIG = -3.0e38f;
  const char* kb = lds + tbuf;
  const int ksw = r32 & 7;
  f32x16 p0, p1;
  {
    f32x16 zz;
#pragma unroll
    for (int r = 0; r < 16; ++r) zz[r] = 0.f;
    const unsigned nmb = cvtpk(-st.m, 0.f);
    const bf16x8 kone = __builtin_bit_cast(bf16x8, (u32x4){hi ? 0u : 0x3F80u, 0u, 0u, 0u});
    const bf16x8 qm = __builtin_bit_cast(bf16x8, (u32x4){nmb, 0u, 0u, 0u});
    p0 = MFMA32(kone, qm, zz);
    p1 = MFMA32(kone, qm, zz);
  }
#pragma unroll
  for (int d0 = 0; d0 < 4; ++d0) {
    const int co = ((2 * d0 + hi) ^ ksw) << 4;
    const bf16x8 ka = *(const bf16x8*)(kb + r32 * 128 + co);
    const bf16x8 kc = *(const bf16x8*)(kb + (r32 + 32) * 128 + co);
    p0 = MFMA32(ka, qr[d0], p0);
    p1 = MFMA32(kc, qr[d0], p1);
  }
  if (MODE == 0) {
    const int kbase = ktl * 64 + 4 * hi;
#pragma unroll
    for (int r = 0; r < 16; ++r) {
      const int kv = kbase + (r & 3) + 8 * (r >> 2);
      if (kv > qrel) p0[r] = NEGBIG;
      if (kv + 32 > qrel) p1[r] = NEGBIG;
    }
  }
  float mxa = max3f(p0[0], p0[1], p1[0]), mxb = max3f(p0[2], p0[3], p1[1]);
  mxa = max3f(mxa, p1[2], p1[3]);
#pragma unroll
  for (int r = 4; r < 16; r += 4) { mxa = max3f(mxa, p0[r], p0[r + 1]); mxb = max3f(mxb, p0[r + 2], p0[r + 3]); mxa = max3f(mxa, p1[r], p1[r + 1]); mxb = max3f(mxb, p1[r + 2], p1[r + 3]); }
  float mx = fmaxf(mxa, mxb);
  mx = fmaxf(mx, __shfl_xor(mx, 32));
  if (__any(mx > THR)) {
    asm volatile("; rescale (rare)" ::: "memory");
    const float d0_ = (mx > THR) ? mx : 0.f;
    const float mnew = __uint_as_float(cvtpk(st.m + d0_, 0.f) << 16);
    const float d = mnew - st.m;
    st.m = mnew;
    const float alpha = fexp2(-d);
#pragma unroll
    for (int r = 0; r < 16; ++r) { st.o0[r] *= alpha; st.o1[r] *= alpha; p0[r] -= d; p1[r] -= d; }
    st.l *= alpha;
  }
#pragma unroll
  for (int r = 0; r < 16; ++r) { p0[r] = fexp2(p0[r]); p1[r] = fexp2(p1[r]); }
  if (MODE == 1) {
    const unsigned w0 = w.x >> (4 * hi), w1 = w.y >> (4 * hi);
#define DSA_MASK1(R, POS) { int k0_, k1_; asm("v_bfe_i32 %0, %1, " #POS ", 1" : "=v"(k0_) : "v"(w0)); asm("v_bfe_i32 %0, %1, " #POS ", 1" : "=v"(k1_) : "v"(w1)); \
      p0[R] = __uint_as_float(__float_as_uint(p0[R]) & (unsigned)k0_); p1[R] = __uint_as_float(__float_as_uint(p1[R]) & (unsigned)k1_); }
    DSA_MASK1(0, 0) DSA_MASK1(1, 1) DSA_MASK1(2, 2) DSA_MASK1(3, 3) DSA_MASK1(4, 8) DSA_MASK1(5, 9) DSA_MASK1(6, 10) DSA_MASK1(7, 11)
    DSA_MASK1(8, 16) DSA_MASK1(9, 17) DSA_MASK1(10, 18) DSA_MASK1(11, 19) DSA_MASK1(12, 24) DSA_MASK1(13, 25) DSA_MASK1(14, 26) DSA_MASK1(15, 27)
#undef DSA_MASK1
  }
  {
    typedef float f32x2 __attribute__((ext_vector_type(2)));
    f32x2 t[8];
#pragma unroll
    for (int k = 0; k < 8; ++k) t[k] = (f32x2){p0[2 * k], p0[2 * k + 1]} + (f32x2){p1[2 * k], p1[2 * k + 1]};
#pragma unroll
    for (int k = 0; k < 4; ++k) t[k] += t[k + 4];
    t[0] += t[2]; t[1] += t[3];
    t[0] += t[1];
    st.l += t[0].x + t[0].y;
  }
  bf16x8 pa[4];
#pragma unroll
  for (int ks = 0; ks < 2; ++ks) {
    u32x4 a, c;
    a.x = cvtpk(p0[8 * ks + 0], p0[8 * ks + 1]); a.y = cvtpk(p0[8 * ks + 2], p0[8 * ks + 3]); a.z = cvtpk(p0[8 * ks + 4], p0[8 * ks + 5]); a.w = cvtpk(p0[8 * ks + 6], p0[8 * ks + 7]);
    c.x = cvtpk(p1[8 * ks + 0], p1[8 * ks + 1]); c.y = cvtpk(p1[8 * ks + 2], p1[8 * ks + 3]); c.z = cvtpk(p1[8 * ks + 4], p1[8 * ks + 5]); c.w = cvtpk(p1[8 * ks + 6], p1[8 * ks + 7]);
    pa[ks] = __builtin_bit_cast(bf16x8, a); pa[ks + 2] = __builtin_bit_cast(bf16x8, c);
  }
  const LAS char* vb = (const LAS char*)lds + tbuf + 8192 + (4 * hi + ((lane & 15) >> 2)) * 64 + ((lane >> 4) & 1) * 32 + (lane & 3) * 8;
#pragma unroll
  for (int ks = 0; ks < 4; ++ks) {
    const s16x4 l0 = vtr(vb + ks * 1024), h0 = vtr(vb + ks * 1024 + 512);
    const s16x4 l1 = vtr(vb + 4096 + ks * 1024), h1 = vtr(vb + 4096 + ks * 1024 + 512);
    const bf16x8 f0 = (bf16x8){l0[0], l0[1], l0[2], l0[3], h0[0], h0[1], h0[2], h0[3]};
    const bf16x8 f1 = (bf16x8){l1[0], l1[1], l1[2], l1[3], h1[0], h1[1], h1[2], h1[3]};
    st.o0 = MFMA32(f0, pa[ks], st.o0);
    st.o1 = MFMA32(f1, pa[ks], st.o1);
  }
}

DI void attn_load_q(const bf16_t* __restrict__ qp, bf16x8 (&qr)[4]) {
#pragma unroll
  for (int d0 = 0; d0 < 4; ++d0) {
    const u32x4 v = *(const u32x4*)(qp + d0 * 16);
    u32x4 o;
    o.x = cvtpk(bflo(v.x) * C2, bfhi(v.x) * C2); o.y = cvtpk(bflo(v.y) * C2, bfhi(v.y) * C2);
    o.z = cvtpk(bflo(v.z) * C2, bfhi(v.z) * C2); o.w = cvtpk(bflo(v.w) * C2, bfhi(v.w) * C2);
    qr[d0] = __builtin_bit_cast(bf16x8, o);
  }
}
DI void attn_store(bf16_t* op, const AttState& st, float inv) {
#pragma unroll
  for (int g = 0; g < 4; ++g) {
    u32x2 a, c;
    a.x = cvtpk(st.o0[4 * g + 0] * inv, st.o0[4 * g + 1] * inv); a.y = cvtpk(st.o0[4 * g + 2] * inv, st.o0[4 * g + 3] * inv);
    c.x = cvtpk(st.o1[4 * g + 0] * inv, st.o1[4 * g + 1] * inv); c.y = cvtpk(st.o1[4 * g + 2] * inv, st.o1[4 * g + 3] * inv);
    *(u32x2*)(op + 8 * g) = a;
    *(u32x2*)(op + 32 + 8 * g) = c;
  }
}

DI void attn_dsa_unit(char* lds, const bf16_t* __restrict__ proj, bf16_t* __restrict__ mix, const uint2* __restrict__ bmt, int b, int h, int qb) {
  const int tid = otid(), lane = tid & 63, wid = __builtin_amdgcn_readfirstlane(tid >> 6), r32 = lane & 31, hi = lane >> 5;
  const int qrel = wid * 32 + r32, t = qb * 256 + qrel;
  const size_t tokq = (size_t)(b * S + t);
  bf16x8 qr[4];
  attn_load_q(proj + tokq * PLD + C_QD + h * 64 + hi * 8, qr);
  AttState st; st.m = 0.f; st.l = 0.f;
#pragma unroll
  for (int r = 0; r < 16; ++r) { st.o0[r] = 0.f; st.o1[r] = 0.f; }
  const uint2* bmp = bmt + (size_t)(b * 128) * 8192 + t;
  uint2 wn[4];
#pragma unroll
  for (int tt = 0; tt < 4; ++tt) wn[tt] = bmp[(size_t)tt * 8192];
  attn_stage<1>(lds, 0, proj, b, h, 0, lane, wid);
  const int ns = qb + 1;
  for (int s = 0; s < ns; ++s) {
    uint2 wc[4];
#pragma unroll
    for (int tt = 0; tt < 4; ++tt) wc[tt] = wn[tt];
    asm volatile("s_waitcnt vmcnt(0)" ::: "memory");
    __syncthreads();
    if (s + 1 < ns) {
#pragma unroll
      for (int tt = 0; tt < 4; ++tt) wn[tt] = bmp[(size_t)(4 * (s + 1) + tt) * 8192];
      attn_stage<1>(lds, ((s + 1) & 1) * ATT_ST, proj, b, h, (s + 1) * 256, lane, wid);
    }
#pragma unroll
    for (int tt = 0; tt < 4; ++tt) attn_tile<1>(lds, (s & 1) * ATT_ST + tt * 16384, qr, st, wc[tt], 0, qrel, r32, hi, lane);
  }
  float l = st.l; l += __shfl_xor(l, 32);
  attn_store(mix + tokq * D + 640 + h * 64 + 4 * hi, st, 1.f / l);
  __syncthreads();
}

DI void attn_own_unit(char* lds, const bf16_t* __restrict__ proj, bf16_t* __restrict__ part_o, float2* __restrict__ part_ml, int b, int h, int qb) {
  const int tid = otid(), lane = tid & 63, wid = __builtin_amdgcn_readfirstlane(tid >> 6), r32 = lane & 31, hi = lane >> 5;
  const int qrel = wid * 32 + r32, t = qb * 256 + qrel;
  const size_t tokq = (size_t)(b * S + t);
  attn_stage<0>(lds, 0, proj, b, h, qb * 256, lane, wid);
  bf16x8 qr[4];
  attn_load_q(proj + tokq * PLD + C_QM + h * 64 + hi * 8, qr);
  AttState st; st.m = 0.f; st.l = 0.f;
#pragma unroll
  for (int r = 0; r < 16; ++r) { st.o0[r] = 0.f; st.o1[r] = 0.f; }
  asm volatile("s_waitcnt vmcnt(0)" ::: "memory");
  __syncthreads();
#pragma unroll
  for (int tt = 0; tt < 4; ++tt) attn_tile<0>(lds, tt * 16384, qr, st, make_uint2(0u, 0u), tt, qrel, r32, hi, lane);
  float l = st.l; l += __shfl_xor(l, 32);
  const size_t pi = (tokq * 6 + h) * 4 + 3;
  if (hi == 0) st_wt64((unsigned long long*)&part_ml[pi], ((unsigned long long)__float_as_uint(l) << 32) | __float_as_uint(st.m));
  attn_store(part_o + pi * 64 + 4 * hi, st, 1.f / l);
  __syncthreads();
}

DI void attn_gather_unit(char* lds, const bf16_t* __restrict__ proj, bf16_t* __restrict__ part_o, float2* __restrict__ part_ml, int b, int h, int j, const unsigned* __restrict__ lst, int nent) {
  const int tid = otid(), lane = tid & 63, wid = __builtin_amdgcn_readfirstlane(tid >> 6), r32 = lane & 31, hi = lane >> 5;
  attn_stage<2>(lds, 0, proj, b, h, j * 256, lane, wid);
  asm volatile("s_waitcnt vmcnt(0)" ::: "memory");
  __syncthreads();
  const int ntile = (nent + 31) >> 5;
  for (int qt = wid; qt < ntile; qt += 8) {
    const int qi = qt * 32 + r32;
    const bool valid = qi < nent;
    const unsigned e = lst[valid ? qi : 0];
    const int t = (int)(e & 0x1FFFu), pslot = (int)(e >> 13);
    const size_t tokq = (size_t)(b * S + t);
    bf16x8 qr[4];
    attn_load_q(proj + tokq * PLD + C_QM + h * 64 + hi * 8, qr);
    AttState st; st.m = 0.f; st.l = 0.f;
#pragma unroll
    for (int r = 0; r < 16; ++r) { st.o0[r] = 0.f; st.o1[r] = 0.f; }
#pragma unroll
    for (int tt = 0; tt < 4; ++tt) attn_tile<2>(lds, tt * 16384, qr, st, make_uint2(0u, 0u), 0, 0, r32, hi, lane);
    float l = st.l; l += __shfl_xor(l, 32);
    if (valid) {
      const size_t pi = (tokq * 6 + h) * 4 + pslot;
      if (hi == 0) st_wt64((unsigned long long*)&part_ml[pi], ((unsigned long long)__float_as_uint(l) << 32) | __float_as_uint(st.m));
      attn_store(part_o + pi * 64 + 4 * hi, st, 1.f / l);
    }
  }
  __syncthreads();
}

DI void gate_unit(char* lds, int u, const bf16_t* __restrict__ proj, const float* __restrict__ kmean, unsigned* __restrict__ mcnt, unsigned* __restrict__ mlist) {
  unsigned* lc = (unsigned*)lds;
  unsigned* lb = lc + 192;
  float* kml = (float*)(lds + 2048);
  const int tid = otid();
  if (tid < 192) lc[tid] = 0u;
  const int tok = u * 64 + (tid & 63), head = tid >> 6;
  const int b = tok >> 13, t = tok & (S - 1), own = t >> 8;
  for (int i = tid; i < 6 * 32 * 16; i += NTHR) {
    const int jb = (i >> 4) & 31;
    if (jb < own) *(float4*)(kml + i * 4) = *(const float4*)(kmean + (size_t)b * 6 * 32 * 64 + i * 4);
  }
  __syncthreads();
  int sj[3] = {-1, -1, -1}; unsigned sp[3] = {0u, 0u, 0u};
  if (tid < 384) {
    u32x4 q[8];
    const bf16_t* qp = proj + (size_t)tok * PLD + C_QM + head * 64;
#pragma unroll
    for (int i = 0; i < 8; ++i) q[i] = *(const u32x4*)(qp + i * 8);
    float v1 = -INFINITY, v2 = -INFINITY, v3 = -INFINITY; int i1 = -1, i2 = -1, i3 = -1;
    for (int j = 0; j < own; ++j) {
      const float* km = kml + (head * 32 + j) * 64;
      float g = 0.f;
#pragma unroll
      for (int i = 0; i < 8; ++i) {
        const float4 ka = *(const float4*)(km + i * 8), kb = *(const float4*)(km + i * 8 + 4);
        g += bflo(q[i].x) * ka.x + bfhi(q[i].x) * ka.y + bflo(q[i].y) * ka.z + bfhi(q[i].y) * ka.w;
        g += bflo(q[i].z) * kb.x + bfhi(q[i].z) * kb.y + bflo(q[i].w) * kb.z + bfhi(q[i].w) * kb.w;
      }
      if (g > v1) { v3 = v2; i3 = i2; v2 = v1; i2 = i1; v1 = g; i1 = j; }
      else if (g > v2) { v3 = v2; i3 = i2; v2 = g; i2 = j; }
      else if (g > v3) { v3 = g; i3 = j; }
    }
    sj[0] = i1; sj[1] = i2; sj[2] = i3;
#pragma unroll
    for (int p = 0; p < 3; ++p) if (sj[p] >= 0) sp[p] = atomicAdd(&lc[head * 32 + sj[p]], 1u);
  }
  __syncthreads();
  if (tid < 192 && lc[tid]) lb[tid] = atomicAdd(&mcnt[(b * 6 + (tid >> 5)) * 32 + (tid & 31)], lc[tid]);
  __syncthreads();
  if (tid < 384) {
#pragma unroll
    for (int p = 0; p < 3; ++p) if (sj[p] >= 0) {
      const int c = (b * 6 + head) * 32 + sj[p];
      st_wt32(&mlist[(size_t)c * 8192 + lb[head * 32 + sj[p]] + sp[p]], (unsigned)t | ((unsigned)p << 13));
    }
  }
  __syncthreads();
}

DI void conv_unit(char* lds, int u, const bf16_t* __restrict__ proj, bf16_t* __restrict__ mix, const float* __restrict__ conv_w, const float* __restrict__ conv_b,
                  const float* __restrict__ ln_g, const float* __restrict__ ln_b);
DI void attn_queue_phase(char* lds, const bf16_t* proj, bf16_t* mix, const uint2* bmt, bf16_t* part_o, float2* part_ml, const unsigned* mcnt, const unsigned* mlist, unsigned* qhead,
                         const float* w1, const float* w3, const float* w2, bf16_t* w13T, bf16_t* w2T,
                         const float* conv_w, const float* conv_b, const float* ln_g, const float* ln_b) {
  unsigned* pfx = (unsigned*)(lds + 133120);
  unsigned* qw = (unsigned*)(lds + 133120 + 3328);
  const int tid = otid(), lane = tid & 63;
  if (tid < 64) {
    unsigned loc[12]; unsigned sum = 0u;
#pragma unroll
    for (int i = 0; i < 12; ++i) { loc[i] = (mcnt[tid * 12 + i] + 2047u) >> 11; sum += loc[i]; }
    unsigned run = scan_add(sum) - sum;
    if (lane == 0) pfx[0] = 0u;
#pragma unroll
    for (int i = 0; i < 12; ++i) { run += loc[i]; pfx[tid * 12 + i + 1] = run; }
  }
  __syncthreads();
  const int nsp = (int)pfx[768];
  const int natt = 768 + nsp + 768;
  const int nconv = T / 64;
  const int total = natt + nconv + PREP_EXP_ITEMS;
  int qlast = 0;
  for (;;) {
    if (tid == 0) qw[0] = atomicAdd(qhead, 1u);
    __syncthreads();
    const int q = (int)qw[0];
    __syncthreads();
    if (q >= natt) { qlast = q; break; }
    if (q < 768) {
      const int qb = 31 - q / 24, bh = q % 24;
      attn_dsa_unit(lds, proj, mix, bmt, bh / 6, bh % 6, qb);
    } else if (q < 768 + nsp) {
      const unsigned item = (unsigned)(q - 768);
      int lo = 0, hi = 768;
      while (hi - lo > 1) { const int mid = (lo + hi) >> 1; if (pfx[mid] <= item) lo = mid; else hi = mid; }
      const int c = lo, chunk = (int)(item - pfx[c]);
      const int nent = min(2048, (int)mcnt[c] - chunk * 2048);
      attn_gather_unit(lds, proj, part_o, part_ml, c / 192, (c >> 5) % 6, c & 31, mlist + (size_t)c * 8192 + chunk * 2048, nent);
    } else {
      const int o = q - 768 - nsp, qb = 31 - o / 24, bh = o % 24;
      attn_own_unit(lds, proj, part_o, part_ml, bh / 6, bh % 6, qb);
    }
  }
  for (int q = qlast; q < total;) {
    if (q < natt + nconv) conv_unit(lds, q - natt, proj, mix, conv_w, conv_b, ln_g, ln_b);
    else prep_exp_item(lds, q - natt - nconv, w1, w3, w2, w13T, w2T);
    if (tid == 0) qw[0] = atomicAdd(qhead, 1u);
    __syncthreads();
    q = (int)qw[0];
    __syncthreads();
  }
}

constexpr int SEL_CAP = 1024, SEL_G = 512, SEL_K = 256;
constexpr int SEL_LDS = 131072 + 512 + 4096 + 4096;
constexpr int SEL_DUMMY = 131072 + 512 + 4096;
DI unsigned fkey(float f) { const unsigned u = __float_as_uint(f); return (u & 0x80000000u) ? ~u : (u | 0x80000000u); }

DI float fkey_inv(unsigned k) { const unsigned u = (k & 0x80000000u) ? (k & 0x7fffffffu) : ~k; return __uint_as_float(u); }
DI int sbin(float s, float lo, float sc) { return min(63, __float2int_rd((s - lo) * sc)); }
DI int hist_scan(const unsigned* h, int lane, int K) {
  const unsigned Sx = scan_add(h[63 - lane]);
  const unsigned long long m = __ballot(Sx >= (unsigned)K);
  return m ? (63 - (int)__builtin_ctzll(m)) : -1;
}
DI void sel_row_maint(uint2* rowbuf, unsigned* cntp, float* taup, unsigned* hist, bool last, int K = SEL_K, bool thr = false, bool raw = false) {
  const int lane = otid() & 63;
  int n = (int)*cntp; if (n > SEL_CAP) n = SEL_CAP;
  const int lim = thr ? K - 1 : (last ? SEL_K : (SEL_CAP - SEL_G));
  if (thr && n <= lim) { if (lane == 0) { *cntp = 0u; *taup = -INFINITY; } }
  if (n > lim) {
    unsigned ky[16], kx[16];
    unsigned kmin = 0xffffffffu, kmax = 0u;
#pragma unroll
    for (int i = 0; i < 16; ++i) {
      const int idx = lane + 64 * i; uint2 v = make_uint2(0u, 0u);
      if (64 * i < n) { if (idx < n) { v = rowbuf[idx]; if (raw) v.y = fkey(__uint_as_float(v.y)); kmin = min(kmin, v.y); kmax = max(kmax, v.y); } }
      ky[i] = v.y; kx[i] = v.x;
    }
    kmin = red_min(kmin); kmax = red_max(kmax);
    const float lo = fkey_inv(kmin), range = fkey_inv(kmax) - lo, sc = range > 0.f ? 64.f / range : 0.f;
    hist[lane] = 0u;
    int bn[16];
#pragma unroll
    for (int i = 0; i < 16; ++i) { const int idx = lane + 64 * i; bn[i] = -1; if (64 * i < n) { if (idx < n) { bn[i] = max(0, sbin(fkey_inv(ky[i]), lo, sc)); atomicAdd(&hist[bn[i]], 1u); } } }
    const int L = hist_scan(hist, lane, K);
    unsigned ka = 0xffffffffu, kb = 0xffffffffu;
    int ckeep = 0;
#pragma unroll
    for (int i = 0; i < 16; ++i) { if (64 * i < n) { if (bn[i] >= L) { ka = min(ka, ky[i]); ++ckeep; } if (bn[i] > L) kb = min(kb, ky[i]); } }
    ka = red_min(ka); kb = red_min(kb); ckeep = (int)red_add((unsigned)ckeep);
    if (thr) { if (lane == 0) { *cntp = 0u; *taup = fkey_inv(ka); } return; }
    unsigned theta = ka, phi = 0u;
    int nsel = ckeep;
    if (last || ckeep > SEL_CAP - SEL_G) {
      unsigned av = ka, hi = (kb != 0xffffffffu) ? kb - 1u : kmax;
      int ca = -1;
      while (av < hi) {
        const unsigned d = hi - av, mid = av + (d >> 1) + (d & 1u);
        int c = 0;
#pragma unroll
        for (int i = 0; i < 16; ++i) { if (64 * i < n) c += __popcll(__ballot(ky[i] >= mid)); }
        if (c >= SEL_K) { av = mid; ca = c; } else hi = mid - 1u;
        if (c == SEL_K) break;
      }
      theta = av;
      if (ca != SEL_K) {
        int cgt = 0;
#pragma unroll
        for (int i = 0; i < 16; ++i) cgt += __popcll(__ballot(ky[i] > theta));
        const int need = SEL_K - cgt;
        for (int bit = 31; bit >= 0; --bit) {
          const unsigned cand = phi | (1u << bit);
          int c = 0;
#pragma unroll
          for (int i = 0; i < 16; ++i) c += __popcll(__ballot(ky[i] == theta && kx[i] >= cand));
          if (c >= need) phi = cand;
          if (c == need) break;
        }
      }
      nsel = SEL_K;
    }
    const unsigned long long lt = (1ull << lane) - 1ull;
    int base = 0;
#pragma unroll
    for (int i = 0; i < 16; ++i) {
      if (64 * i < n) {
        const bool sl = (ky[i] > theta) || (ky[i] == theta && kx[i] >= phi);
        const unsigned long long bal = __ballot(sl);
        const int pos = base + __popcll(bal & lt);
        if (sl && pos < SEL_CAP) rowbuf[pos] = make_uint2(kx[i], ky[i]);
        base += __popcll(bal);
      }
    }
    if (lane == 0) { *cntp = (unsigned)nsel; *taup = fkey_inv(theta); }
  }
}

constexpr int SEL_CTL = 131072, SEL_HIST = 131072 + 512;
template <int SM>
DI void dsa_select_unit(char* lds, const bf16_t* __restrict__ proj, uint2* __restrict__ bmt, int b, int rg) {
  uint2* buf = (uint2*)lds;
  unsigned* cnt = (unsigned*)(lds + SEL_CTL);
  float* tauf = (float*)(cnt + 16);
  unsigned* flag = cnt + 32;
  unsigned* hist = (unsigned*)(lds + SEL_HIST);
  const int tid = otid(), lane = tid & 63, wid = __builtin_amdgcn_readfirstlane(tid >> 6), fr = lane & 15, fq = lane >> 4;
  const int t0 = rg * 16, t = t0 + fr;
  if (tid < 16) { cnt[tid] = 0u; tauf[tid] = -INFINITY; }
  if (tid == 0) flag[0] = 0u;
  const bf16_t* qrow = proj + (size_t)(b * S + t) * PLD;
  bf16x8 qf[8][2]; float w[8];
#pragma unroll
  for (int hh = 0; hh < 8; ++hh) {
    qf[hh][0] = *(const bf16x8*)(qrow + C_QI + hh * 64 + fq * 8);
    qf[hh][1] = *(const bf16x8*)(qrow + C_QI + hh * 64 + 32 + fq * 8);
    w[hh] = bf2f(qrow[C_WI + hh]);
  }
  const int ntile = rg + 1;
  const bf16_t* kbase = proj + (size_t)(b * S + fr) * PLD + C_KI + fq * 8;
  bf16x8 q9[2];
#pragma unroll
  for (int s = 0; s < 2; ++s) {
    float f[8];
#pragma unroll
    for (int j = 0; j < 8; ++j) {
      float a = 0.f;
#pragma unroll
      for (int hh = 0; hh < 8; ++hh) a += w[hh] * bf2f((bf16_t)qf[hh][s][j]);
      f[j] = a;
    }
    u32x4 o; o.x = cvtpk(f[0], f[1]); o.y = cvtpk(f[2], f[3]); o.z = cvtpk(f[4], f[5]); o.w = cvtpk(f[6], f[7]);
    q9[s] = __builtin_bit_cast(bf16x8, o);
  }
  unsigned dmask = 0u;
#pragma unroll
  for (int r = 0; r < 4; ++r) dmask |= (fq * 4 + r <= fr) ? (1u << r) : 0u;
  __syncthreads();
  uint2* const dummy = (uint2*)(lds + SEL_DUMMY) + tid;
  auto stream = [&](int first, int step, int kend, float tv, bool raw) {
    bf16x8 kf[4][2];
#pragma unroll
    for (int i = 0; i < 4; ++i) {
      const int kt = first + i * step;
      if (kt < kend) { const bf16_t* kp = kbase + (size_t)kt * 16 * PLD; kf[i][0] = *(const bf16x8*)kp; kf[i][1] = *(const bf16x8*)(kp + 32); }
    }
    for (int kb0 = first; kb0 < kend; kb0 += 4 * step) {
      bf16x8 kn[4][2];
#pragma unroll
      for (int i = 0; i < 4; ++i) {
        const int kt = kb0 + (4 + i) * step;
        if (kt < kend) { const bf16_t* kp = kbase + (size_t)kt * 16 * PLD; kn[i][0] = *(const bf16x8*)kp; kn[i][1] = *(const bf16x8*)(kp + 32); }
      }
      f32x4 sv[4];
      unsigned pmask = 0u;
      {
        const f32x4 z = (f32x4){0.f, 0.f, 0.f, 0.f};
        f32x4 xb[3];
        f32x4 acc = z;
#define SEL_PAIR(n) do { const int i_ = (n) / 9, j_ = (n) % 9; \
          const f32x4 t_ = MFMA16(kf[i_][0], j_ ? qf[j_ ? j_ - 1 : 0][0] : q9[0], z); \
          xb[(n) % 3] = MFMA16(kf[i_][1], j_ ? qf[j_ ? j_ - 1 : 0][1] : q9[1], t_); } while (0)
        SEL_PAIR(0); SEL_PAIR(1);
#pragma unroll
        for (int n = 0; n < 36; ++n) {
          if (n + 2 < 36) SEL_PAIR(n + 2);
          __builtin_amdgcn_sched_barrier(0);
          const int i = n / 9, j = n % 9;
          if (j == 0) acc = xb[n % 3];
          else {
#pragma unroll
            for (int r = 0; r < 4; ++r) { float v = fmaf(fabsf(xb[n % 3][r]), w[j - 1], acc[r]); asm volatile("" : "+v"(v)); acc[r] = v; }
          }
          if (j == 8) {
            const int kt = kb0 + i * step;
            sv[i] = acc;
            if (SM == 1) { asm volatile("" :: "v"(acc[0]), "v"(acc[1]), "v"(acc[2]), "v"(acc[3])); }
            else {
              const unsigned allow = (kt < kend) ? ((kt == ntile - 1) ? dmask : 0xfu) : 0u;
              unsigned pm = 0u;
#pragma unroll
              for (int r = 0; r < 4; ++r) pm |= (acc[r] >= tv) ? (1u << r) : 0u;
              pmask |= (pm & allow) << (i * 4);
            }
          }
          __builtin_amdgcn_sched_barrier(0);
        }
#undef SEL_PAIR
      }
      if (SM != 1) {
        const int np = __popc(pmask);
        unsigned slot = 0u;
        if (np) slot = atomicAdd(&cnt[fr], (unsigned)np);
        if (slot + (unsigned)np > (unsigned)SEL_CAP) slot = (unsigned)(SEL_CAP - 16);
        uint2* rb = buf + fr * SEL_CAP;
#pragma unroll
        for (int i = 0; i < 4; ++i) {
          const unsigned xb = ~(unsigned)((kb0 + i * step) * 16 + fq * 4);
#pragma unroll
          for (int r = 0; r < 4; ++r) {
            const int e = i * 4 + r;
            const unsigned pos = slot + (unsigned)__popc(pmask & ((1u << e) - 1u));
            uint2* dst = ((pmask >> e) & 1u) ? (rb + pos) : dummy;
            *dst = make_uint2(xb - (unsigned)r, raw ? __float_as_uint(sv[i][r]) : fkey(sv[i][r]));
          }
        }
      }
#pragma unroll
      for (int i = 0; i < 4; ++i) { kf[i][0] = kn[i][0]; kf[i][1] = kn[i][1]; }
    }
  };
  bool done = false;
  if (SM == 0 || SM == 3) {
    if (ntile > 64) {
      stream(8 * wid, 64, ntile, -INFINITY, true);
      __syncthreads();
#pragma unroll 1
      for (int rr = 0; rr < 2; ++rr) {
        const int row = 2 * wid + rr;
        const int ns = (int)cnt[row], nrow = t0 + row + 1;
        const int K = min(ns, (2 * SEL_K * ns + nrow - 1) / nrow);
        sel_row_maint(buf + row * SEL_CAP, &cnt[row], &tauf[row], hist + wid * 64, false, max(K, 1), true, true);
      }
      __syncthreads();
      stream(wid, 8, ntile, tauf[fr], true);
      __syncthreads();
      if (tid < 16) { const unsigned c = cnt[tid]; if (c < (unsigned)SEL_K || c > (unsigned)SEL_CAP) atomicOr(&flag[0], 1u); }
      __syncthreads();
      done = (flag[0] == 0u);
      if (done) {
#pragma unroll 1
        for (int rr = 0; rr < 2; ++rr) { const int row = 2 * wid + rr; sel_row_maint(buf + row * SEL_CAP, &cnt[row], &tauf[row], hist + wid * 64, true, SEL_K, false, true); }
      }
      __syncthreads();
      if (!done && tid < 16) { cnt[tid] = 0u; tauf[tid] = -INFINITY; }
      __syncthreads();
    }
  }
  if (!done) {
    const int nround = (ntile + 31) >> 5;
    for (int rd = 0; rd < nround; ++rd) {
      stream(rd * 32 + wid, 8, min(ntile, rd * 32 + 32), tauf[fr], false);
      __syncthreads();
      const bool last = (rd == nround - 1);
      if (SM == 1 || SM == 2) continue;
#pragma unroll 1
      for (int rr = 0; rr < 2; ++rr) {
        const int row = 2 * wid + rr;
        sel_row_maint(buf + row * SEL_CAP, &cnt[row], &tauf[row], hist + wid * 64, last);
      }
      __syncthreads();
    }
  }
  if (SM != 0) { __syncthreads(); return; }
#pragma unroll
  for (int i = 0; i < 8; ++i) { const int wd = tid + NTHR * i; *(unsigned*)(lds + (wd >> 8) * 8192 + 4096 + (wd & 255) * 4) = 0u; }
  __syncthreads();
  {
    const int row = tid >> 5;
    int n = (int)cnt[row]; if (n > SEL_K) n = SEL_K;
    unsigned* img = (unsigned*)(lds + row * 8192 + 4096);
#pragma unroll
    for (int i = 0; i < 8; ++i) {
      const int e = (tid & 31) + 32 * i;
      if (e < n) { const unsigned idx = ~buf[row * SEL_CAP + e].x; atomicOr(&img[idx >> 5], 1u << (idx & 31)); }
    }
  }
  __syncthreads();
  {
    const int ntw = 4 * (t0 >> 8) + 4;
    const int r = tid & 15;
    const unsigned* img = (const unsigned*)(lds + r * 8192 + 4096);
    for (int tile = tid >> 4; tile < ntw; tile += 32)
      bmt[((size_t)(b * 128 + tile)) * 8192 + t0 + r] = make_uint2(img[2 * tile], img[2 * tile + 1]);
  }
  __syncthreads();
}

constexpr int MIX_LDS = 94 * 256 * 4;
DI void conv_unit(char* lds, int u, const bf16_t* __restrict__ proj, bf16_t* __restrict__ mix, const float* __restrict__ conv_w, const float* __restrict__ conv_b,
                  const float* __restrict__ ln_g, const float* __restrict__ ln_b) {
  float* ut = (float*)lds;
  const int tid = otid(), lane = tid & 63, wid = tid >> 6;
  {
    const int tok0 = u * 64, b = tok0 >> 13, t0 = tok0 & (S - 1);
#pragma unroll
    for (int it = 0; it < 6; ++it) {
      const int task = tid + it * NTHR;
      if (task >= 94 * 32) break;
      const int row = task >> 5, cc = (task & 31) * 8;
      const int tt = t0 - 30 + row;
      float uv[8] = {0.f, 0.f, 0.f, 0.f, 0.f, 0.f, 0.f, 0.f};
      if (tt >= 0) {
        const bf16_t* pr = proj + (size_t)(b * S + tt) * PLD;
        const u32x4 a = *(const u32x4*)(pr + C_CA + cc), g = *(const u32x4*)(pr + C_CG + cc);
        const float av[8] = {bflo(a.x), bfhi(a.x), bflo(a.y), bfhi(a.y), bflo(a.z), bfhi(a.z), bflo(a.w), bfhi(a.w)};
        const float gv[8] = {bflo(g.x), bfhi(g.x), bflo(g.y), bfhi(g.y), bflo(g.z), bfhi(g.z), bflo(g.w), bfhi(g.w)};
#pragma unroll
        for (int q = 0; q < 8; ++q) uv[q] = av[q] * frcp(1.f + fexp2(gv[q] * -1.4426950408889634f));
      }
      *(float4*)(ut + row * 256 + cc) = make_float4(uv[0], uv[1], uv[2], uv[3]);
      *(float4*)(ut + row * 256 + cc + 4) = make_float4(uv[4], uv[5], uv[6], uv[7]);
    }
    __syncthreads();
    const int c = tid & 255, half = tid >> 8;
    float cw[31];
#pragma unroll
    for (int w = 0; w < 31; ++w) cw[w] = conv_w[w * 256 + c];
    float y[32];
    const float cb = conv_b[c];
#pragma unroll
    for (int o = 0; o < 32; ++o) y[o] = cb;
#pragma unroll
    for (int rho = 0; rho < 62; ++rho) {
      const float uvv = ut[(half * 32 + rho) * 256 + c];
#pragma unroll
      for (int o = 0; o < 32; ++o) { if (rho - o >= 0 && rho - o <= 30) y[o] += uvv * cw[rho - o]; }
    }
    __syncthreads();
#pragma unroll
    for (int o = 0; o < 32; ++o) ut[(half * 32 + o) * 256 + c] = y[o];
    __syncthreads();
    {
      const float4 gg = *(const float4*)(ln_g + lane * 4), bb = *(const float4*)(ln_b + lane * 4);
#pragma unroll 1
      for (int i4 = 0; i4 < 8; i4 += 4) {
        float4 v[4]; float sm[4], vr[4];
#pragma unroll
        for (int r = 0; r < 4; ++r) { v[r] = *(const float4*)(ut + (wid * 8 + i4 + r) * 256 + lane * 4); sm[r] = v[r].x + v[r].y + v[r].z + v[r].w; }
        wave_sum4(sm);
#pragma unroll
        for (int r = 0; r < 4; ++r) {
          const float mu = sm[r] * (1.f / 256.f);
          v[r].x -= mu; v[r].y -= mu; v[r].z -= mu; v[r].w -= mu;
          vr[r] = v[r].x * v[r].x + v[r].y * v[r].y + v[r].z * v[r].z + v[r].w * v[r].w;
        }
        wave_sum4(vr);
#pragma unroll
        for (int r = 0; r < 4; ++r) {
          const float rs = rsqrtf(vr[r] * (1.f / 256.f) + EPS);
          const float z0 = v[r].x * rs * gg.x + bb.x, z1 = v[r].y * rs * gg.y + bb.y, z2 = v[r].z * rs * gg.z + bb.z, z3 = v[r].w * rs * gg.w + bb.w;
          u32x2 o; o.x = cvtpk(silu_f(z0), silu_f(z1)); o.y = cvtpk(silu_f(z2), silu_f(z3));
          *(u32x2*)(mix + (size_t)(tok0 + wid * 8 + i4 + r) * D + 384 + lane * 4) = o;
        }
      }
    }
    __syncthreads();
  }
}

DI void mixfin_phase(bf16_t* __restrict__ mix, const float* __restrict__ mg, const float* __restrict__ dg, const bf16_t* __restrict__ part_o, const float2* __restrict__ part_ml) {
  const int tid = otid(), lane = tid & 63, wid = tid >> 6;
  for (int u = blockIdx.x; u < T / 64; u += gridDim.x) {
    const int tok0 = u * 64, t0 = tok0 & (S - 1);
    {
      const int nsel = min(3, t0 >> 8);
#pragma unroll 4
      for (int i = 0; i < 8; ++i) {
        const int tl = wid * 8 + i;
        const size_t tok = (size_t)(tok0 + tl);
        bf16_t* mr = mix + tok * D;
        float av[8] = {0.f, 0.f, 0.f, 0.f, 0.f, 0.f, 0.f, 0.f};
#pragma unroll
        for (int ch = 0; ch < 2; ++ch) {
          if (ch == 0 || lane < 32) {
            const int col = ch * 256 + lane * 4, hh = col >> 6, d0 = col & 63;
            const size_t pb = (tok * 6 + hh) * 4;
            const float2 ml3 = part_ml[pb + 3];
            float2 mls[3]; float M = ml3.x;
#pragma unroll
            for (int p = 0; p < 3; ++p) { mls[p] = make_float2(-1e30f, 0.f); if (p < nsel) { mls[p] = part_ml[pb + p]; M = fmaxf(M, mls[p].x); } }
            float wsum = 0.f, acc4[4] = {0.f, 0.f, 0.f, 0.f};
#pragma unroll
            for (int p = 0; p < 4; ++p) {
              if (p == 3 || p < nsel) {
                const float2 mlp = (p == 3) ? ml3 : mls[p < 3 ? p : 0];
                const float wgt = mlp.y * fexp2(mlp.x - M);
                const u32x2 ov = *(const u32x2*)(part_o + (pb + p) * 64 + d0);
                wsum += wgt;
                acc4[0] += wgt * bflo(ov.x); acc4[1] += wgt * bfhi(ov.x); acc4[2] += wgt * bflo(ov.y); acc4[3] += wgt * bfhi(ov.y);
              }
            }
            const float iw = 1.f / wsum;
#pragma unroll
            for (int q = 0; q < 4; ++q) av[ch * 4 + q] = acc4[q] * iw;
          }
        }
        {
          const float ss = wave_sum(av[0] * av[0] + av[1] * av[1] + av[2] * av[2] + av[3] * av[3] + av[4] * av[4] + av[5] * av[5] + av[6] * av[6] + av[7] * av[7]);
          const float rs = rsqrtf(ss * (1.f / 384.f) + EPS);
          const float4 g0 = *(const float4*)(mg + lane * 4);
          u32x2 o; o.x = cvtpk(av[0] * rs * g0.x, av[1] * rs * g0.y); o.y = cvtpk(av[2] * rs * g0.z, av[3] * rs * g0.w);
          *(u32x2*)(mr + lane * 4) = o;
          if (lane < 32) {
            const float4 g1 = *(const float4*)(mg + 256 + lane * 4);
            u32x2 o2; o2.x = cvtpk(av[4] * rs * g1.x, av[5] * rs * g1.y); o2.y = cvtpk(av[6] * rs * g1.z, av[7] * rs * g1.w);
            *(u32x2*)(mr + 256 + lane * 4) = o2;
          }
        }
        {
          bf16_t* pp = mr + 640;
          const u32x2 a = *(const u32x2*)(pp + lane * 4);
          u32x2 c2 = (u32x2){0u, 0u};
          if (lane < 32) c2 = *(const u32x2*)(pp + 256 + lane * 4);
          const float a0 = bflo(a.x), a1 = bfhi(a.x), a2 = bflo(a.y), a3 = bfhi(a.y);
          const float c0 = bflo(c2.x), c1 = bfhi(c2.x), c2f = bflo(c2.y), c3 = bfhi(c2.y);
          const float ss = wave_sum(a0 * a0 + a1 * a1 + a2 * a2 + a3 * a3 + c0 * c0 + c1 * c1 + c2f * c2f + c3 * c3);
          const float rs = rsqrtf(ss * (1.f / 384.f) + EPS);
          const float4 g0 = *(const float4*)(dg + lane * 4);
          u32x2 o; o.x = cvtpk(a0 * rs * g0.x, a1 * rs * g0.y); o.y = cvtpk(a2 * rs * g0.z, a3 * rs * g0.w);
          *(u32x2*)(pp + lane * 4) = o;
          if (lane < 32) {
            const float4 g1 = *(const float4*)(dg + 256 + lane * 4);
            u32x2 o2; o2.x = cvtpk(c0 * rs * g1.x, c1 * rs * g1.y); o2.y = cvtpk(c2f * rs * g1.z, c3 * rs * g1.w);
            *(u32x2*)(pp + 256 + lane * 4) = o2;
          }
        }
      }
    }
    __syncthreads();
  }
}

DI void route_phase(char* lds, const float* __restrict__ logits, const float* __restrict__ rgb, const float* __restrict__ reb, unsigned* __restrict__ list, int* __restrict__ cnt, float* __restrict__ gate) {
  unsigned* lcnt = (unsigned*)lds;
  unsigned* lbase = lcnt + 32;
  const int tid = otid();
  for (int u = blockIdx.x; u < T / NTHR; u += gridDim.x) {
    if (tid < 32) lcnt[tid] = 0u;
    __syncthreads();
    const int tok = u * NTHR + tid;
    const float* lg = logits + (size_t)tok * 36;
    float gl[4];
#pragma unroll
    for (int i = 0; i < 4; ++i) gl[i] = lg[i] + rgb[i];
    int gi = 0; float gm = gl[0];
#pragma unroll
    for (int i = 1; i < 4; ++i) if (gl[i] > gm) { gm = gl[i]; gi = i; }
    float gs = 0.f;
#pragma unroll
    for (int i = 0; i < 4; ++i) gs += __expf(gl[i] - gm);
    const float gw = 1.f / gs;
    float e1 = -INFINITY, e2 = -INFINITY; int j1 = 0, j2 = 0;
    for (int j = 0; j < 8; ++j) {
      const float v = lg[4 + gi * 8 + j] + reb[gi * 8 + j];
      if (v > e1) { e2 = e1; j2 = j1; e1 = v; j1 = j; }
      else if (v > e2) { e2 = v; j2 = j; }
    }
    const float p2 = 1.f / (1.f + __expf(e1 - e2)), p1 = 1.f - p2;
    const int ex1 = gi * 8 + j1, ex2 = gi * 8 + j2;
    gate[tok * 2] = gw * p1; gate[tok * 2 + 1] = gw * p2;
    const unsigned pos1 = atomicAdd(&lcnt[ex1], 1u);
    const unsigned pos2 = atomicAdd(&lcnt[ex2], 1u);
    __syncthreads();
    if (tid < 32) lbase[tid] = (unsigned)atomicAdd(&cnt[tid], (int)lcnt[tid]);
    __syncthreads();
    st_wt32(&list[(size_t)ex1 * 65536 + lbase[ex1] + pos1], (unsigned)(tok * 2));
    st_wt32(&list[(size_t)ex2 * 65536 + lbase[ex2] + pos2], (unsigned)(tok * 2 + 1));
    __syncthreads();
  }
}

DI void combine_phase(float* __restrict__ xio, const bf16_t* __restrict__ ys, const float* __restrict__ g2, int final_mode,
                      const float* __restrict__ g, const float* __restrict__ mod_sh, const float* __restrict__ mod_sc, bf16_t* __restrict__ h) {
  const int tid_ = otid(); const int lane = tid_ & 63, wid = tid_ >> 6;
  for (int row0 = (blockIdx.x * 8 + wid) * 2; row0 < T; row0 += gridDim.x * 16) {
    const int b = row0 >> 13;
    float4 v[2][4]; float ssa[4] = {0.f, 0.f, 0.f, 0.f};
    u32x2 ya[2][4], yc[2][4];
#pragma unroll
    for (int r = 0; r < 2; ++r) {
      const float* xr = xio + (size_t)(row0 + r) * D;
      const bf16_t* y0 = ys + (size_t)(row0 + r) * 2048;
#pragma unroll
      for (int i = 0; i < 4; ++i) {
        const int col = i * 256 + lane * 4;
        v[r][i] = *(const float4*)(xr + col);
        ya[r][i] = *(const u32x2*)(y0 + col); yc[r][i] = *(const u32x2*)(y0 + 1024 + col);
      }
    }
#pragma unroll
    for (int i = 0; i < 4; ++i) {
      const int col = i * 256 + lane * 4;
      const float4 gg = *(const float4*)(g2 + (size_t)b * 6144 + col);
#pragma unroll
      for (int r = 0; r < 2; ++r) {
        v[r][i].x += gg.x * (bflo(ya[r][i].x) + bflo(yc[r][i].x)); v[r][i].y += gg.y * (bfhi(ya[r][i].x) + bfhi(yc[r][i].x));
        v[r][i].z += gg.z * (bflo(ya[r][i].y) + bflo(yc[r][i].y)); v[r][i].w += gg.w * (bfhi(ya[r][i].y) + bfhi(yc[r][i].y));
        ssa[r] += v[r][i].x * v[r][i].x + v[r][i].y * v[r][i].y + v[r][i].z * v[r][i].z + v[r][i].w * v[r][i].w;
      }
    }
    wave_sum4(ssa);
#pragma unroll
    for (int i = 0; i < 4; ++i) {
      const int col = i * 256 + lane * 4;
      const float4 gg = *(const float4*)(g + col);
      float4 sc = make_float4(0.f, 0.f, 0.f, 0.f), sh = sc;
      if (!final_mode) { sc = *(const float4*)(mod_sc + (size_t)b * 6144 + col); sh = *(const float4*)(mod_sh + (size_t)b * 6144 + col); }
#pragma unroll
      for (int r = 0; r < 2; ++r) {
        const float rstd = rsqrtf(ssa[r] * (1.f / 1024.f) + EPS);
        float* xr = xio + (size_t)(row0 + r) * D;
        if (final_mode) {
          *(float4*)(xr + col) = make_float4(v[r][i].x * rstd * gg.x, v[r][i].y * rstd * gg.y, v[r][i].z * rstd * gg.z, v[r][i].w * rstd * gg.w);
        } else {
          *(float4*)(xr + col) = v[r][i];
          u32x2 o;
          o.x = cvtpk(v[r][i].x * rstd * gg.x * (1.f + sc.x) + sh.x, v[r][i].y * rstd * gg.y * (1.f + sc.y) + sh.y);
          o.y = cvtpk(v[r][i].z * rstd * gg.z * (1.f + sc.z) + sh.z, v[r][i].w * rstd * gg.w * (1.f + sc.w) + sh.w);
          *(u32x2*)(h + (size_t)(row0 + r) * D + col) = o;
        }
      }
    }
  }
}

#define XB_TMO      128
#define XB_XCNT(j)  (256  + 64 * (j))
#define XB_XSUB(j)  (1280 + 64 * (j))
#define XB_XGEN(j)  (2304 + 64 * (j))
#define XB_TOP      3328
#define XB_TOPGEN   3392
#define XCD_BAR_WORDS 3456
#define XB_SPIN_CAP (1u << 18)
DI unsigned xb_ld(unsigned* p) { return __hip_atomic_load(p, __ATOMIC_RELAXED, __HIP_MEMORY_SCOPE_AGENT); }
DI unsigned xb_add(unsigned* p, unsigned v) { return __hip_atomic_fetch_add(p, v, __ATOMIC_RELAXED, __HIP_MEMORY_SCOPE_AGENT); }
DI unsigned xb_xcc_id() { return (unsigned)__builtin_amdgcn_s_getreg((3 << 11) | 20) & 0xFu; }
#define XB_SPIN(cond, bar) do { unsigned _sp = 0; while (cond) { __builtin_amdgcn_s_sleep(1); \
    if ((++_sp & 255u) == 0u) { if (xb_ld(&(bar)[XB_TMO])) break; if (_sp > XB_SPIN_CAP) { atomicAdd(&(bar)[XB_TMO], 1u); break; } } } } while (0)
struct XcdBarrier { unsigned* bar; unsigned x; volatile LAS unsigned* st; };
DI XcdBarrier xcd_barrier_post(unsigned* bar, volatile LAS unsigned* st) {
  XcdBarrier b; b.bar = bar; b.x = xb_xcc_id(); b.st = st;
  if (threadIdx.x == 0) (void)xb_add(&bar[XB_XCNT(b.x)], 1u);
  return b;
}
DI void xcd_barrier_complete(unsigned* bar, unsigned x, unsigned& nloc, unsigned& nx) {
  const unsigned G = gridDim.x * gridDim.y * gridDim.z;
  unsigned sum, cnt, mine, sp = 0u;
  for (;;) {
    sum = 0u; cnt = 0u; mine = 0u;
#pragma unroll
    for (unsigned j = 0; j < 16; ++j) { const unsigned c = xb_ld(&bar[XB_XCNT(j)]); sum += c; cnt += (c > 0u) ? 1u : 0u; mine = (j == x) ? c : mine; }
    if (sum == G) break;
    __builtin_amdgcn_s_sleep(1);
    if ((++sp & 255u) == 0u) { if (xb_ld(&bar[XB_TMO])) break; if (sp > XB_SPIN_CAP) { atomicAdd(&bar[XB_TMO], 1u); break; } }
  }
  nloc = mine > 0u ? mine : 1u; nx = cnt > 0u ? cnt : 1u;
}
DI void xcd_barrier(const XcdBarrier& b) {
  asm volatile("s_waitcnt vmcnt(0)" ::: "memory");
  __syncthreads();
  if (threadIdx.x == 0) {
    unsigned* bar = b.bar;
    __builtin_amdgcn_s_waitcnt(0);
    unsigned nloc = b.st[0], nx = b.st[1];
    if (nloc == 0u) { xcd_barrier_complete(bar, b.x, nloc, nx); b.st[0] = nloc; b.st[1] = nx; }
    const unsigned old = xb_add(&bar[XB_XSUB(b.x)], 1u);
    const unsigned gen = old / nloc;
    if (old + 1u == (gen + 1u) * nloc) {
      __builtin_amdgcn_fence(__ATOMIC_RELEASE, "");
      asm volatile("s_waitcnt vmcnt(0)" ::: "memory");
      const unsigned og = xb_add(&bar[XB_TOP], 1u);
      const unsigned tg = og / nx;
      if (og + 1u == (tg + 1u) * nx) xb_add(&bar[XB_TOPGEN], 1u);
      else XB_SPIN(xb_ld(&bar[XB_TOPGEN]) == tg, bar);
      __builtin_amdgcn_fence(__ATOMIC_ACQUIRE, "");
      xb_add(&bar[XB_XGEN(b.x)], 1u);
      asm volatile("s_waitcnt vmcnt(0)" ::: "memory");
    } else {
      XB_SPIN(xb_ld(&bar[XB_XGEN(b.x)]) == gen, bar);
      __builtin_amdgcn_fence(__ATOMIC_ACQUIRE, "");
      asm volatile("s_waitcnt vmcnt(0)" ::: "memory");
    }
  }
  __syncthreads();
}

struct MegaP {
  const float *x, *c, *ada_w, *ada_b, *norm1_g, *w_in, *conv_w, *conv_b, *cln_g, *cln_b, *moba_g, *dsa_g, *w_out, *norm2_g, *rgw, *rgb, *rew, *reb, *w1, *w3, *w2, *final_g;
  float* out; char* ws;
};
constexpr int LDS_BST = 143360;
constexpr int MEGA_LDS = LDS_BST + 16;
constexpr int CW_BAR = 1024;
#ifndef PROBE
#define PROBE 0
#endif
#define NREP(k) ((PROBE == (k)) ? 2 : 1)

__global__ void __launch_bounds__(NTHR) mega(MegaP p) {
  extern __shared__ __attribute__((aligned(16))) char lds[];
  cg::grid_group grid = cg::this_grid();
  char* ws = p.ws;
  unsigned* ctl = (unsigned*)(ws + WS_CTL);
  float* mod = (float*)(ws + WS_MOD);
  float* kmean = (float*)(ws + WS_KMEAN);
  float* gate = (float*)(ws + WS_GATE);
  float* logits = (float*)(ws + WS_LOGIT);
  unsigned* list = (unsigned*)(ws + WS_LIST);
  bf16_t* winT = (bf16_t*)(ws + WS_WINT);
  bf16_t* woutT = (bf16_t*)(ws + WS_WOUTT);
  bf16_t* rt = (bf16_t*)(ws + WS_RT);
  bf16_t* w13T = (bf16_t*)(ws + WS_W13T);
  bf16_t* w2T = (bf16_t*)(ws + WS_W2T);
  bf16_t* hb = (bf16_t*)(ws + WS_HB);
  uint2* bmt = (uint2*)(ws + WS_BMT);
  bf16_t* proj = (bf16_t*)(ws + WS_PROJ);
  bf16_t* act = (bf16_t*)(ws + WS_ACT);
  bf16_t* ys = (bf16_t*)(ws + WS_YS);
  bf16_t* part_o = (bf16_t*)(ws + WS_PARTO);
  float2* part_ml = (float2*)(ws + WS_PARTML);
  unsigned* mlist = (unsigned*)(ws + WS_MLIST);
  float* out = p.out;
  const int nblk = gridDim.x, bid = blockIdx.x;
  volatile LAS unsigned* bst = (volatile LAS unsigned*)(LAS char*)(lds + LDS_BST);
  if (threadIdx.x < 2) bst[threadIdx.x] = 0u;
  __syncthreads();
  const XcdBarrier xb = xcd_barrier_post(ctl + CW_BAR, bst);
#define GSYNC() xcd_barrier(xb)
  grid.sync();

  {
    const int mb = nblk - 1 - bid;
    mod_units(lds, mb, nblk, p.c, p.ada_w, p.ada_b, mod);
    prep_small_units(lds, bid, nblk, p.w_in, p.w_out, p.rgw, p.rew, winT, woutT, rt);
  }
  GSYNC();
  rmsmod_phase(p.x, p.norm1_g, mod + 0, mod + 1024, hb);
  GSYNC();

  for (int l = 0; l < 2; ++l) {
    char* wsl = p.ws; asm volatile("" : "+s"(wsl));
    unsigned* ctl = (unsigned*)(wsl + WS_CTL);
    float* mod = (float*)(wsl + WS_MOD);
    float* kmean = (float*)(wsl + WS_KMEAN);
    float* gate = (float*)(wsl + WS_GATE);
    float* logits = (float*)(wsl + WS_LOGIT);
    unsigned* list = (unsigned*)(wsl + WS_LIST);
    bf16_t* winT = (bf16_t*)(wsl + WS_WINT);
    bf16_t* woutT = (bf16_t*)(wsl + WS_WOUTT);
    bf16_t* rt = (bf16_t*)(wsl + WS_RT);
    bf16_t* w13T = (bf16_t*)(wsl + WS_W13T);
    bf16_t* w2T = (bf16_t*)(wsl + WS_W2T);
    bf16_t* hb = (bf16_t*)(wsl + WS_HB);
    uint2* bmt = (uint2*)(wsl + WS_BMT);
    bf16_t* proj = (bf16_t*)(wsl + WS_PROJ);
    bf16_t* act = (bf16_t*)(wsl + WS_ACT);
    bf16_t* ys = (bf16_t*)(wsl + WS_YS);
    bf16_t* part_o = (bf16_t*)(wsl + WS_PARTO);
    float2* part_ml = (float2*)(wsl + WS_PARTML);
    unsigned* mlist = (unsigned*)(wsl + WS_MLIST);
    const float* modl = mod + (size_t)l * 4 * 6144;
    if (PROBE == 13) { GemmP P{}; P.A = hb; P.Bt = winT; P.lda = 1024; P.K = 1024; P.Obf = proj; P.ldo = PLD; gemm_phase<GM_INPROJ, 8, 1>(lds, P, T / 256, 14); GSYNC(); }
    if (PROBE == 14) { GemmP P{}; P.A = hb; P.Bt = winT; P.lda = 1024; P.K = 1024; P.Obf = proj; P.ldo = PLD; gemm_phase<GM_INPROJ, 8, 2>(lds, P, T / 256, 14); GSYNC(); }
    for (int rep = 0; rep < NREP(1); ++rep) {
      { GemmP P{}; P.A = hb; P.Bt = winT; P.lda = 1024; P.K = 1024; P.Obf = proj; P.ldo = PLD; gemm_phase<GM_INPROJ, 8>(lds, P, T / 256, 14); }
      GSYNC();
    }
    for (int u = bid; u < NB * 32; u += nblk) kmean_unit(lds, u, proj, kmean);
    GSYNC();
    unsigned* mcnt = ctl + CW_MC + l * 768;
    if (PROBE >= 10 && PROBE <= 12) {
      for (int u = bid; u < NB * 512; u += nblk) dsa_select_unit<(PROBE >= 10 && PROBE <= 12) ? PROBE - 9 : 1>(lds, proj, bmt, u & 3, 511 - (u >> 2));
      GSYNC();
    }
    for (int rep = 0; rep < NREP(2); ++rep) {
      for (int u = bid; u < NB * 512 + T / 64; u += nblk) {
        if (u < NB * 512) dsa_select_unit<0>(lds, proj, bmt, u & 3, 511 - (u >> 2));
        else if (rep == 0) gate_unit(lds, u - NB * 512, proj, kmean, mcnt, mlist);
      }
      GSYNC();
    }
    if (PROBE == 3) {
      attn_queue_phase(lds, proj, hb, bmt, part_o, part_ml, mcnt, mlist, ctl + CW_Q + 2 + l, p.w1 + (size_t)l * 32 * 1024 * 512, p.w3 + (size_t)l * 32 * 1024 * 512, p.w2 + (size_t)l * 32 * 512 * 1024, w13T, w2T,
                     p.conv_w + (size_t)l * 31 * 256, p.conv_b + l * 256, p.cln_g + l * 256, p.cln_b + l * 256);
      GSYNC();
    }
    attn_queue_phase(lds, proj, hb, bmt, part_o, part_ml, mcnt, mlist, ctl + CW_Q + l, p.w1 + (size_t)l * 32 * 1024 * 512, p.w3 + (size_t)l * 32 * 1024 * 512, p.w2 + (size_t)l * 32 * 512 * 1024, w13T, w2T,
                     p.conv_w + (size_t)l * 31 * 256, p.conv_b + l * 256, p.cln_g + l * 256, p.cln_b + l * 256);
    GSYNC();
    mixfin_phase(hb, p.moba_g + l * 384, p.dsa_g + l * 384, part_o, part_ml);
    GSYNC();
    { GemmP P{}; P.A = hb; P.Bt = woutT; P.lda = 1024; P.K = 1024; P.xin = (l == 0) ? p.x : out; P.xout = out; P.gvec = modl + 2048; gemm_phase<GM_OUTPROJ, 8>(lds, P, T / 256, 4); }
    GSYNC();
    for (int rep = 0; rep < NREP(4); ++rep) {
      rmsmod_phase(out, p.norm2_g + l * 1024, modl + 3072, modl + 4096, hb);
      GSYNC();
    }
    for (int rep = 0; rep < NREP(5); ++rep) {
      { GemmP P{}; P.A = hb; P.Bt = rt; P.lda = 1024; P.K = 1024; P.logits = logits; gemm_phase<GM_ROUTER, 4>(lds, P, T / 256, 1); }
      GSYNC();
    }
    int* cntl = (int*)(ctl + CW_CNT + l * 32);
    route_phase(lds, logits, p.rgb + l * 4, p.reb + l * 32, list, cntl, gate);
    GSYNC();
    for (int rep = 0; rep < NREP(6); ++rep) {
      { GemmP P{}; P.A = hb; P.Bt = w13T; P.lda = 1024; P.K = 1024; P.Obf = act; P.list = list; P.cnt = cntl; P.gate = gate; gemm_phase<GM_MOE1, 8>(lds, P, 0, 0); }
      GSYNC();
    }
    for (int rep = 0; rep < NREP(7); ++rep) {
      { GemmP P{}; P.A = act; P.Bt = w2T; P.lda = 512; P.K = 512; P.Obf = ys; P.list = list; P.cnt = cntl; P.gate = gate; gemm_phase<GM_MOE2, 8>(lds, P, 0, 0); }
      GSYNC();
    }
    for (int rep = 0; rep < NREP(9) - 1; ++rep) { GSYNC(); GSYNC(); GSYNC(); GSYNC(); GSYNC(); GSYNC(); GSYNC(); GSYNC(); GSYNC(); GSYNC(); }
    if (l == 0) {
      const float* mod1 = mod + (size_t)4 * 6144;
      combine_phase(out, ys, modl + 5120, 0, p.norm1_g + 1024, mod1 + 0, mod1 + 1024, hb);
      prep_small_units(lds, bid, nblk, p.w_in + (size_t)1024 * NIN, p.w_out + (size_t)1024 * 1024, p.rgw + 4096, p.rew + 32768, winT, woutT, rt);
      GSYNC();
    } else {
      combine_phase(out, ys, modl + 5120, 1, p.final_g, nullptr, nullptr, nullptr);
    }
  }
}

extern "C" void kernel_launch(void* const* d_in, const int* in_sizes, int n_in, void* d_out, int out_size, void* d_ws, size_t ws_size, hipStream_t stream) {
  if (ws_size < WS_END) return;
  MegaP p{};
  p.x = (const float*)d_in[0]; p.c = (const float*)d_in[1]; p.ada_w = (const float*)d_in[2]; p.ada_b = (const float*)d_in[3]; p.norm1_g = (const float*)d_in[4];
  p.w_in = (const float*)d_in[5]; p.conv_w = (const float*)d_in[6]; p.conv_b = (const float*)d_in[7]; p.cln_g = (const float*)d_in[8]; p.cln_b = (const float*)d_in[9];
  p.moba_g = (const float*)d_in[10]; p.dsa_g = (const float*)d_in[11]; p.w_out = (const float*)d_in[12]; p.norm2_g = (const float*)d_in[13]; p.rgw = (const float*)d_in[14];
  p.rgb = (const float*)d_in[15]; p.rew = (const float*)d_in[16]; p.reb = (const float*)d_in[17]; p.w1 = (const float*)d_in[18]; p.w3 = (const float*)d_in[19];
  p.w2 = (const float*)d_in[20]; p.final_g = (const float*)d_in[21];
  p.out = (float*)d_out; p.ws = (char*)d_ws;
  static int grid_blocks = 0;
  if (!grid_blocks) {
    int dev = 0, cus = 0, per_cu = 0;
    (void)hipGetDevice(&dev);
    (void)hipDeviceGetAttribute(&cus, hipDeviceAttributeMultiprocessorCount, dev);
    (void)hipFuncSetAttribute((const void*)mega, hipFuncAttributeMaxDynamicSharedMemorySize, MEGA_LDS);
    (void)hipOccupancyMaxActiveBlocksPerMultiprocessor(&per_cu, (const void*)mega, NTHR, MEGA_LDS);
    if (per_cu < 1) per_cu = 1;
    if (per_cu > 1) per_cu = 1;
    grid_blocks = cus * per_cu;
  }
  (void)hipMemsetAsync((char*)d_ws + WS_CTL, 0, 32768, stream);
  void* args[] = {&p};
  (void)hipLaunchCooperativeKernel((const void*)mega, dim3(grid_blocks), dim3(NTHR), args, MEGA_LDS, stream);
}
```

```cpp
#include <hip/hip_runtime.h>
#include <hip/hip_cooperative_groups.h>
namespace cg = cooperative_groups;
#include <stdint.h>

#define DI __device__ __forceinline__
typedef unsigned short bf16_t;
typedef short bf16x8 __attribute__((ext_vector_type(8)));
typedef short s16x4 __attribute__((ext_vector_type(4)));
typedef float f32x4 __attribute__((ext_vector_type(4)));
typedef float f32x16 __attribute__((ext_vector_type(16)));
typedef unsigned u32x4 __attribute__((ext_vector_type(4)));
typedef unsigned u32x2 __attribute__((ext_vector_type(2)));
typedef float f32x2_t __attribute__((ext_vector_type(2)));
typedef __bf16 bf16x2_t __attribute__((ext_vector_type(2)));
#define LAS __attribute__((address_space(3)))

constexpr int NB = 4, S = 8192, T = NB * S, D = 1024;
constexpr int PLD = 3456;
constexpr int C_QM = 0, C_KM = 384, C_VM = 768, C_CA = 1152, C_CG = 1408, C_QD = 1664, C_KD = 2048, C_VD = 2432, C_QI = 2816, C_KI = 3328, C_WI = 3392;
constexpr int NIN = 3400;
constexpr float EPS = 1e-6f;
constexpr int NTHR = 512;

constexpr size_t MiB = 1u << 20;
constexpr size_t WS_CTL = 0;
constexpr size_t WS_MOD = 1 * MiB;
constexpr size_t WS_KMEAN = WS_MOD + 256 * 1024;
constexpr size_t WS_SELM = WS_KMEAN + 256 * 1024;
constexpr size_t WS_GATE = WS_SELM + 1 * MiB;
constexpr size_t WS_LOGIT = WS_GATE + 512 * 1024;
constexpr size_t WS_LIST = WS_LOGIT + 5 * MiB;
constexpr size_t WS_WINT = WS_LIST + 8 * MiB;
constexpr size_t WS_WOUTT = WS_WINT + 7 * MiB;
constexpr size_t WS_RT = WS_WOUTT + 2 * MiB;
constexpr size_t WS_W13T = WS_RT + 1 * MiB;
constexpr size_t WS_W2T = WS_W13T + 64 * MiB;
constexpr size_t WS_HB = WS_W2T + 32 * MiB;
constexpr size_t WS_BMT = WS_HB + 64 * MiB;
constexpr size_t WS_PROJ = WS_BMT + 32 * MiB;
constexpr size_t WS_ACT = WS_PROJ;
constexpr size_t WS_YS = WS_PROJ + 64 * MiB;
constexpr size_t WS_PARTO = WS_PROJ + 216 * MiB;
constexpr size_t WS_PARTML = WS_PARTO + 96 * MiB;
constexpr size_t WS_MLIST = WS_PARTML + 6 * MiB;
constexpr size_t WS_END = WS_MLIST + 24 * MiB;
constexpr int CW_CNT = 0;
constexpr int CW_Q = 64;
constexpr int CW_MC = 5120;

DI int otid() { int t = threadIdx.x; asm volatile("" : "+v"(t)); return t; }
DI void st_wt32(unsigned* p, unsigned v) { __hip_atomic_store(p, v, __ATOMIC_RELAXED, __HIP_MEMORY_SCOPE_AGENT); }
DI void st_wt64(unsigned long long* p, unsigned long long v) { __hip_atomic_store(p, v, __ATOMIC_RELAXED, __HIP_MEMORY_SCOPE_AGENT); }
DI float bf2f(bf16_t b) { return __uint_as_float(((unsigned)b) << 16); }
DI float bflo(unsigned u) { return __uint_as_float(u << 16); }
DI float bfhi(unsigned u) { return __uint_as_float(u & 0xffff0000u); }
DI unsigned cvtpk(float lo, float hi) { f32x2_t v = {lo, hi}; bf16x2_t b = __builtin_convertvector(v, bf16x2_t); return __builtin_bit_cast(unsigned, b); }
DI float fexp2(float x) { return __builtin_amdgcn_exp2f(x); }
DI float frcp(float x) { return __builtin_amdgcn_rcpf(x); }
DI float silu_f(float x) { return x * frcp(1.f + fexp2(x * -1.4426950408889634f)); }
DI float wave_sum(float v) {
#pragma unroll
  for (int o = 32; o >= 1; o >>= 1) v += __shfl_xor(v, o);
  return v;
}
#define DPP_STEP(OPF, v, ident, ctrl, rmask) v = OPF(v, (unsigned)__builtin_amdgcn_update_dpp((int)(ident), (int)(v), ctrl, rmask, 0xf, false))
DI unsigned opadd(unsigned a, unsigned b) { return a + b; }
DI unsigned opmin(unsigned a, unsigned b) { return min(a, b); }
DI unsigned opmax(unsigned a, unsigned b) { return max(a, b); }
DI unsigned scan_add(unsigned v) {
  DPP_STEP(opadd, v, 0u, 0x111, 0xf); DPP_STEP(opadd, v, 0u, 0x112, 0xf); DPP_STEP(opadd, v, 0u, 0x114, 0xf); DPP_STEP(opadd, v, 0u, 0x118, 0xf);
  DPP_STEP(opadd, v, 0u, 0x142, 0xa); DPP_STEP(opadd, v, 0u, 0x143, 0xc); return v;
}
DI unsigned red_add(unsigned v) { return (unsigned)__builtin_amdgcn_readlane((int)scan_add(v), 63); }
DI unsigned red_min(unsigned v) {
  DPP_STEP(opmin, v, 0xffffffffu, 0x111, 0xf); DPP_STEP(opmin, v, 0xffffffffu, 0x112, 0xf); DPP_STEP(opmin, v, 0xffffffffu, 0x114, 0xf); DPP_STEP(opmin, v, 0xffffffffu, 0x118, 0xf);
  DPP_STEP(opmin, v, 0xffffffffu, 0x142, 0xa); DPP_STEP(opmin, v, 0xffffffffu, 0x143, 0xc); return (unsigned)__builtin_amdgcn_readlane((int)v, 63);
}
DI unsigned red_max(unsigned v) {
  DPP_STEP(opmax, v, 0u, 0x111, 0xf); DPP_STEP(opmax, v, 0u, 0x112, 0xf); DPP_STEP(opmax, v, 0u, 0x114, 0xf); DPP_STEP(opmax, v, 0u, 0x118, 0xf);
  DPP_STEP(opmax, v, 0u, 0x142, 0xa); DPP_STEP(opmax, v, 0u, 0x143, 0xc); return (unsigned)__builtin_amdgcn_readlane((int)v, 63);
}
#define MFMA16(a, b, c) __builtin_amdgcn_mfma_f32_16x16x32_bf16((a), (b), (c), 0, 0, 0)
#define MFMA32(a, b, c) __builtin_amdgcn_mfma_f32_32x32x16_bf16((a), (b), (c), 0, 0, 0)

DI void mod_units(char* lds, int ubase, int nblk, const float* __restrict__ c, const float* __restrict__ ada_w, const float* __restrict__ ada_b, float* __restrict__ mod) {
  float (*sc)[1024] = (float (*)[1024])lds;
  float (*red)[4][64] = (float (*)[4][64])(lds + 16384);
  const int tid = otid();
  bool loaded = false;
  for (int u = ubase; u < 2 * 96; u += nblk) {
    if (!loaded) { for (int i = tid; i < 4096; i += NTHR) sc[i >> 10][i & 1023] = silu_f(c[i]); __syncthreads(); loaded = true; }
    const int l = u / 96, n = (u % 96) * 64 + (tid & 63), ks = tid >> 6;
    const float* w = ada_w + (size_t)l * 1024 * 6144 + n;
    float a0 = 0.f, a1 = 0.f, a2 = 0.f, a3 = 0.f;
#pragma unroll 8
    for (int k = ks * 128; k < ks * 128 + 128; ++k) {
      const float wv = w[(size_t)k * 6144];
      a0 += sc[0][k] * wv; a1 += sc[1][k] * wv; a2 += sc[2][k] * wv; a3 += sc[3][k] * wv;
    }
    red[ks][0][tid & 63] = a0; red[ks][1][tid & 63] = a1; red[ks][2][tid & 63] = a2; red[ks][3][tid & 63] = a3;
    __syncthreads();
    if (tid < 256) {
      const int b = tid >> 6, nn = tid & 63;
      float s = 0.f;
#pragma unroll
      for (int k = 0; k < 8; ++k) s += red[k][b][nn];
      const int ncol = (u % 96) * 64 + nn;
      mod[((size_t)l * 4 + b) * 6144 + ncol] = s + ada_b[(size_t)l * 6144 + ncol];
    }
    __syncthreads();
  }
}

struct TJob { const float* src; bf16_t* dst; int R, C, Cpad, grp, stride, off; };

DI void transpose_tile_wave(const TJob& J, int tr, int tc, float (*tile)[65], int lane) {
#pragma unroll 1
  for (int hf = 0; hf < 2; ++hf) {
    float4 v[8];
#pragma unroll
    for (int p = 0; p < 8; ++p) {
      const int r = (lane >> 4) + (hf * 8 + p) * 4, c4 = (lane & 15) * 4;
      const int gr = tr * 64 + r, gc = tc * 64 + c4;
      v[p] = make_float4(0.f, 0.f, 0.f, 0.f);
      if (gc + 3 < J.C) v[p] = *(const float4*)(J.src + (size_t)gr * J.C + gc);
      else { float t4[4] = {0.f, 0.f, 0.f, 0.f}; for (int q = 0; q < 4; ++q) if (gc + q < J.C) t4[q] = J.src[(size_t)gr * J.C + gc + q]; v[p] = make_float4(t4[0], t4[1], t4[2], t4[3]); }
    }
#pragma unroll
    for (int p = 0; p < 8; ++p) {
      const int r = (lane >> 4) + (hf * 8 + p) * 4, c4 = (lane & 15) * 4;
      tile[r][c4 + 0] = v[p].x; tile[r][c4 + 1] = v[p].y; tile[r][c4 + 2] = v[p].z; tile[r][c4 + 3] = v[p].w;
    }
  }
  __builtin_amdgcn_fence(__ATOMIC_RELEASE, "wavefront");
  __builtin_amdgcn_wave_barrier();
#pragma unroll
  for (int p = 0; p < 8; ++p) {
    const int n = (lane >> 3) + p * 8, kc = lane & 7;
    const int gc = tc * 64 + n;
    if (gc < J.Cpad) {
      const int drow = (gc / J.grp) * J.stride + J.off + (gc % J.grp);
      u32x4 o;
      o.x = cvtpk(tile[kc * 8 + 0][n], tile[kc * 8 + 1][n]); o.y = cvtpk(tile[kc * 8 + 2][n], tile[kc * 8 + 3][n]);
      o.z = cvtpk(tile[kc * 8 + 4][n], tile[kc * 8 + 5][n]); o.w = cvtpk(tile[kc * 8 + 6][n], tile[kc * 8 + 7][n]);
      *(u32x4*)(J.dst + (size_t)drow * J.R + tr * 64 + kc * 8) = o;
    }
  }
  __builtin_amdgcn_fence(__ATOMIC_RELEASE, "wavefront");
  __builtin_amdgcn_wave_barrier();
}

constexpr int WINT_ROWS = 3584;
constexpr int PREP_UNITS = 896 + 256 + 32 * 384;
DI void prep_unit(int u, const float* w_in, const float* w_out, const float* w1, const float* w3, const float* w2,
                  bf16_t* winT, bf16_t* woutT, bf16_t* w13T, bf16_t* w2T, float (*tile)[65], int lane) {
  TJob J; int tr, tc;
  if (u < 896) { J = TJob{w_in, winT, 1024, NIN, WINT_ROWS, 1 << 30, 0, 0}; tr = u % 16; tc = u / 16; }
  else if (u < 1152) { u -= 896; J = TJob{w_out, woutT, 1024, 1024, 1024, 1 << 30, 0, 0}; tr = u % 16; tc = u / 16; }
  else {
    u -= 1152; const int e = u / 384; int r = u % 384;
    if (r < 128) { J = TJob{w1 + (size_t)e * 1024 * 512, w13T + (size_t)e * 1024 * 1024, 1024, 512, 512, 32, 64, 0}; tr = r % 16; tc = r / 16; }
    else if (r < 256) { r -= 128; J = TJob{w3 + (size_t)e * 1024 * 512, w13T + (size_t)e * 1024 * 1024, 1024, 512, 512, 32, 64, 32}; tr = r % 16; tc = r / 16; }
    else { r -= 256; J = TJob{w2 + (size_t)e * 512 * 1024, w2T + (size_t)e * 1024 * 512, 512, 1024, 1024, 1 << 30, 0, 0}; tr = r % 8; tc = r / 8; }
  }
  transpose_tile_wave(J, tr, tc, tile, lane);
}

DI void prep_rt_unit(int u, const float* __restrict__ rgw, const float* __restrict__ rew, bf16_t* __restrict__ rt) {
#pragma unroll
  for (int q = 0; q < 4; ++q) {
    const int i = u * 2048 + q * NTHR + threadIdx.x;
    const int n = i >> 10, k = i & 1023;
    float v = 0.f;
    if (n < 4) v = rgw[k * 4 + n]; else if (n < 36) v = rew[k * 32 + (n - 4)];
    rt[i] = (bf16_t)(cvtpk(v, 0.f) & 0xffffu);
  }
}
constexpr int PREP_SMALL = 896 + 256;
constexpr int PREP_EXP_ITEMS = (32 * 384) / 8;
DI void prep_small_units(char* lds, int ubase, int nblk, const float* w_in, const float* w_out, const float* rgw, const float* rew, bf16_t* winT, bf16_t* woutT, bf16_t* rt) {
  const int tid = otid(), lane = tid & 63, wid = tid >> 6;
  float (*tile)[65] = (float (*)[65])(lds + wid * 16640);
  for (int u = ubase * 8 + wid; u < PREP_SMALL; u += nblk * 8) prep_unit(u, w_in, w_out, nullptr, nullptr, nullptr, winT, woutT, nullptr, nullptr, tile, lane);
  for (int u = ubase; u < 64; u += nblk) prep_rt_unit(u, rgw, rew, rt);
  __syncthreads();
}
DI void prep_exp_item(char* lds, int item, const float* w1, const float* w3, const float* w2, bf16_t* w13T, bf16_t* w2T) {
  const int tid = otid(), lane = tid & 63, wid = tid >> 6;
  float (*tile)[65] = (float (*)[65])(lds + wid * 16640);
  prep_unit(PREP_SMALL + item * 8 + wid, nullptr, nullptr, w1, w3, w2, nullptr, nullptr, w13T, w2T, tile, lane);
  __syncthreads();
}

DI void wave_sum4(float (&v)[4]) {
#pragma unroll
  for (int o = 32; o >= 1; o >>= 1) {
    float t[4];
#pragma unroll
    for (int r = 0; r < 4; ++r) t[r] = __shfl_xor(v[r], o);
#pragma unroll
    for (int r = 0; r < 4; ++r) v[r] += t[r];
  }
}
DI void rmsmod_phase(const float* __restrict__ x, const float* __restrict__ g, const float* __restrict__ mod_sh, const float* __restrict__ mod_sc, bf16_t* __restrict__ h) {
  const int tid_ = otid(); const int lane = tid_ & 63, wid = tid_ >> 6;
  for (int row0 = (blockIdx.x * 8 + wid) * 4; row0 < T; row0 += gridDim.x * 32) {
    const int b = row0 >> 13;
    float4 v[4][4]; float ss[4];
#pragma unroll
    for (int r = 0; r < 4; ++r) {
      const float* xr = x + (size_t)(row0 + r) * D;
      ss[r] = 0.f;
#pragma unroll
      for (int i = 0; i < 4; ++i) { v[r][i] = *(const float4*)(xr + i * 256 + lane * 4); }
    }
#pragma unroll
    for (int r = 0; r < 4; ++r)
#pragma unroll
      for (int i = 0; i < 4; ++i) ss[r] += v[r][i].x * v[r][i].x + v[r][i].y * v[r][i].y + v[r][i].z * v[r][i].z + v[r][i].w * v[r][i].w;
    wave_sum4(ss);
#pragma unroll
    for (int i = 0; i < 4; ++i) {
      const int col = i * 256 + lane * 4;
      const float4 gg = *(const float4*)(g + col), sc = *(const float4*)(mod_sc + (size_t)b * 6144 + col), sh = *(const float4*)(mod_sh + (size_t)b * 6144 + col);
#pragma unroll
      for (int r = 0; r < 4; ++r) {
        const float rstd = rsqrtf(ss[r] * (1.f / 1024.f) + EPS);
        const float o0 = v[r][i].x * rstd * gg.x * (1.f + sc.x) + sh.x, o1 = v[r][i].y * rstd * gg.y * (1.f + sc.y) + sh.y;
        const float o2 = v[r][i].z * rstd * gg.z * (1.f + sc.z) + sh.z, o3 = v[r][i].w * rstd * gg.w * (1.f + sc.w) + sh.w;
        u32x2 o; o.x = cvtpk(o0, o1); o.y = cvtpk(o2, o3);
        *(u32x2*)(h + (size_t)(row0 + r) * D + col) = o;
      }
    }
  }
}

enum { GM_INPROJ = 0, GM_OUTPROJ = 1, GM_ROUTER = 2, GM_MOE1 = 3, GM_MOE2 = 4 };
struct GemmP {
  const bf16_t* A; const bf16_t* Bt; int lda; int K;
  bf16_t* Obf; int ldo;
  const float* xin; float* xout; const float* gvec;
  float* logits;
  const unsigned* list; const int* cnt; const float* gate;
};
constexpr int GEMM_LDS = 98304 + 1024;

template <int MODE, int NJ, int VAR = 0>
DI void gemm_tile(char* lds, const GemmP& P, const bf16_t* __restrict__ Bt, int m0, int n0, int nvalid, const unsigned* lst, int ebase) {
  constexpr int BN = 32 * NJ, STG = 32768 + BN * 128, NBP = BN / 64;
  const int tid = otid(), lane = tid & 63, wid = __builtin_amdgcn_readfirstlane(tid >> 6), fr = lane & 15, fq = lane >> 4;
  const int wm = wid >> 1, wn = wid & 1;
  const int K = P.K;
  int* ridx = (int*)(lds + 2 * STG);
  if (MODE == GM_MOE1) {
    if (tid < 256) { const int r = tid < nvalid ? tid : 0; ridx[tid] = (int)(lst[r] >> 1); }
    __syncthreads();
  }
  const int prow = lane >> 3, pkc = (lane & 7) ^ (lane >> 3);
  const bf16_t* ap[4];
#pragma unroll
  for (int i = 0; i < 4; ++i) {
    const int row = 8 * (wid + 8 * i) + prow;
    size_t grow;
    if (MODE == GM_MOE1) grow = (size_t)ridx[row];
    else if (MODE == GM_MOE2) grow = (size_t)(ebase + (row < nvalid ? row : 0));
    else grow = (size_t)(m0 + row);
    ap[i] = P.A + grow * P.lda + pkc * 8;
  }
  const bf16_t* bp[NBP];
#pragma unroll
  for (int i = 0; i < NBP; ++i) {
    const int row = 8 * (wid + 8 * i) + prow;
    bp[i] = Bt + (size_t)(n0 + row) * K + pkc * 8;
  }
  f32x4 acc[4][NJ];
#pragma unroll
  for (int i = 0; i < 4; ++i)
#pragma unroll
    for (int j = 0; j < NJ; ++j) acc[i][j] = (f32x4){0.f, 0.f, 0.f, 0.f};
  LAS char* lds3 = (LAS char*)lds;
#define GEMM_STAGE(st, kt_) do { \
    _Pragma("unroll") for (int i = 0; i < 4; ++i) __builtin_amdgcn_global_load_lds((const unsigned*)(ap[i] + (kt_) * 64), (LAS unsigned*)(lds3 + (st) * STG + (wid + 8 * i) * 1024), 16, 0, 0); \
    _Pragma("unroll") for (int i = 0; i < NBP; ++i) __builtin_amdgcn_global_load_lds((const unsigned*)(bp[i] + (kt_) * 64), (LAS unsigned*)(lds3 + (st) * STG + 32768 + (wid + 8 * i) * 1024), 16, 0, 0); \
  } while (0)
#define GEMM_PIECE(st, kt_, q) do { \
    if ((q) < 4) __builtin_amdgcn_global_load_lds((const unsigned*)(ap[(q)] + (kt_) * 64), (LAS unsigned*)(lds3 + (st) * STG + (wid + 8 * (q)) * 1024), 16, 0, 0); \
    else if ((q) - 4 < NBP) __builtin_amdgcn_global_load_lds((const unsigned*)(bp[((q) - 4) < NBP ? (q) - 4 : 0] + (kt_) * 64), (LAS unsigned*)(lds3 + (st) * STG + 32768 + (wid + 8 * ((q) - 4)) * 1024), 16, 0, 0); \
  } while (0)
#define GEMM_LDA(i, base, ko) a[i] = *(const bf16x8*)((base) + (arow + (i) * 16) * 128 + (ko))
#define GEMM_LDB(j, base, ko) b[j] = *(const bf16x8*)((base) + 32768 + (brow + (j) * 16) * 128 + (ko))
#define GEMM_SB __builtin_amdgcn_sched_barrier(0)
#define GEMM_BLOCK(RL, DM, base, ko, st, kt_) do { \
    _Pragma("unroll") for (int j = 0; j < NJ; ++j) acc[0][j] = MFMA16(b[j], a[0], acc[0][j]); \
    if (RL) GEMM_LDA(0, base, ko); \
    if (DM) { GEMM_PIECE(st, kt_, 0); GEMM_PIECE(st, kt_, 1); } \
    GEMM_SB; \
    _Pragma("unroll") for (int j = 0; j < NJ; ++j) acc[1][j] = MFMA16(b[j], a[1], acc[1][j]); \
    if (RL) GEMM_LDA(1, base, ko); \
    if (DM) { GEMM_PIECE(st, kt_, 2); GEMM_PIECE(st, kt_, 3); } \
    GEMM_SB; \
    _Pragma("unroll") for (int j = 0; j < NJ; ++j) { \
      acc[2][j] = MFMA16(b[j], a[2], acc[2][j]); \
      acc[3][j] = MFMA16(b[j], a[3], acc[3][j]); \
      if (RL) GEMM_LDB(j, base, ko); \
      if (DM && (j & 1) == 0) GEMM_PIECE(st, kt_, 4 + (j >> 1)); \
      GEMM_SB; \
    } \
    if (RL) { GEMM_LDA(2, base, ko); GEMM_LDA(3, base, ko); } \
    GEMM_SB; \
  } while (0)
  const int nk = K >> 6;
  const int arow = wm * 64 + fr, brow = wn * (BN / 2) + fr, sw = fr & 7;
  const int ko0 = (fq ^ sw) << 4, ko1 = ((4 + fq) ^ sw) << 4;
  bf16x8 a[4], b[NJ];
  GEMM_STAGE(0, 0);
  asm volatile("s_waitcnt vmcnt(0)" ::: "memory");
  __syncthreads();
  if (VAR != 1) GEMM_STAGE(1, 1);
#pragma unroll
  for (int i = 0; i < 4; ++i) GEMM_LDA(i, lds, ko0);
#pragma unroll
  for (int j = 0; j < NJ; ++j) GEMM_LDB(j, lds, ko0);
  for (int kt = 0; kt < nk; ++kt) {
    const int cur = kt & 1;
    const char* sb = lds + cur * STG;
    const char* sn = lds + (cur ^ 1) * STG;
    GEMM_BLOCK(true, false, sb, ko1, 0, 0);
    asm volatile("s_waitcnt vmcnt(0) lgkmcnt(0)" ::: "memory");
    __syncthreads();
    const int kn = min(kt + 2, nk - 1);
    GEMM_BLOCK(true, VAR != 1, sn, ko0, cur, kn);
  }
  asm volatile("s_waitcnt vmcnt(0)" ::: "memory");
#undef GEMM_BLOCK
#undef GEMM_SB
#undef GEMM_LDA
#undef GEMM_LDB
#undef GEMM_PIECE
#undef GEMM_STAGE
  const int nw0 = n0 + wn * (BN / 2);
#pragma unroll
  for (int i = 0; i < 4; ++i) {
    const int ml = wm * 64 + i * 16 + fr;
    const int m = m0 + ml;
    if (MODE == GM_INPROJ) {
#pragma unroll
      for (int j = 0; j < NJ; ++j) {
        const int n = nw0 + j * 16 + fq * 4;
        if (n < P.ldo) {
          u32x2 o; o.x = cvtpk(acc[i][j][0], acc[i][j][1]); o.y = cvtpk(acc[i][j][2], acc[i][j][3]);
          *(u32x2*)(P.Obf + (size_t)m * P.ldo + n) = o;
        }
      }
    } else if (MODE == GM_OUTPROJ) {
      const int b = m >> 13;
#pragma unroll
      for (int j = 0; j < NJ; ++j) {
        const int n = nw0 + j * 16 + fq * 4;
        const float4 xi = *(const float4*)(P.xin + (size_t)m * D + n);
        const float4 gv = *(const float4*)(P.gvec + (size_t)b * 6144 + n);
        float4 o; o.x = xi.x + gv.x * acc[i][j][0]; o.y = xi.y + gv.y * acc[i][j][1]; o.z = xi.z + gv.z * acc[i][j][2]; o.w = xi.w + gv.w * acc[i][j][3];
        *(float4*)(P.xout + (size_t)m * D + n) = o;
      }
    } else if (MODE == GM_ROUTER) {
#pragma unroll
      for (int j = 0; j < NJ; ++j) {
        const int n = nw0 + j * 16 + fq * 4;
        if (n < 36) { float4 o; o.x = acc[i][j][0]; o.y = acc[i][j][1]; o.z = acc[i][j][2]; o.w = acc[i][j][3]; *(float4*)(P.logits + (size_t)m * 36 + n) = o; }
      }
    } else if (MODE == GM_MOE1) {
      if (ml < nvalid) {
#pragma unroll
        for (int jb2 = 0; jb2 < NJ / 4; ++jb2) {
          const int jb = (nw0 >> 6) + jb2;
#pragma unroll
          for (int j = 0; j < 2; ++j) {
            const int col = jb * 32 + j * 16 + fq * 4;
            float v[4];
#pragma unroll
            for (int q = 0; q < 4; ++q) v[q] = silu_f(acc[i][4 * jb2 + j][q]) * acc[i][4 * jb2 + j + 2][q];
            u32x2 o; o.x = cvtpk(v[0], v[1]); o.y = cvtpk(v[2], v[3]);
            *(u32x2*)(P.Obf + (size_t)(ebase + ml) * 512 + col) = o;
          }
        }
      }
    } else if (MODE == GM_MOE2) {
      if (ml < nvalid) {
        const unsigned slot = lst[ml];
        const float gt = P.gate[slot];
#pragma unroll
        for (int j = 0; j < NJ; ++j) {
          const int n = nw0 + j * 16 + fq * 4;
          u32x2 o; o.x = cvtpk(acc[i][j][0] * gt, acc[i][j][1] * gt); o.y = cvtpk(acc[i][j][2] * gt, acc[i][j][3] * gt);
          *(u32x2*)(P.Obf + (size_t)slot * 1024 + n) = o;
        }
      }
    }
  }
  __syncthreads();
}

template <int MODE, int NJ, int VAR = 0>
DI void gemm_phase(char* lds, const GemmP& P, int ntm, int ntn) {
  constexpr int BN = 32 * NJ;
  const int xcd = blockIdx.x & 7, bi = blockIdx.x >> 3, nbx = gridDim.x >> 3;
  const bool xo = (gridDim.x & 7) == 0;
  if (MODE == GM_MOE1 || MODE == GM_MOE2) {
    constexpr int NNT = 1024 / BN;
    if (xo) {
      int ce[4], tm[4], eb[4];
      {
        int acc_ = 0, q = 0;
#pragma unroll
        for (int k = 0; k < 4; ++k) {
          const int e = xcd + 8 * k;
          for (; q < e; ++q) acc_ += P.cnt[q];
          eb[k] = acc_; ce[k] = P.cnt[e]; tm[k] = (ce[k] + 255) >> 8;
        }
      }
      const int total = (tm[0] + tm[1] + tm[2] + tm[3]) * NNT;
      const int nfull = (total / nbx) * nbx;
      const int nhalf = (NJ == 8) ? 2 * (total - nfull) : 0;
      for (int it = bi; it < nfull + ((NJ == 8) ? nhalf : total - nfull); it += nbx) {
        const bool half = (NJ == 8) && it >= nfull;
        const int j = half ? nfull + ((it - nfull) >> 1) : it;
        int k = 0, r = j;
        if (r >= tm[0] * NNT) { r -= tm[0] * NNT; k = 1; if (r >= tm[1] * NNT) { r -= tm[1] * NNT; k = 2; if (r >= tm[2] * NNT) { r -= tm[2] * NNT; k = 3; } } }
        const int cek = k == 0 ? ce[0] : k == 1 ? ce[1] : k == 2 ? ce[2] : ce[3];
        const int ebk = k == 0 ? eb[0] : k == 1 ? eb[1] : k == 2 ? eb[2] : eb[3];
        const int e = xcd + 8 * k, mt = r / NNT, nt = r % NNT;
        const int nvalid = min(256, cek - mt * 256);
        const unsigned* lst = P.list + (size_t)e * 65536 + mt * 256;
        const bf16_t* Bt = P.Bt + (size_t)e * 1024 * P.K;
        if (half) gemm_tile<MODE, (NJ == 8) ? 4 : NJ, VAR>(lds, P, Bt, mt * 256, nt * BN + ((it - nfull) & 1) * (BN / 2), nvalid, lst, ebk + mt * 256);
        else gemm_tile<MODE, NJ, VAR>(lds, P, Bt, mt * 256, nt * BN, nvalid, lst, ebk + mt * 256);
      }
    } else {
      int total_mt = 0;
      for (int e = 0; e < 32; ++e) total_mt += (P.cnt[e] + 255) >> 8;
      const int total = total_mt * NNT;
      for (int u = blockIdx.x; u < total; u += gridDim.x) {
        int e = 0, rem = u, ebase = 0;
        for (;;) { const int c = P.cnt[e]; const int te = ((c + 255) >> 8) * NNT; if (rem < te) break; rem -= te; ebase += c; ++e; }
        const int ce = P.cnt[e], tme = (ce + 255) >> 8;
        const int nt = rem / tme, mt = rem % tme;
        const int nvalid = min(256, ce - mt * 256);
        const unsigned* lst = P.list + (size_t)e * 65536 + mt * 256;
        const bf16_t* Bt = P.Bt + (size_t)e * 1024 * P.K;
        gemm_tile<MODE, NJ, VAR>(lds, P, Bt, mt * 256, nt * BN, nvalid, lst, ebase + mt * 256);
      }
    }
  } else if (xo && (ntm & 7) == 0) {
    const int per = (ntm >> 3) * ntn;
    for (int j = bi; j < per; j += nbx) {
      const int mt = xcd + 8 * (j / ntn), nt = j % ntn;
      gemm_tile<MODE, NJ, VAR>(lds, P, P.Bt, mt * 256, nt * BN, 256, nullptr, 0);
    }
  } else {
    const int total = ntm * ntn;
    for (int u = blockIdx.x; u < total; u += gridDim.x) {
      const int nt = u / ntm, mt = u % ntm;
      gemm_tile<MODE, NJ, VAR>(lds, P, P.Bt, mt * 256, nt * BN, 256, nullptr, 0);
    }
  }
}

DI void kmean_unit(char* lds, int u, const bf16_t* __restrict__ proj, float* __restrict__ kmean) {
  float* red = (float*)lds;
  const int tid = otid();
  const int b = u >> 5, blk = u & 31;
  const int cc = tid % 48, rg = tid / 48;
  if (rg < 10) {
    const bf16_t* p = proj + (size_t)(b * S + blk * 256) * PLD + C_KM + cc * 8;
    float acc[8] = {0.f, 0.f, 0.f, 0.f, 0.f, 0.f, 0.f, 0.f};
#pragma unroll 13
    for (int r = rg; r < 256; r += 10) {
      const u32x4 v = *(const u32x4*)(p + (size_t)r * PLD);
      acc[0] += bflo(v.x); acc[1] += bfhi(v.x); acc[2] += bflo(v.y); acc[3] += bfhi(v.y);
      acc[4] += bflo(v.z); acc[5] += bfhi(v.z); acc[6] += bflo(v.w); acc[7] += bfhi(v.w);
    }
#pragma unroll
    for (int q = 0; q < 8; ++q) red[rg * 384 + cc * 8 + q] = acc[q];
  }
  __syncthreads();
  if (tid < 384) {
    float sm = 0.f;
#pragma unroll
    for (int g = 0; g < 10; ++g) sm += red[g * 384 + tid];
    kmean[((size_t)(b * 6 + tid / 64) * 32 + blk) * 64 + (tid & 63)] = sm * (1.f / 256.f);
  }
  __syncthreads();
}

constexpr int ATT_LDS = 32768;
constexpr float C2 = 0.125f * 1.4426950408889634f;
DI float max3f(float a, float b, float c) { return __builtin_fmaxf(__builtin_fmaxf(a, b), c); }
DI int crow(int r, int hi) { return (r & 3) + 8 * (r >> 2) + 4 * hi; }
typedef short v4i16_t __attribute__((ext_vector_type(4)));
DI s16x4 vtr(const LAS char* p) { return __builtin_bit_cast(s16x4, __builtin_amdgcn_ds_read_tr16_b64_v4i16((LAS v4i16_t*)p)); }

constexpr int ATT_ST = 65536;
struct AttState { float m, l; f32x16 o0, o1; };

template <int MODE>
DI void attn_stage(char* lds, int bufoff, const bf16_t* __restrict__ proj, int b, int h, int key0, int lane, int wid) {
  constexpr int KC = (MODE == 1) ? C_KD : C_KM, VC = (MODE == 1) ? C_VD : C_VM;
  LAS char* l3 = (LAS char*)lds + bufoff;
  const bf16_t* ks = proj + (size_t)(b * S + key0 + 8 * wid + (lane >> 3)) * PLD + KC + h * 64 + (((lane & 7) ^ (lane >> 3)) << 3);
  const bf16_t* vs = proj + (size_t)(b * S + key0 + 16 * (wid & 3) + (lane >> 2)) * PLD + VC + h * 64 + (wid >> 2) * 32 + ((lane & 3) << 3);
#pragma unroll
  for (int tt = 0; tt < 4; ++tt) {
    __builtin_amdgcn_global_load_lds((const unsigned*)(ks + (size_t)tt * 64 * PLD), (LAS unsigned*)(l3 + tt * 16384 + wid * 1024), 16, 0, 0);
    __builtin_amdgcn_global_load_lds((const unsigned*)(vs + (size_t)tt * 64 * PLD), (LAS unsigned*)(l3 + tt * 16384 + 8192 + (wid >> 2) * 4096 + (wid & 3) * 1024), 16, 0, 0);
  }
}

template <int MODE>
DI void attn_tile(char* lds, int tbuf, const bf16x8 (&qr)[4], AttState& st, uint2 w, int ktl, int qrel, int r32, int hi, int lane) {
  constexpr float THR = 8.f;
  const float NEGBIG = -3.0e38f;
  const char* kb = lds + tbuf;
  const int ksw = r32 & 7;
  f32x16 p0, p1;
  {
    f32x16 zz;
#pragma unroll
    for (int r = 0; r < 16; ++r) zz[r] = 0.f;
    const unsigned nmb = cvtpk(-st.m, 0.f);
    const bf16x8 kone = __builtin_bit_cast(bf16x8, (u32x4){hi ? 0u : 0x3F80u, 0u, 0u, 0u});
    const bf16x8 qm = __builtin_bit_cast(bf16x8, (u32x4){nmb, 0u, 0u, 0u});
    p0 = MFMA32(kone, qm, zz);
    p1 = MFMA32(kone, qm, zz);
  }
#pragma unroll
  for (int d0 = 0; d0 < 4; ++d0) {
    const int co = ((2 * d0 + hi) ^ ksw) << 4;
    const bf16x8 ka = *(const bf16x8*)(kb + r32 * 128 + co);
    const bf16x8 kc = *(const bf16x8*)(kb + (r32 + 32) * 128 + co);
    p0 = MFMA32(ka, qr[d0], p0);
    p1 = MFMA32(kc, qr[d0], p1);
  }
  if (MODE == 0) {
    const int kbase = ktl * 64 + 4 * hi;
#pragma unroll
    for (int r = 0; r < 16; ++r) {
      const int kv = kbase + (r & 3) + 8 * (r >> 2);
      if (kv > qrel) p0[r] = NEGBIG;
      if (kv + 32 > qrel) p1[r] = NEGBIG;
    }
  }
  float mxa = max3f(p0[0], p0[1], p1[0]), mxb = max3f(p0[2], p0[3], p1[1]);
  mxa = max3f(mxa, p1[2], p1[3]);
#pragma unroll
  for (int r = 4; r < 16; r += 4) { mxa = max3f(mxa, p0[r], p0[r + 1]); mxb = max3f(mxb, p0[r + 2], p0[r + 3]); mxa = max3f(mxa, p1[r], p1[r + 1]); mxb = max3f(mxb, p1[r + 2], p1[r + 3]); }
  float mx = fmaxf(mxa, mxb);
  mx = fmaxf(mx, __shfl_xor(mx, 32));
  if (__any(mx > THR)) {
    asm volatile("; rescale (rare)" ::: "memory");
    const float d0_ = (mx > THR) ? mx : 0.f;
    const float mnew = __uint_as_float(cvtpk(st.m + d0_, 0.f) << 16);
    const float d = mnew - st.m;
    st.m = mnew;
    const float alpha = fexp2(-d);
#pragma unroll
    for (int r = 0; r < 16; ++r) { st.o0[r] *= alpha; st.o1[r] *= alpha; p0[r] -= d; p1[r] -= d; }
    st.l *= alpha;
  }
#pragma unroll
  for (int r = 0; r < 16; ++r) { p0[r] = fexp2(p0[r]); p1[r] = fexp2(p1[r]); }
  if (MODE == 1) {
    const unsigned w0 = w.x >> (4 * hi), w1 = w.y >> (4 * hi);
#define DSA_MASK1(R, POS) { int k0_, k1_; asm("v_bfe_i32 %0, %1, " #POS ", 1" : "=v"(k0_) : "v"(w0)); asm("v_bfe_i32 %0, %1, " #POS ", 1" : "=v"(k1_) : "v"(w1)); \
      p0[R] = __uint_as_float(__float_as_uint(p0[R]) & (unsigned)k0_); p1[R] = __uint_as_float(__float_as_uint(p1[R]) & (unsigned)k1_); }
    DSA_MASK1(0, 0) DSA_MASK1(1, 1) DSA_MASK1(2, 2) DSA_MASK1(3, 3) DSA_MASK1(4, 8) DSA_MASK1(5, 9) DSA_MASK1(6, 10) DSA_MASK1(7, 11)
    DSA_MASK1(8, 16) DSA_MASK1(9, 17) DSA_MASK1(10, 18) DSA_MASK1(11, 19) DSA_MASK1(12, 24) DSA_MASK1(13, 25) DSA_MASK1(14, 26) DSA_MASK1(15, 27)
#undef DSA_MASK1
  }
  {
    typedef float f32x2 __attribute__((ext_vector_type(2)));
    f32x2 t[8];
#pragma unroll
    for (int k = 0; k < 8; ++k) t[k] = (f32x2){p0[2 * k], p0[2 * k + 1]} + (f32x2){p1[2 * k], p1[2 * k + 1]};
#pragma unroll
    for (int k = 0; k < 4; ++k) t[k] += t[k + 4];
    t[0] += t[2]; t[1] += t[3];
    t[0] += t[1];
    st.l += t[0].x + t[0].y;
  }
  bf16x8 pa[4];
#pragma unroll
  for (int ks = 0; ks < 2; ++ks) {
    u32x4 a, c;
    a.x = cvtpk(p0[8 * ks + 0], p0[8 * ks + 1]); a.y = cvtpk(p0[8 * ks + 2], p0[8 * ks + 3]); a.z = cvtpk(p0[8 * ks + 4], p0[8 * ks + 5]); a.w = cvtpk(p0[8 * ks + 6], p0[8 * ks + 7]);
    c.x = cvtpk(p1[8 * ks + 0], p1[8 * ks + 1]); c.y = cvtpk(p1[8 * ks + 2], p1[8 * ks + 3]); c.z = cvtpk(p1[8 * ks + 4], p1[8 * ks + 5]); c.w = cvtpk(p1[8 * ks + 6], p1[8 * ks + 7]);
    pa[ks] = __builtin_bit_cast(bf16x8, a); pa[ks + 2] = __builtin_bit_cast(bf16x8, c);
  }
  const LAS char* vb = (const LAS char*)lds + tbuf + 8192 + (4 * hi + ((lane & 15) >> 2)) * 64 + ((lane >> 4) & 1) * 32 + (lane & 3) * 8;
#pragma unroll
  for (int ks = 0; ks < 4; ++ks) {
    const s16x4 l0 = vtr(vb + ks * 1024), h0 = vtr(vb + ks * 1024 + 512);
    const s16x4 l1 = vtr(vb + 4096 + ks * 1024), h1 = vtr(vb + 4096 + ks * 1024 + 512);
    const bf16x8 f0 = (bf16x8){l0[0], l0[1], l0[2], l0[3], h0[0], h0[1], h0[2], h0[3]};
    const bf16x8 f1 = (bf16x8){l1[0], l1[1], l1[2], l1[3], h1[0], h1[1], h1[2], h1[3]};
    st.o0 = MFMA32(f0, pa[ks], st.o0);
    st.o1 = MFMA32(f1, pa[ks], st.o1);
  }
}

DI void attn_load_q(const bf16_t* __restrict__ qp, bf16x8 (&qr)[4]) {
#pragma unroll
  for (int d0 = 0; d0 < 4; ++d0) {
    const u32x4 v = *(const u32x4*)(qp + d0 * 16);
    u32x4 o;
    o.x = cvtpk(bflo(v.x) * C2, bfhi(v.x) * C2); o.y = cvtpk(bflo(v.y) * C2, bfhi(v.y) * C2);
    o.z = cvtpk(bflo(v.z) * C2, bfhi(v.z) * C2); o.w = cvtpk(bflo(v.w) * C2, bfhi(v.w) * C2);
    qr[d0] = __builtin_bit_cast(bf16x8, o);
  }
}
DI void attn_store(bf16_t* op, const AttState& st, float inv) {
#pragma unroll
  for (int g = 0; g < 4; ++g) {
    u32x2 a, c;
    a.x = cvtpk(st.o0[4 * g + 0] * inv, st.o0[4 * g + 1] * inv); a.y = cvtpk(st.o0[4 * g + 2] * inv, st.o0[4 * g + 3] * inv);
    c.x = cvtpk(st.o1[4 * g + 0] * inv, st.o1[4 * g + 1] * inv); c.y = cvtpk(st.o1[4 * g + 2] * inv, st.o1[4 * g + 3] * inv);
    *(u32x2*)(op + 8 * g) = a;
    *(u32x2*)(op + 32 + 8 * g) = c;
  }
}

DI void attn_dsa_unit(char* lds, const bf16_t* __restrict__ proj, bf16_t* __restrict__ mix, const uint2* __restrict__ bmt, int b, int h, int qb) {
  const int tid = otid(), lane = tid & 63, wid = __builtin_amdgcn_readfirstlane(tid >> 6), r32 = lane & 31, hi = lane >> 5;
  const int qrel = wid * 32 + r32, t = qb * 256 + qrel;
  const size_t tokq = (size_t)(b * S + t);
  bf16x8 qr[4];
  attn_load_q(proj + tokq * PLD + C_QD + h * 64 + hi * 8, qr);
  AttState st; st.m = 0.f; st.l = 0.f;
#pragma unroll
  for (int r = 0; r < 16; ++r) { st.o0[r] = 0.f; st.o1[r] = 0.f; }
  const uint2* bmp = bmt + (size_t)(b * 128) * 8192 + t;
  uint2 wn[4];
#pragma unroll
  for (int tt = 0; tt < 4; ++tt) wn[tt] = bmp[(size_t)tt * 8192];
  attn_stage<1>(lds, 0, proj, b, h, 0, lane, wid);
  const int ns = qb + 1;
  for (int s = 0; s < ns; ++s) {
    uint2 wc[4];
#pragma unroll
    for (int tt = 0; tt < 4; ++tt) wc[tt] = wn[tt];
    asm volatile("s_waitcnt vmcnt(0)" ::: "memory");
    __syncthreads();
    if (s + 1 < ns) {
#pragma unroll
      for (int tt = 0; tt < 4; ++tt) wn[tt] = bmp[(size_t)(4 * (s + 1) + tt) * 8192];
      attn_stage<1>(lds, ((s + 1) & 1) * ATT_ST, proj, b, h, (s + 1) * 256, lane, wid);
    }
#pragma unroll
    for (int tt = 0; tt < 4; ++tt) attn_tile<1>(lds, (s & 1) * ATT_ST + tt * 16384, qr, st, wc[tt], 0, qrel, r32, hi, lane);
  }
  float l = st.l; l += __shfl_xor(l, 32);
  attn_store(mix + tokq * D + 640 + h * 64 + 4 * hi, st, 1.f / l);
  __syncthreads();
}

DI void attn_own_unit(char* lds, const bf16_t* __restrict__ proj, bf16_t* __restrict__ part_o, float2* __restrict__ part_ml, int b, int h, int qb) {
  const int tid = otid(), lane = tid & 63, wid = __builtin_amdgcn_readfirstlane(tid >> 6), r32 = lane & 31, hi = lane >> 5;
  const int qrel = wid * 32 + r32, t = qb * 256 + qrel;
  const size_t tokq = (size_t)(b * S + t);
  attn_stage<0>(lds, 0, proj, b, h, qb * 256, lane, wid);
  bf16x8 qr[4];
  attn_load_q(proj + tokq * PLD + C_QM + h * 64 + hi * 8, qr);
  AttState st; st.m = 0.f; st.l = 0.f;
#pragma unroll
  for (int r = 0; r < 16; ++r) { st.o0[r] = 0.f; st.o1[r] = 0.f; }
  asm volatile("s_waitcnt vmcnt(0)" ::: "memory");
  __syncthreads();
#pragma unroll
  for (int tt = 0; tt < 4; ++tt) attn_tile<0>(lds, tt * 16384, qr, st, make_uint2(0u, 0u), tt, qrel, r32, hi, lane);
  float l = st.l; l += __shfl_xor(l, 32);
  const size_t pi = (tokq * 6 + h) * 4 + 3;
  if (hi == 0) st_wt64((unsigned long long*)&part_ml[pi], ((unsigned long long)__float_as_uint(l) << 32) | __float_as_uint(st.m));
  attn_store(part_o + pi * 64 + 4 * hi, st, 1.f / l);
  __syncthreads();
}

DI void attn_gather_unit(char* lds, const bf16_t* __restrict__ proj, bf16_t* __restrict__ part_o, float2* __restrict__ part_ml, int b, int h, int j, const unsigned* __restrict__ lst, int nent) {
  const int tid = otid(), lane = tid & 63, wid = __builtin_amdgcn_readfirstlane(tid >> 6), r32 = lane & 31, hi = lane >> 5;
  attn_stage<2>(lds, 0, proj, b, h, j * 256, lane, wid);
  asm volatile("s_waitcnt vmcnt(0)" ::: "memory");
  __syncthreads();
  const int ntile = (nent + 31) >> 5;
  for (int qt = wid; qt < ntile; qt += 8) {
    const int qi = qt * 32 + r32;
    const bool valid = qi < nent;
    const unsigned e = lst[valid ? qi : 0];
    const int t = (int)(e & 0x1FFFu), pslot = (int)(e >> 13);
    const size_t tokq = (size_t)(b * S + t);
    bf16x8 qr[4];
    attn_load_q(proj + tokq * PLD + C_QM + h * 64 + hi * 8, qr);
    AttState st; st.m = 0.f; st.l = 0.f;
#pragma unroll
    for (int r = 0; r < 16; ++r) { st.o0[r] = 0.f; st.o1[r] = 0.f; }
#pragma unroll
    for (int tt = 0; tt < 4; ++tt) attn_tile<2>(lds, tt * 16384, qr, st, make_uint2(0u, 0u), 0, 0, r32, hi, lane);
    float l = st.l; l += __shfl_xor(l, 32);
    if (valid) {
      const size_t pi = (tokq * 6 + h) * 4 + pslot;
      if (hi == 0) st_wt64((unsigned long long*)&part_ml[pi], ((unsigned long long)__float_as_uint(l) << 32) | __float_as_uint(st.m));
      attn_store(part_o + pi * 64 + 4 * hi, st, 1.f / l);
    }
  }
  __syncthreads();
}

DI void gate_unit(char* lds, int u, const bf16_t* __restrict__ proj, const float* __restrict__ kmean, unsigned* __restrict__ mcnt, unsigned* __restrict__ mlist) {
  unsigned* lc = (unsigned*)lds;
  unsigned* lb = lc + 192;
  float* kml = (float*)(lds + 2048);
  const int tid = otid();
  if (tid < 192) lc[tid] = 0u;
  const int tok = u * 64 + (tid & 63), head = tid >> 6;
  const int b = tok >> 13, t = tok & (S - 1), own = t >> 8;
  for (int i = tid; i < 6 * 32 * 16; i += NTHR) {
    const int jb = (i >> 4) & 31;
    if (jb < own) *(float4*)(kml + i * 4) = *(const float4*)(kmean + (size_t)b * 6 * 32 * 64 + i * 4);
  }
  __syncthreads();
  int sj[3] = {-1, -1, -1}; unsigned sp[3] = {0u, 0u, 0u};
  if (tid < 384) {
    u32x4 q[8];
    const bf16_t* qp = proj + (size_t)tok * PLD + C_QM + head * 64;
#pragma unroll
    for (int i = 0; i < 8; ++i) q[i] = *(const u32x4*)(qp + i * 8);
    float v1 = -INFINITY, v2 = -INFINITY, v3 = -INFINITY; int i1 = -1, i2 = -1, i3 = -1;
    for (int j = 0; j < own; ++j) {
      const float* km = kml + (head * 32 + j) * 64;
      float g = 0.f;
#pragma unroll
      for (int i = 0; i < 8; ++i) {
        const float4 ka = *(const float4*)(km + i * 8), kb = *(const float4*)(km + i * 8 + 4);
        g += bflo(q[i].x) * ka.x + bfhi(q[i].x) * ka.y + bflo(q[i].y) * ka.z + bfhi(q[i].y) * ka.w;
        g += bflo(q[i].z) * kb.x + bfhi(q[i].z) * kb.y + bflo(q[i].w) * kb.z + bfhi(q[i].w) * kb.w;
      }
      if (g > v1) { v3 = v2; i3 = i2; v2 = v1; i2 = i1; v1 = g; i1 = j; }
      else if (g > v2) { v3 = v2; i3 = i2; v2 = g; i2 = j; }
      else if (g > v3) { v3 = g; i3 = j; }
    }
    sj[0] = i1; sj[1] = i2; sj[2] = i3;
#pragma unroll
    for (int p = 0; p < 3; ++p) if (sj[p] >= 0) sp[p] = atomicAdd(&lc[head * 32 + sj[p]], 1u);
  }
  __syncthreads();
  if (tid < 192 && lc[tid]) lb[tid] = atomicAdd(&mcnt[(b * 6 + (tid >> 5)) * 32 + (tid & 31)], lc[tid]);
  __syncthreads();
  if (tid < 384) {
#pragma unroll
    for (int p = 0; p < 3; ++p) if (sj[p] >= 0) {
      const int c = (b * 6 + head) * 32 + sj[p];
      st_wt32(&mlist[(size_t)c * 8192 + lb[head * 32 + sj[p]] + sp[p]], (unsigned)t | ((unsigned)p << 13));
    }
  }
  __syncthreads();
}

DI void conv_unit(char* lds, int u, const bf16_t* __restrict__ proj, bf16_t* __restrict__ mix, const float* __restrict__ conv_w, const float* __restrict__ conv_b,
                  const float* __restrict__ ln_g, const float* __restrict__ ln_b);
DI void attn_queue_phase(char* lds, const bf16_t* proj, bf16_t* mix, const uint2* bmt, bf16_t* part_o, float2* part_ml, const unsigned* mcnt, const unsigned* mlist, unsigned* qhead,
                         const float* w1, const float* w3, const float* w2, bf16_t* w13T, bf16_t* w2T,
                         const float* conv_w, const float* conv_b, const float* ln_g, const float* ln_b) {
  unsigned* pfx = (unsigned*)(lds + 133120);
  unsigned* qw = (unsigned*)(lds + 133120 + 3328);
  const int tid = otid(), lane = tid & 63;
  if (tid < 64) {
    unsigned loc[12]; unsigned sum = 0u;
#pragma unroll
    for (int i = 0; i < 12; ++i) { loc[i] = (mcnt[tid * 12 + i] + 2047u) >> 11; sum += loc[i]; }
    unsigned run = scan_add(sum) - sum;
    if (lane == 0) pfx[0] = 0u;
#pragma unroll
    for (int i = 0; i < 12; ++i) { run += loc[i]; pfx[tid * 12 + i + 1] = run; }
  }
  __syncthreads();
  const int nsp = (int)pfx[768];
  const int natt = 768 + nsp + 768;
  const int nconv = T / 64;
  const int total = natt + nconv + PREP_EXP_ITEMS;
  int qlast = 0;
  for (;;) {
    if (tid == 0) qw[0] = atomicAdd(qhead, 1u);
    __syncthreads();
    const int q = (int)qw[0];
    __syncthreads();
    if (q >= natt) { qlast = q; break; }
    if (q < 768) {
      const int qb = 31 - q / 24, bh = q % 24;
      attn_dsa_unit(lds, proj, mix, bmt, bh / 6, bh % 6, qb);
    } else if (q < 768 + nsp) {
      const unsigned item = (unsigned)(q - 768);
      int lo = 0, hi = 768;
      while (hi - lo > 1) { const int mid = (lo + hi) >> 1; if (pfx[mid] <= item) lo = mid; else hi = mid; }
      const int c = lo, chunk = (int)(item - pfx[c]);
      const int nent = min(2048, (int)mcnt[c] - chunk * 2048);
      attn_gather_unit(lds, proj, part_o, part_ml, c / 192, (c >> 5) % 6, c & 31, mlist + (size_t)c * 8192 + chunk * 2048, nent);
    } else {
      const int o = q - 768 - nsp, qb = 31 - o / 24, bh = o % 24;
      attn_own_unit(lds, proj, part_o, part_ml, bh / 6, bh % 6, qb);
    }
  }
  for (int q = qlast; q < total;) {
    if (q < natt + nconv) conv_unit(lds, q - natt, proj, mix, conv_w, conv_b, ln_g, ln_b);
    else prep_exp_item(lds, q - natt - nconv, w1, w3, w2, w13T, w2T);
    if (tid == 0) qw[0] = atomicAdd(qhead, 1u);
    __syncthreads();
    q = (int)qw[0];
    __syncthreads();
  }
}

constexpr int SEL_CAP = 1024, SEL_G = 512, SEL_K = 256;
constexpr int SEL_LDS = 131072 + 512 + 4096 + 4096;
constexpr int SEL_DUMMY = 131072 + 512 + 4096;
DI unsigned fkey(float f) { const unsigned u = __float_as_uint(f); return (u & 0x80000000u) ? ~u : (u | 0x80000000u); }

DI float fkey_inv(unsigned k) { const unsigned u = (k & 0x80000000u) ? (k & 0x7fffffffu) : ~k; return __uint_as_float(u); }
DI int sbin(float s, float lo, float sc) { return min(63, __float2int_rd((s - lo) * sc)); }
DI int hist_scan(const unsigned* h, int lane, int K) {
  const unsigned Sx = scan_add(h[63 - lane]);
  const unsigned long long m = __ballot(Sx >= (unsigned)K);
  return m ? (63 - (int)__builtin_ctzll(m)) : -1;
}
DI void sel_row_maint(uint2* rowbuf, unsigned* cntp, float* taup, unsigned* hist, bool last, int K = SEL_K, bool thr = false, bool raw = false) {
  const int lane = otid() & 63;
  int n = (int)*cntp; if (n > SEL_CAP) n = SEL_CAP;
  const int lim = thr ? K - 1 : (last ? SEL_K : (SEL_CAP - SEL_G));
  if (thr && n <= lim) { if (lane == 0) { *cntp = 0u; *taup = -INFINITY; } }
  if (n > lim) {
    unsigned ky[16], kx[16];
    unsigned kmin = 0xffffffffu, kmax = 0u;
#pragma unroll
    for (int i = 0; i < 16; ++i) {
      const int idx = lane + 64 * i; uint2 v = make_uint2(0u, 0u);
      if (64 * i < n) { if (idx < n) { v = rowbuf[idx]; if (raw) v.y = fkey(__uint_as_float(v.y)); kmin = min(kmin, v.y); kmax = max(kmax, v.y); } }
      ky[i] = v.y; kx[i] = v.x;
    }
    kmin = red_min(kmin); kmax = red_max(kmax);
    const float lo = fkey_inv(kmin), range = fkey_inv(kmax) - lo, sc = range > 0.f ? 64.f / range : 0.f;
    hist[lane] = 0u;
    int bn[16];
#pragma unroll
    for (int i = 0; i < 16; ++i) { const int idx = lane + 64 * i; bn[i] = -1; if (64 * i < n) { if (idx < n) { bn[i] = max(0, sbin(fkey_inv(ky[i]), lo, sc)); atomicAdd(&hist[bn[i]], 1u); } } }
    const int L = hist_scan(hist, lane, K);
    unsigned ka = 0xffffffffu, kb = 0xffffffffu;
    int ckeep = 0;
#pragma unroll
    for (int i = 0; i < 16; ++i) { if (64 * i < n) { if (bn[i] >= L) { ka = min(ka, ky[i]); ++ckeep; } if (bn[i] > L) kb = min(kb, ky[i]); } }
    ka = red_min(ka); kb = red_min(kb); ckeep = (int)red_add((unsigned)ckeep);
    if (thr) { if (lane == 0) { *cntp = 0u; *taup = fkey_inv(ka); } return; }
    unsigned theta = ka, phi = 0u;
    int nsel = ckeep;
    if (last || ckeep > SEL_CAP - SEL_G) {
      unsigned av = ka, hi = (kb != 0xffffffffu) ? kb - 1u : kmax;
      int ca = -1;
      while (av < hi) {
        const unsigned d = hi - av, mid = av + (d >> 1) + (d & 1u);
        int c = 0;
#pragma unroll
        for (int i = 0; i < 16; ++i) { if (64 * i < n) c += __popcll(__ballot(ky[i] >= mid)); }
        if (c >= SEL_K) { av = mid; ca = c; } else hi = mid - 1u;
        if (c == SEL_K) break;
      }
      theta = av;
      if (ca != SEL_K) {
        int cgt = 0;
#pragma unroll
        for (int i = 0; i < 16; ++i) cgt += __popcll(__ballot(ky[i] > theta));
        const int need = SEL_K - cgt;
        for (int bit = 31; bit >= 0; --bit) {
          const unsigned cand = phi | (1u << bit);
          int c = 0;
#pragma unroll
          for (int i = 0; i < 16; ++i) c += __popcll(__ballot(ky[i] == theta && kx[i] >= cand));
          if (c >= need) phi = cand;
          if (c == need) break;
        }
      }
      nsel = SEL_K;
    }
    const unsigned long long lt = (1ull << lane) - 1ull;
    int base = 0;
#pragma unroll
    for (int i = 0; i < 16; ++i) {
      if (64 * i < n) {
        const bool sl = (ky[i] > theta) || (ky[i] == theta && kx[i] >= phi);
        const unsigned long long bal = __ballot(sl);
        const int pos = base + __popcll(bal & lt);
        if (sl && pos < SEL_CAP) rowbuf[pos] = make_uint2(kx[i], ky[i]);
        base += __popcll(bal);
      }
    }
    if (lane == 0) { *cntp = (unsigned)nsel; *taup = fkey_inv(theta); }
  }
}

constexpr int SEL_CTL = 131072, SEL_HIST = 131072 + 512;
template <int SM>
DI void dsa_select_unit(char* lds, const bf16_t* __restrict__ proj, uint2* __restrict__ bmt, int b, int rg) {
  uint2* buf = (uint2*)lds;
  unsigned* cnt = (unsigned*)(lds + SEL_CTL);
  float* tauf = (float*)(cnt + 16);
  unsigned* flag = cnt + 32;
  unsigned* hist = (unsigned*)(lds + SEL_HIST);
  const int tid = otid(), lane = tid & 63, wid = __builtin_amdgcn_readfirstlane(tid >> 6), fr = lane & 15, fq = lane >> 4;
  const int t0 = rg * 16, t = t0 + fr;
  if (tid < 16) { cnt[tid] = 0u; tauf[tid] = -INFINITY; }
  if (tid == 0) flag[0] = 0u;
  const bf16_t* qrow = proj + (size_t)(b * S + t) * PLD;
  bf16x8 qf[8][2]; float w[8];
#pragma unroll
  for (int hh = 0; hh < 8; ++hh) {
    qf[hh][0] = *(const bf16x8*)(qrow + C_QI + hh * 64 + fq * 8);
    qf[hh][1] = *(const bf16x8*)(qrow + C_QI + hh * 64 + 32 + fq * 8);
    w[hh] = bf2f(qrow[C_WI + hh]);
  }
  const int ntile = rg + 1;
  const bf16_t* kbase = proj + (size_t)(b * S + fr) * PLD + C_KI + fq * 8;
  bf16x8 q9[2];
#pragma unroll
  for (int s = 0; s < 2; ++s) {
    float f[8];
#pragma unroll
    for (int j = 0; j < 8; ++j) {
      float a = 0.f;
#pragma unroll
      for (int hh = 0; hh < 8; ++hh) a += w[hh] * bf2f((bf16_t)qf[hh][s][j]);
      f[j] = a;
    }
    u32x4 o; o.x = cvtpk(f[0], f[1]); o.y = cvtpk(f[2], f[3]); o.z = cvtpk(f[4], f[5]); o.w = cvtpk(f[6], f[7]);
    q9[s] = __builtin_bit_cast(bf16x8, o);
  }
  unsigned dmask = 0u;
#pragma unroll
  for (int r = 0; r < 4; ++r) dmask |= (fq * 4 + r <= fr) ? (1u << r) : 0u;
  __syncthreads();
  uint2* const dummy = (uint2*)(lds + SEL_DUMMY) + tid;
  auto stream = [&](int first, int step, int kend, float tv, bool raw) {
    bf16x8 kf[4][2];
#pragma unroll
    for (int i = 0; i < 4; ++i) {
      const int kt = first + i * step;
      if (kt < kend) { const bf16_t* kp = kbase + (size_t)kt * 16 * PLD; kf[i][0] = *(const bf16x8*)kp; kf[i][1] = *(const bf16x8*)(kp + 32); }
    }
    for (int kb0 = first; kb0 < kend; kb0 += 4 * step) {
      bf16x8 kn[4][2];
#pragma unroll
      for (int i = 0; i < 4; ++i) {
        const int kt = kb0 + (4 + i) * step;
        if (kt < kend) { const bf16_t* kp = kbase + (size_t)kt * 16 * PLD; kn[i][0] = *(const bf16x8*)kp; kn[i][1] = *(const bf16x8*)(kp + 32); }
      }
      f32x4 sv[4];
      unsigned pmask = 0u;
      {
        const f32x4 z = (f32x4){0.f, 0.f, 0.f, 0.f};
        f32x4 xb[3];
        f32x4 acc = z;
#define SEL_PAIR(n) do { const int i_ = (n) / 9, j_ = (n) % 9; \
          const f32x4 t_ = MFMA16(kf[i_][0], j_ ? qf[j_ ? j_ - 1 : 0][0] : q9[0], z); \
          xb[(n) % 3] = MFMA16(kf[i_][1], j_ ? qf[j_ ? j_ - 1 : 0][1] : q9[1], t_); } while (0)
        SEL_PAIR(0); SEL_PAIR(1);
#pragma unroll
        for (int n = 0; n < 36; ++n) {
          if (n + 2 < 36) SEL_PAIR(n + 2);
          __builtin_amdgcn_sched_barrier(0);
          const int i = n / 9, j = n % 9;
          if (j == 0) acc = xb[n % 3];
          else {
#pragma unroll
            for (int r = 0; r < 4; ++r) { float v = fmaf(fabsf(xb[n % 3][r]), w[j - 1], acc[r]); asm volatile("" : "+v"(v)); acc[r] = v; }
          }
          if (j == 8) {
            const int kt = kb0 + i * step;
            sv[i] = acc;
            if (SM == 1) { asm volatile("" :: "v"(acc[0]), "v"(acc[1]), "v"(acc[2]), "v"(acc[3])); }
            else {
              const unsigned allow = (kt < kend) ? ((kt == ntile - 1) ? dmask : 0xfu) : 0u;
              unsigned pm = 0u;
#pragma unroll
              for (int r = 0; r < 4; ++r) pm |= (acc[r] >= tv) ? (1u << r) : 0u;
              pmask |= (pm & allow) << (i * 4);
            }
          }
          __builtin_amdgcn_sched_barrier(0);
        }
#undef SEL_PAIR
      }
      if (SM != 1) {
        const int np = __popc(pmask);
        unsigned slot = 0u;
        if (np) slot = atomicAdd(&cnt[fr], (unsigned)np);
        if (slot + (unsigned)np > (unsigned)SEL_CAP) slot = (unsigned)(SEL_CAP - 16);
        uint2* rb = buf + fr * SEL_CAP;
#pragma unroll
        for (int i = 0; i < 4; ++i) {
          const unsigned xb = ~(unsigned)((kb0 + i * step) * 16 + fq * 4);
#pragma unroll
          for (int r = 0; r < 4; ++r) {
            const int e = i * 4 + r;
            const unsigned pos = slot + (unsigned)__popc(pmask & ((1u << e) - 1u));
            uint2* dst = ((pmask >> e) & 1u) ? (rb + pos) : dummy;
            *dst = make_uint2(xb - (unsigned)r, raw ? __float_as_uint(sv[i][r]) : fkey(sv[i][r]));
          }
        }
      }
#pragma unroll
      for (int i = 0; i < 4; ++i) { kf[i][0] = kn[i][0]; kf[i][1] = kn[i][1]; }
    }
  };
  bool done = false;
  if (SM == 0 || SM == 3) {
    if (ntile > 64) {
      stream(8 * wid, 64, ntile, -INFINITY, true);
      __syncthreads();
#pragma unroll 1
      for (int rr = 0; rr < 2; ++rr) {
        const int row = 2 * wid + rr;
        const int ns = (int)cnt[row], nrow = t0 + row + 1;
        const int K = min(ns, (2 * SEL_K * ns + nrow - 1) / nrow);
        sel_row_maint(buf + row * SEL_CAP, &cnt[row], &tauf[row], hist + wid * 64, false, max(K, 1), true, true);
      }
      __syncthreads();
      stream(wid, 8, ntile, tauf[fr], true);
      __syncthreads();
      if (tid < 16) { const unsigned c = cnt[tid]; if (c < (unsigned)SEL_K || c > (unsigned)SEL_CAP) atomicOr(&flag[0], 1u); }
      __syncthreads();
      done = (flag[0] == 0u);
      if (done) {
#pragma unroll 1
        for (int rr = 0; rr < 2; ++rr) { const int row = 2 * wid + rr; sel_row_maint(buf + row * SEL_CAP, &cnt[row], &tauf[row], hist + wid * 64, true, SEL_K, false, true); }
      }
      __syncthreads();
      if (!done && tid < 16) { cnt[tid] = 0u; tauf[tid] = -INFINITY; }
      __syncthreads();
    }
  }
  if (!done) {
    const int nround = (ntile + 31) >> 5;
    for (int rd = 0; rd < nround; ++rd) {
      stream(rd * 32 + wid, 8, min(ntile, rd * 32 + 32), tauf[fr], false);
      __syncthreads();
      const bool last = (rd == nround - 1);
      if (SM == 1 || SM == 2) continue;
#pragma unroll 1
      for (int rr = 0; rr < 2; ++rr) {
        const int row = 2 * wid + rr;
        sel_row_maint(buf + row * SEL_CAP, &cnt[row], &tauf[row], hist + wid * 64, last);
      }
      __syncthreads();
    }
  }
  if (SM != 0) { __syncthreads(); return; }
#pragma unroll
  for (int i = 0; i < 8; ++i) { const int wd = tid + NTHR * i; *(unsigned*)(lds + (wd >> 8) * 8192 + 4096 + (wd & 255) * 4) = 0u; }
  __syncthreads();
  {
    const int row = tid >> 5;
    int n = (int)cnt[row]; if (n > SEL_K) n = SEL_K;
    unsigned* img = (unsigned*)(lds + row * 8192 + 4096);
#pragma unroll
    for (int i = 0; i < 8; ++i) {
      const int e = (tid & 31) + 32 * i;
      if (e < n) { const unsigned idx = ~buf[row * SEL_CAP + e].x; atomicOr(&img[idx >> 5], 1u << (idx & 31)); }
    }
  }
  __syncthreads();
  {
    const int ntw = 4 * (t0 >> 8) + 4;
    const int r = tid & 15;
    const unsigned* img = (const unsigned*)(lds + r * 8192 + 4096);
    for (int tile = tid >> 4; tile < ntw; tile += 32)
      bmt[((size_t)(b * 128 + tile)) * 8192 + t0 + r] = make_uint2(img[2 * tile], img[2 * tile + 1]);
  }
  __syncthreads();
}

constexpr int MIX_LDS = 94 * 256 * 4;
DI void conv_unit(char* lds, int u, const bf16_t* __restrict__ proj, bf16_t* __restrict__ mix, const float* __restrict__ conv_w, const float* __restrict__ conv_b,
                  const float* __restrict__ ln_g, const float* __restrict__ ln_b) {
  float* ut = (float*)lds;
  const int tid = otid(), lane = tid & 63, wid = tid >> 6;
  {
    const int tok0 = u * 64, b = tok0 >> 13, t0 = tok0 & (S - 1);
#pragma unroll
    for (int it = 0; it < 6; ++it) {
      const int task = tid + it * NTHR;
      if (task >= 94 * 32) break;
      const int row = task >> 5, cc = (task & 31) * 8;
      const int tt = t0 - 30 + row;
      float uv[8] = {0.f, 0.f, 0.f, 0.f, 0.f, 0.f, 0.f, 0.f};
      if (tt >= 0) {
        const bf16_t* pr = proj + (size_t)(b * S + tt) * PLD;
        const u32x4 a = *(const u32x4*)(pr + C_CA + cc), g = *(const u32x4*)(pr + C_CG + cc);
        const float av[8] = {bflo(a.x), bfhi(a.x), bflo(a.y), bfhi(a.y), bflo(a.z), bfhi(a.z), bflo(a.w), bfhi(a.w)};
        const float gv[8] = {bflo(g.x), bfhi(g.x), bflo(g.y), bfhi(g.y), bflo(g.z), bfhi(g.z), bflo(g.w), bfhi(g.w)};
#pragma unroll
        for (int q = 0; q < 8; ++q) uv[q] = av[q] * frcp(1.f + fexp2(gv[q] * -1.4426950408889634f));
      }
      *(float4*)(ut + row * 256 + cc) = make_float4(uv[0], uv[1], uv[2], uv[3]);
      *(float4*)(ut + row * 256 + cc + 4) = make_float4(uv[4], uv[5], uv[6], uv[7]);
    }
    __syncthreads();
    const int c = tid & 255, half = tid >> 8;
    float cw[31];
#pragma unroll
    for (int w = 0; w < 31; ++w) cw[w] = conv_w[w * 256 + c];
    float y[32];
    const float cb = conv_b[c];
#pragma unroll
    for (int o = 0; o < 32; ++o) y[o] = cb;
#pragma unroll
    for (int rho = 0; rho < 62; ++rho) {
      const float uvv = ut[(half * 32 + rho) * 256 + c];
#pragma unroll
      for (int o = 0; o < 32; ++o) { if (rho - o >= 0 && rho - o <= 30) y[o] += uvv * cw[rho - o]; }
    }
    __syncthreads();
#pragma unroll
    for (int o = 0; o < 32; ++o) ut[(half * 32 + o) * 256 + c] = y[o];
    __syncthreads();
    {
      const float4 gg = *(const float4*)(ln_g + lane * 4), bb = *(const float4*)(ln_b + lane * 4);
#pragma unroll 1
      for (int i4 = 0; i4 < 8; i4 += 4) {
        float4 v[4]; float sm[4], vr[4];
#pragma unroll
        for (int r = 0; r < 4; ++r) { v[r] = *(const float4*)(ut + (wid * 8 + i4 + r) * 256 + lane * 4); sm[r] = v[r].x + v[r].y + v[r].z + v[r].w; }
        wave_sum4(sm);
#pragma unroll
        for (int r = 0; r < 4; ++r) {
          const float mu = sm[r] * (1.f / 256.f);
          v[r].x -= mu; v[r].y -= mu; v[r].z -= mu; v[r].w -= mu;
          vr[r] = v[r].x * v[r].x + v[r].y * v[r].y + v[r].z * v[r].z + v[r].w * v[r].w;
        }
        wave_sum4(vr);
#pragma unroll
        for (int r = 0; r < 4; ++r) {
          const float rs = rsqrtf(vr[r] * (1.f / 256.f) + EPS);
          const float z0 = v[r].x * rs * gg.x + bb.x, z1 = v[r].y * rs * gg.y + bb.y, z2 = v[r].z * rs * gg.z + bb.z, z3 = v[r].w * rs * gg.w + bb.w;
          u32x2 o; o.x = cvtpk(silu_f(z0), silu_f(z1)); o.y = cvtpk(silu_f(z2), silu_f(z3));
          *(u32x2*)(mix + (size_t)(tok0 + wid * 8 + i4 + r) * D + 384 + lane * 4) = o;
        }
      }
    }
    __syncthreads();
  }
}

DI void mixfin_phase(bf16_t* __restrict__ mix, const float* __restrict__ mg, const float* __restrict__ dg, const bf16_t* __restrict__ part_o, const float2* __restrict__ part_ml) {
  const int tid = otid(), lane = tid & 63, wid = tid >> 6;
  for (int u = blockIdx.x; u < T / 64; u += gridDim.x) {
    const int tok0 = u * 64, t0 = tok0 & (S - 1);
    {
      const int nsel = min(3, t0 >> 8);
#pragma unroll 4
      for (int i = 0; i < 8; ++i) {
        const int tl = wid * 8 + i;
        const size_t tok = (size_t)(tok0 + tl);
        bf16_t* mr = mix + tok * D;
        float av[8] = {0.f, 0.f, 0.f, 0.f, 0.f, 0.f, 0.f, 0.f};
#pragma unroll
        for (int ch = 0; ch < 2; ++ch) {
          if (ch == 0 || lane < 32) {
            const int col = ch * 256 + lane * 4, hh = col >> 6, d0 = col & 63;
            const size_t pb = (tok * 6 + hh) * 4;
            const float2 ml3 = part_ml[pb + 3];
            float2 mls[3]; float M = ml3.x;
#pragma unroll
            for (int p = 0; p < 3; ++p) { mls[p] = make_float2(-1e30f, 0.f); if (p < nsel) { mls[p] = part_ml[pb + p]; M = fmaxf(M, mls[p].x); } }
            float wsum = 0.f, acc4[4] = {0.f, 0.f, 0.f, 0.f};
#pragma unroll
            for (int p = 0; p < 4; ++p) {
              if (p == 3 || p < nsel) {
                const float2 mlp = (p == 3) ? ml3 : mls[p < 3 ? p : 0];
                const float wgt = mlp.y * fexp2(mlp.x - M);
                const u32x2 ov = *(const u32x2*)(part_o + (pb + p) * 64 + d0);
                wsum += wgt;
                acc4[0] += wgt * bflo(ov.x); acc4[1] += wgt * bfhi(ov.x); acc4[2] += wgt * bflo(ov.y); acc4[3] += wgt * bfhi(ov.y);
              }
            }
            const float iw = 1.f / wsum;
#pragma unroll
            for (int q = 0; q < 4; ++q) av[ch * 4 + q] = acc4[q] * iw;
          }
        }
        {
          const float ss = wave_sum(av[0] * av[0] + av[1] * av[1] + av[2] * av[2] + av[3] * av[3] + av[4] * av[4] + av[5] * av[5] + av[6] * av[6] + av[7] * av[7]);
          const float rs = rsqrtf(ss * (1.f / 384.f) + EPS);
          const float4 g0 = *(const float4*)(mg + lane * 4);
          u32x2 o; o.x = cvtpk(av[0] * rs * g0.x, av[1] * rs * g0.y); o.y = cvtpk(av[2] * rs * g0.z, av[3] * rs * g0.w);
          *(u32x2*)(mr + lane * 4) = o;
          if (lane < 32) {
            const float4 g1 = *(const float4*)(mg + 256 + lane * 4);
            u32x2 o2; o2.x = cvtpk(av[4] * rs * g1.x, av[5] * rs * g1.y); o2.y = cvtpk(av[6] * rs * g1.z, av[7] * rs * g1.w);
            *(u32x2*)(mr + 256 + lane * 4) = o2;
          }
        }
        {
          bf16_t* pp = mr + 640;
          const u32x2 a = *(const u32x2*)(pp + lane * 4);
          u32x2 c2 = (u32x2){0u, 0u};
          if (lane < 32) c2 = *(const u32x2*)(pp + 256 + lane * 4);
          const float a0 = bflo(a.x), a1 = bfhi(a.x), a2 = bflo(a.y), a3 = bfhi(a.y);
          const float c0 = bflo(c2.x), c1 = bfhi(c2.x), c2f = bflo(c2.y), c3 = bfhi(c2.y);
          const float ss = wave_sum(a0 * a0 + a1 * a1 + a2 * a2 + a3 * a3 + c0 * c0 + c1 * c1 + c2f * c2f + c3 * c3);
          const float rs = rsqrtf(ss * (1.f / 384.f) + EPS);
          const float4 g0 = *(const float4*)(dg + lane * 4);
          u32x2 o; o.x = cvtpk(a0 * rs * g0.x, a1 * rs * g0.y); o.y = cvtpk(a2 * rs * g0.z, a3 * rs * g0.w);
          *(u32x2*)(pp + lane * 4) = o;
          if (lane < 32) {
            const float4 g1 = *(const float4*)(dg + 256 + lane * 4);
            u32x2 o2; o2.x = cvtpk(c0 * rs * g1.x, c1 * rs * g1.y); o2.y = cvtpk(c2f * rs * g1.z, c3 * rs * g1.w);
            *(u32x2*)(pp + 256 + lane * 4) = o2;
          }
        }
      }
    }
    __syncthreads();
  }
}

DI void route_phase(char* lds, const float* __restrict__ logits, const float* __restrict__ rgb, const float* __restrict__ reb, unsigned* __restrict__ list, int* __restrict__ cnt, float* __restrict__ gate) {
  unsigned* lcnt = (unsigned*)lds;
  unsigned* lbase = lcnt + 32;
  const int tid = otid();
  for (int u = blockIdx.x; u < T / NTHR; u += gridDim.x) {
    if (tid < 32) lcnt[tid] = 0u;
    __syncthreads();
    const int tok = u * NTHR + tid;
    const float* lg = logits + (size_t)tok * 36;
    float gl[4];
#pragma unroll
    for (int i = 0; i < 4; ++i) gl[i] = lg[i] + rgb[i];
    int gi = 0; float gm = gl[0];
#pragma unroll
    for (int i = 1; i < 4; ++i) if (gl[i] > gm) { gm = gl[i]; gi = i; }
    float gs = 0.f;
#pragma unroll
    for (int i = 0; i < 4; ++i) gs += __expf(gl[i] - gm);
    const float gw = 1.f / gs;
    float e1 = -INFINITY, e2 = -INFINITY; int j1 = 0, j2 = 0;
    for (int j = 0; j < 8; ++j) {
      const float v = lg[4 + gi * 8 + j] + reb[gi * 8 + j];
      if (v > e1) { e2 = e1; j2 = j1; e1 = v; j1 = j; }
      else if (v > e2) { e2 = v; j2 = j; }
    }
    const float p2 = 1.f / (1.f + __expf(e1 - e2)), p1 = 1.f - p2;
    const int ex1 = gi * 8 + j1, ex2 = gi * 8 + j2;
    gate[tok * 2] = gw * p1; gate[tok * 2 + 1] = gw * p2;
    const unsigned pos1 = atomicAdd(&lcnt[ex1], 1u);
    const unsigned pos2 = atomicAdd(&lcnt[ex2], 1u);
    __syncthreads();
    if (tid < 32) lbase[tid] = (unsigned)atomicAdd(&cnt[tid], (int)lcnt[tid]);
    __syncthreads();
    st_wt32(&list[(size_t)ex1 * 65536 + lbase[ex1] + pos1], (unsigned)(tok * 2));
    st_wt32(&list[(size_t)ex2 * 65536 + lbase[ex2] + pos2], (unsigned)(tok * 2 + 1));
    __syncthreads();
  }
}

DI void combine_phase(float* __restrict__ xio, const bf16_t* __restrict__ ys, const float* __restrict__ g2, int final_mode,
                      const float* __restrict__ g, const float* __restrict__ mod_sh, const float* __restrict__ mod_sc, bf16_t* __restrict__ h) {
  const int tid_ = otid(); const int lane = tid_ & 63, wid = tid_ >> 6;
  for (int row0 = (blockIdx.x * 8 + wid) * 2; row0 < T; row0 += gridDim.x * 16) {
    const int b = row0 >> 13;
    float4 v[2][4]; float ssa[4] = {0.f, 0.f, 0.f, 0.f};
    u32x2 ya[2][4], yc[2][4];
#pragma unroll
    for (int r = 0; r < 2; ++r) {
      const float* xr = xio + (size_t)(row0 + r) * D;
      const bf16_t* y0 = ys + (size_t)(row0 + r) * 2048;
#pragma unroll
      for (int i = 0; i < 4; ++i) {
        const int col = i * 256 + lane * 4;
        v[r][i] = *(const float4*)(xr + col);
        ya[r][i] = *(const u32x2*)(y0 + col); yc[r][i] = *(const u32x2*)(y0 + 1024 + col);
      }
    }
#pragma unroll
    for (int i = 0; i < 4; ++i) {
      const int col = i * 256 + lane * 4;
      const float4 gg = *(const float4*)(g2 + (size_t)b * 6144 + col);
#pragma unroll
      for (int r = 0; r < 2; ++r) {
        v[r][i].x += gg.x * (bflo(ya[r][i].x) + bflo(yc[r][i].x)); v[r][i].y += gg.y * (bfhi(ya[r][i].x) + bfhi(yc[r][i].x));
        v[r][i].z += gg.z * (bflo(ya[r][i].y) + bflo(yc[r][i].y)); v[r][i].w += gg.w * (bfhi(ya[r][i].y) + bfhi(yc[r][i].y));
        ssa[r] += v[r][i].x * v[r][i].x + v[r][i].y * v[r][i].y + v[r][i].z * v[r][i].z + v[r][i].w * v[r][i].w;
      }
    }
    wave_sum4(ssa);
#pragma unroll
    for (int i = 0; i < 4; ++i) {
      const int col = i * 256 + lane * 4;
      const float4 gg = *(const float4*)(g + col);
      float4 sc = make_float4(0.f, 0.f, 0.f, 0.f), sh = sc;
      if (!final_mode) { sc = *(const float4*)(mod_sc + (size_t)b * 6144 + col); sh = *(const float4*)(mod_sh + (size_t)b * 6144 + col); }
#pragma unroll
      for (int r = 0; r < 2; ++r) {
        const float rstd = rsqrtf(ssa[r] * (1.f / 1024.f) + EPS);
        float* xr = xio + (size_t)(row0 + r) * D;
        if (final_mode) {
          *(float4*)(xr + col) = make_float4(v[r][i].x * rstd * gg.x, v[r][i].y * rstd * gg.y, v[r][i].z * rstd * gg.z, v[r][i].w * rstd * gg.w);
        } else {
          *(float4*)(xr + col) = v[r][i];
          u32x2 o;
          o.x = cvtpk(v[r][i].x * rstd * gg.x * (1.f + sc.x) + sh.x, v[r][i].y * rstd * gg.y * (1.f + sc.y) + sh.y);
          o.y = cvtpk(v[r][i].z * rstd * gg.z * (1.f + sc.z) + sh.z, v[r][i].w * rstd * gg.w * (1.f + sc.w) + sh.w);
          *(u32x2*)(h + (size_t)(row0 + r) * D + col) = o;
        }
      }
    }
  }
}

#define XB_TMO      128
#define XB_XCNT(j)  (256  + 64 * (j))
#define XB_XSUB(j)  (1280 + 64 * (j))
#define XB_XGEN(j)  (2304 + 64 * (j))
#define XB_TOP      3328
#define XB_TOPGEN   3392
#define XCD_BAR_WORDS 3456
#define XB_SPIN_CAP (1u << 18)
DI unsigned xb_ld(unsigned* p) { return __hip_atomic_load(p, __ATOMIC_RELAXED, __HIP_MEMORY_SCOPE_AGENT); }
DI unsigned xb_add(unsigned* p, unsigned v) { return __hip_atomic_fetch_add(p, v, __ATOMIC_RELAXED, __HIP_MEMORY_SCOPE_AGENT); }
DI unsigned xb_xcc_id() { return (unsigned)__builtin_amdgcn_s_getreg((3 << 11) | 20) & 0xFu; }
#define XB_SPIN(cond, bar) do { unsigned _sp = 0; while (cond) { __builtin_amdgcn_s_sleep(1); \
    if ((++_sp & 255u) == 0u) { if (xb_ld(&(bar)[XB_TMO])) break; if (_sp > XB_SPIN_CAP) { atomicAdd(&(bar)[XB_TMO], 1u); break; } } } } while (0)
struct XcdBarrier { unsigned* bar; unsigned x; volatile LAS unsigned* st; };
DI XcdBarrier xcd_barrier_post(unsigned* bar, volatile LAS unsigned* st) {
  XcdBarrier b; b.bar = bar; b.x = xb_xcc_id(); b.st = st;
  if (threadIdx.x == 0) (void)xb_add(&bar[XB_XCNT(b.x)], 1u);
  return b;
}
DI void xcd_barrier_complete(unsigned* bar, unsigned x, unsigned& nloc, unsigned& nx) {
  const unsigned G = gridDim.x * gridDim.y * gridDim.z;
  unsigned sum, cnt, mine, sp = 0u;
  for (;;) {
    sum = 0u; cnt = 0u; mine = 0u;
#pragma unroll
    for (unsigned j = 0; j < 16; ++j) { const unsigned c = xb_ld(&bar[XB_XCNT(j)]); sum += c; cnt += (c > 0u) ? 1u : 0u; mine = (j == x) ? c : mine; }
    if (sum == G) break;
    __builtin_amdgcn_s_sleep(1);
    if ((++sp & 255u) == 0u) { if (xb_ld(&bar[XB_TMO])) break; if (sp > XB_SPIN_CAP) { atomicAdd(&bar[XB_TMO], 1u); break; } }
  }
  nloc = mine > 0u ? mine : 1u; nx = cnt > 0u ? cnt : 1u;
}
DI void xcd_barrier(const XcdBarrier& b) {
  asm volatile("s_waitcnt vmcnt(0)" ::: "memory");
  __syncthreads();
  if (threadIdx.x == 0) {
    unsigned* bar = b.bar;
    __builtin_amdgcn_s_waitcnt(0);
    unsigned nloc = b.st[0], nx = b.st[1];
    if (nloc == 0u) { xcd_barrier_complete(bar, b.x, nloc, nx); b.st[0] = nloc; b.st[1] = nx; }
    const unsigned old = xb_add(&bar[XB_XSUB(b.x)], 1u);
    const unsigned gen = old / nloc;
    if (old + 1u == (gen + 1u) * nloc) {
      __builtin_amdgcn_fence(__ATOMIC_RELEASE, "");
      asm volatile("s_waitcnt vmcnt(0)" ::: "memory");
      const unsigned og = xb_add(&bar[XB_TOP], 1u);
      const unsigned tg = og / nx;
      if (og + 1u == (tg + 1u) * nx) xb_add(&bar[XB_TOPGEN], 1u);
      else XB_SPIN(xb_ld(&bar[XB_TOPGEN]) == tg, bar);
      __builtin_amdgcn_fence(__ATOMIC_ACQUIRE, "");
      xb_add(&bar[XB_XGEN(b.x)], 1u);
      asm volatile("s_waitcnt vmcnt(0)" ::: "memory");
    } else {
      XB_SPIN(xb_ld(&bar[XB_XGEN(b.x)]) == gen, bar);
      __builtin_amdgcn_fence(__ATOMIC_ACQUIRE, "");
      asm volatile("s_waitcnt vmcnt(0)" ::: "memory");
    }
  }
  __syncthreads();
}

struct MegaP {
  const float *x, *c, *ada_w, *ada_b, *norm1_g, *w_in, *conv_w, *conv_b, *cln_g, *cln_b, *moba_g, *dsa_g, *w_out, *norm2_g, *rgw, *rgb, *rew, *reb, *w1, *w3, *w2, *final_g;
  float* out; char* ws;
};
constexpr int LDS_BST = 143360;
constexpr int MEGA_LDS = LDS_BST + 16;
constexpr int CW_BAR = 1024;
#ifndef PROBE
#define PROBE 0
#endif
#define NREP(k) ((PROBE == (k)) ? 2 : 1)

__global__ void __launch_bounds__(NTHR) mega(MegaP p) {
  extern __shared__ __attribute__((aligned(16))) char lds[];
  cg::grid_group grid = cg::this_grid();
  char* ws = p.ws;
  unsigned* ctl = (unsigned*)(ws + WS_CTL);
  float* mod = (float*)(ws + WS_MOD);
  float* kmean = (float*)(ws + WS_KMEAN);
  float* gate = (float*)(ws + WS_GATE);
  float* logits = (float*)(ws + WS_LOGIT);
  unsigned* list = (unsigned*)(ws + WS_LIST);
  bf16_t* winT = (bf16_t*)(ws + WS_WINT);
  bf16_t* woutT = (bf16_t*)(ws + WS_WOUTT);
  bf16_t* rt = (bf16_t*)(ws + WS_RT);
  bf16_t* w13T = (bf16_t*)(ws + WS_W13T);
  bf16_t* w2T = (bf16_t*)(ws + WS_W2T);
  bf16_t* hb = (bf16_t*)(ws + WS_HB);
  uint2* bmt = (uint2*)(ws + WS_BMT);
  bf16_t* proj = (bf16_t*)(ws + WS_PROJ);
  bf16_t* act = (bf16_t*)(ws + WS_ACT);
  bf16_t* ys = (bf16_t*)(ws + WS_YS);
  bf16_t* part_o = (bf16_t*)(ws + WS_PARTO);
  float2* part_ml = (float2*)(ws + WS_PARTML);
  unsigned* mlist = (unsigned*)(ws + WS_MLIST);
  float* out = p.out;
  const int nblk = gridDim.x, bid = blockIdx.x;
  volatile LAS unsigned* bst = (volatile LAS unsigned*)(LAS char*)(lds + LDS_BST);
  if (threadIdx.x < 2) bst[threadIdx.x] = 0u;
  __syncthreads();
  const XcdBarrier xb = xcd_barrier_post(ctl + CW_BAR, bst);
#define GSYNC() xcd_barrier(xb)
  grid.sync();

  {
    const int mb = nblk - 1 - bid;
    mod_units(lds, mb, nblk, p.c, p.ada_w, p.ada_b, mod);
    prep_small_units(lds, bid, nblk, p.w_in, p.w_out, p.rgw, p.rew, winT, woutT, rt);
  }
  GSYNC();
  rmsmod_phase(p.x, p.norm1_g, mod + 0, mod + 1024, hb);
  GSYNC();

  for (int l = 0; l < 2; ++l) {
    char* wsl = p.ws; asm volatile("" : "+s"(wsl));
    unsigned* ctl = (unsigned*)(wsl + WS_CTL);
    float* mod = (float*)(wsl + WS_MOD);
    float* kmean = (float*)(wsl + WS_KMEAN);
    float* gate = (float*)(wsl + WS_GATE);
    float* logits = (float*)(wsl + WS_LOGIT);
    unsigned* list = (unsigned*)(wsl + WS_LIST);
    bf16_t* winT = (bf16_t*)(wsl + WS_WINT);
    bf16_t* woutT = (bf16_t*)(wsl + WS_WOUTT);
    bf16_t* rt = (bf16_t*)(wsl + WS_RT);
    bf16_t* w13T = (bf16_t*)(wsl + WS_W13T);
    bf16_t* w2T = (bf16_t*)(wsl + WS_W2T);
    bf16_t* hb = (bf16_t*)(wsl + WS_HB);
    uint2* bmt = (uint2*)(wsl + WS_BMT);
    bf16_t* proj = (bf16_t*)(wsl + WS_PROJ);
    bf16_t* act = (bf16_t*)(wsl + WS_ACT);
    bf16_t* ys = (bf16_t*)(wsl + WS_YS);
    bf16_t* part_o = (bf16_t*)(wsl + WS_PARTO);
    float2* part_ml = (float2*)(wsl + WS_PARTML);
    unsigned* mlist = (unsigned*)(wsl + WS_MLIST);
    const float* modl = mod + (size_t)l * 4 * 6144;
    if (PROBE == 13) { GemmP P{}; P.A = hb; P.Bt = winT; P.lda = 1024; P.K = 1024; P.Obf = proj; P.ldo = PLD; gemm_phase<GM_INPROJ, 8, 1>(lds, P, T / 256, 14); GSYNC(); }
    if (PROBE == 14) { GemmP P{}; P.A = hb; P.Bt = winT; P.lda = 1024; P.K = 1024; P.Obf = proj; P.ldo = PLD; gemm_phase<GM_INPROJ, 8, 2>(lds, P, T / 256, 14); GSYNC(); }
    for (int rep = 0; rep < NREP(1); ++rep) {
      { GemmP P{}; P.A = hb; P.Bt = winT; P.lda = 1024; P.K = 1024; P.Obf = proj; P.ldo = PLD; gemm_phase<GM_INPROJ, 8>(lds, P, T / 256, 14); }
      GSYNC();
    }
    for (int u = bid; u < NB * 32; u += nblk) kmean_unit(lds, u, proj, kmean);
    GSYNC();
    unsigned* mcnt = ctl + CW_MC + l * 768;
    if (PROBE >= 10 && PROBE <= 12) {
      for (int u = bid; u < NB * 512; u += nblk) dsa_select_unit<(PROBE >= 10 && PROBE <= 12) ? PROBE - 9 : 1>(lds, proj, bmt, u & 3, 511 - (u >> 2));
      GSYNC();
    }
    for (int rep = 0; rep < NREP(2); ++rep) {
      unsigned* sq = ctl + CW_Q + 4 + 2 * rep + l;
      unsigned* qw = (unsigned*)(lds + SEL_LDS + 64);
      for (;;) {
        if (otid() == 0) qw[0] = atomicAdd(sq, 1u);
        __syncthreads();
        const int u = (int)qw[0];
        __syncthreads();
        if (u >= NB * 512 + T / 64) break;
        if (u < NB * 512) dsa_select_unit<0>(lds, proj, bmt, u & 3, 511 - (u >> 2));
        else if (rep == 0) gate_unit(lds, u - NB * 512, proj, kmean, mcnt, mlist);
      }
      GSYNC();
    }
    if (PROBE == 3) {
      attn_queue_phase(lds, proj, hb, bmt, part_o, part_ml, mcnt, mlist, ctl + CW_Q + 2 + l, p.w1 + (size_t)l * 32 * 1024 * 512, p.w3 + (size_t)l * 32 * 1024 * 512, p.w2 + (size_t)l * 32 * 512 * 1024, w13T, w2T,
                     p.conv_w + (size_t)l * 31 * 256, p.conv_b + l * 256, p.cln_g + l * 256, p.cln_b + l * 256);
      GSYNC();
    }
    attn_queue_phase(lds, proj, hb, bmt, part_o, part_ml, mcnt, mlist, ctl + CW_Q + l, p.w1 + (size_t)l * 32 * 1024 * 512, p.w3 + (size_t)l * 32 * 1024 * 512, p.w2 + (size_t)l * 32 * 512 * 1024, w13T, w2T,
                     p.conv_w + (size_t)l * 31 * 256, p.conv_b + l * 256, p.cln_g + l * 256, p.cln_b + l * 256);
    GSYNC();
    mixfin_phase(hb, p.moba_g + l * 384, p.dsa_g + l * 384, part_o, part_ml);
    GSYNC();
    { GemmP P{}; P.A = hb; P.Bt = woutT; P.lda = 1024; P.K = 1024; P.xin = (l == 0) ? p.x : out; P.xout = out; P.gvec = modl + 2048; gemm_phase<GM_OUTPROJ, 8>(lds, P, T / 256, 4); }
    GSYNC();
    for (int rep = 0; rep < NREP(4); ++rep) {
      rmsmod_phase(out, p.norm2_g + l * 1024, modl + 3072, modl + 4096, hb);
      GSYNC();
    }
    for (int rep = 0; rep < NREP(5); ++rep) {
      { GemmP P{}; P.A = hb; P.Bt = rt; P.lda = 1024; P.K = 1024; P.logits = logits; gemm_phase<GM_ROUTER, 4>(lds, P, T / 256, 1); }
      GSYNC();
    }
    int* cntl = (int*)(ctl + CW_CNT + l * 32);
    route_phase(lds, logits, p.rgb + l * 4, p.reb + l * 32, list, cntl, gate);
    GSYNC();
    for (int rep = 0; rep < NREP(6); ++rep) {
      { GemmP P{}; P.A = hb; P.Bt = w13T; P.lda = 1024; P.K = 1024; P.Obf = act; P.list = list; P.cnt = cntl; P.gate = gate; gemm_phase<GM_MOE1, 8>(lds, P, 0, 0); }
      GSYNC();
    }
    for (int rep = 0; rep < NREP(7); ++rep) {
      { GemmP P{}; P.A = act; P.Bt = w2T; P.lda = 512; P.K = 512; P.Obf = ys; P.list = list; P.cnt = cntl; P.gate = gate; gemm_phase<GM_MOE2, 8>(lds, P, 0, 0); }
      GSYNC();
    }
    for (int rep = 0; rep < NREP(9) - 1; ++rep) { GSYNC(); GSYNC(); GSYNC(); GSYNC(); GSYNC(); GSYNC(); GSYNC(); GSYNC(); GSYNC(); GSYNC(); }
    if (l == 0) {
      const float* mod1 = mod + (size_t)4 * 6144;
      combine_phase(out, ys, modl + 5120, 0, p.norm1_g + 1024, mod1 + 0, mod1 + 1024, hb);
      prep_small_units(lds, bid, nblk, p.w_in + (size_t)1024 * NIN, p.w_out + (size_t)1024 * 1024, p.rgw + 4096, p.rew + 32768, winT, woutT, rt);
      GSYNC();
    } else {
      combine_phase(out, ys, modl + 5120, 1, p.final_g, nullptr, nullptr, nullptr);
    }
  }
}

extern "C" void kernel_launch(void* const* d_in, const int* in_sizes, int n_in, void* d_out, int out_size, void* d_ws, size_t ws_size, hipStream_t stream) {
  if (ws_size < WS_END) return;
  MegaP p{};
  p.x = (const float*)d_in[0]; p.c = (const float*)d_in[1]; p.ada_w = (const float*)d_in[2]; p.ada_b = (const float*)d_in[3]; p.norm1_g = (const float*)d_in[4];
  p.w_in = (const float*)d_in[5]; p.conv_w = (const float*)d_in[6]; p.conv_b = (const float*)d_in[7]; p.cln_g = (const float*)d_in[8]; p.cln_b = (const float*)d_in[9];
  p.moba_g = (const float*)d_in[10]; p.dsa_g = (const float*)d_in[11]; p.w_out = (const float*)d_in[12]; p.norm2_g = (const float*)d_in[13]; p.rgw = (const float*)d_in[14];
  p.rgb = (const float*)d_in[15]; p.rew = (const float*)d_in[16]; p.reb = (const float*)d_in[17]; p.w1 = (const float*)d_in[18]; p.w3 = (const float*)d_in[19];
  p.w2 = (const float*)d_in[20]; p.final_g = (const float*)d_in[21];
  p.out = (float*)d_out; p.ws = (char*)d_ws;
  static int grid_blocks = 0;
  if (!grid_blocks) {
    int dev = 0, cus = 0, per_cu = 0;
    (void)hipGetDevice(&dev);
    (void)hipDeviceGetAttribute(&cus, hipDeviceAttributeMultiprocessorCount, dev);
    (void)hipFuncSetAttribute((const void*)mega, hipFuncAttributeMaxDynamicSharedMemorySize, MEGA_LDS);
    (void)hipOccupancyMaxActiveBlocksPerMultiprocessor(&per_cu, (const void*)mega, NTHR, MEGA_LDS);
    if (per_cu < 1) per_cu = 1;
    if (per_cu > 1) per_cu = 1;
    grid_blocks = cus * per_cu;
  }
  (void)hipMemsetAsync((char*)d_ws + WS_CTL, 0, 32768, stream);
  void* args[] = {&p};
  (void)hipLaunchCooperativeKernel((const void*)mega, dim3(grid_blocks), dim3(NTHR), args, MEGA_LDS, stream);
}
```

```cpp
#include <hip/hip_runtime.h>
#include <hip/hip_cooperative_groups.h>
namespace cg = cooperative_groups;
#include <stdint.h>

#define DI __device__ __forceinline__
typedef unsigned short bf16_t;
typedef short bf16x8 __attribute__((ext_vector_type(8)));
typedef short s16x4 __attribute__((ext_vector_type(4)));
typedef float f32x4 __attribute__((ext_vector_type(4)));
typedef float f32x16 __attribute__((ext_vector_type(16)));
typedef unsigned u32x4 __attribute__((ext_vector_type(4)));
typedef unsigned u32x2 __attribute__((ext_vector_type(2)));
typedef float f32x2_t __attribute__((ext_vector_type(2)));
typedef __bf16 bf16x2_t __attribute__((ext_vector_type(2)));
#define LAS __attribute__((address_space(3)))

constexpr int NB = 4, S = 8192, T = NB * S, D = 1024;
constexpr int PLD = 3456;
constexpr int C_QM = 0, C_KM = 384, C_VM = 768, C_CA = 1152, C_CG = 1408, C_QD = 1664, C_KD = 2048, C_VD = 2432, C_QI = 2816, C_KI = 3328, C_WI = 3392;
constexpr int NIN = 3400;
constexpr float EPS = 1e-6f;
constexpr int NTHR = 512;

constexpr size_t MiB = 1u << 20;
constexpr size_t WS_CTL = 0;
constexpr size_t WS_MOD = 1 * MiB;
constexpr size_t WS_KMEAN = WS_MOD + 256 * 1024;
constexpr size_t WS_SELM = WS_KMEAN + 256 * 1024;
constexpr size_t WS_GATE = WS_SELM + 1 * MiB;
constexpr size_t WS_LOGIT = WS_GATE + 512 * 1024;
constexpr size_t WS_LIST = WS_LOGIT + 5 * MiB;
constexpr size_t WS_WINT = WS_LIST + 8 * MiB;
constexpr size_t WS_WOUTT = WS_WINT + 7 * MiB;
constexpr size_t WS_RT = WS_WOUTT + 2 * MiB;
constexpr size_t WS_W13T = WS_RT + 1 * MiB;
constexpr size_t WS_W2T = WS_W13T + 64 * MiB;
constexpr size_t WS_HB = WS_W2T + 32 * MiB;
constexpr size_t WS_BMT = WS_HB + 64 * MiB;
constexpr size_t WS_PROJ = WS_BMT + 32 * MiB;
constexpr size_t WS_ACT = WS_PROJ;
constexpr size_t WS_YS = WS_PROJ + 64 * MiB;
constexpr size_t WS_PARTO = WS_PROJ + 216 * MiB;
constexpr size_t WS_PARTML = WS_PARTO + 96 * MiB;
constexpr size_t WS_MLIST = WS_PARTML + 6 * MiB;
constexpr size_t WS_END = WS_MLIST + 24 * MiB;
constexpr int CW_CNT = 0;
constexpr int CW_Q = 64;
constexpr int CW_MC = 5120;

DI int otid() { int t = threadIdx.x; asm volatile("" : "+v"(t)); return t; }
DI void st_wt32(unsigned* p, unsigned v) { __hip_atomic_store(p, v, __ATOMIC_RELAXED, __HIP_MEMORY_SCOPE_AGENT); }
DI void st_wt64(unsigned long long* p, unsigned long long v) { __hip_atomic_store(p, v, __ATOMIC_RELAXED, __HIP_MEMORY_SCOPE_AGENT); }
DI float bf2f(bf16_t b) { return __uint_as_float(((unsigned)b) << 16); }
DI float bflo(unsigned u) { return __uint_as_float(u << 16); }
DI float bfhi(unsigned u) { return __uint_as_float(u & 0xffff0000u); }
DI unsigned cvtpk(float lo, float hi) { f32x2_t v = {lo, hi}; bf16x2_t b = __builtin_convertvector(v, bf16x2_t); return __builtin_bit_cast(unsigned, b); }
DI float fexp2(float x) { return __builtin_amdgcn_exp2f(x); }
DI float frcp(float x) { return __builtin_amdgcn_rcpf(x); }
DI float silu_f(float x) { return x * frcp(1.f + fexp2(x * -1.4426950408889634f)); }
DI float wave_sum(float v) {
#pragma unroll
  for (int o = 32; o >= 1; o >>= 1) v += __shfl_xor(v, o);
  return v;
}
#define DPP_STEP(OPF, v, ident, ctrl, rmask) v = OPF(v, (unsigned)__builtin_amdgcn_update_dpp((int)(ident), (int)(v), ctrl, rmask, 0xf, false))
DI unsigned opadd(unsigned a, unsigned b) { return a + b; }
DI unsigned opmin(unsigned a, unsigned b) { return min(a, b); }
DI unsigned opmax(unsigned a, unsigned b) { return max(a, b); }
DI unsigned scan_add(unsigned v) {
  DPP_STEP(opadd, v, 0u, 0x111, 0xf); DPP_STEP(opadd, v, 0u, 0x112, 0xf); DPP_STEP(opadd, v, 0u, 0x114, 0xf); DPP_STEP(opadd, v, 0u, 0x118, 0xf);
  DPP_STEP(opadd, v, 0u, 0x142, 0xa); DPP_STEP(opadd, v, 0u, 0x143, 0xc); return v;
}
DI unsigned red_add(unsigned v) { return (unsigned)__builtin_amdgcn_readlane((int)scan_add(v), 63); }
DI unsigned red_min(unsigned v) {
  DPP_STEP(opmin, v, 0xffffffffu, 0x111, 0xf); DPP_STEP(opmin, v, 0xffffffffu, 0x112, 0xf); DPP_STEP(opmin, v, 0xffffffffu, 0x114, 0xf); DPP_STEP(opmin, v, 0xffffffffu, 0x118, 0xf);
  DPP_STEP(opmin, v, 0xffffffffu, 0x142, 0xa); DPP_STEP(opmin, v, 0xffffffffu, 0x143, 0xc); return (unsigned)__builtin_amdgcn_readlane((int)v, 63);
}
DI unsigned red_max(unsigned v) {
  DPP_STEP(opmax, v, 0u, 0x111, 0xf); DPP_STEP(opmax, v, 0u, 0x112, 0xf); DPP_STEP(opmax, v, 0u, 0x114, 0xf); DPP_STEP(opmax, v, 0u, 0x118, 0xf);
  DPP_STEP(opmax, v, 0u, 0x142, 0xa); DPP_STEP(opmax, v, 0u, 0x143, 0xc); return (unsigned)__builtin_amdgcn_readlane((int)v, 63);
}
#define MFMA16(a, b, c) __builtin_amdgcn_mfma_f32_16x16x32_bf16((a), (b), (c), 0, 0, 0)
#define MFMA32(a, b, c) __builtin_amdgcn_mfma_f32_32x32x16_bf16((a), (b), (c), 0, 0, 0)

DI void mod_units(char* lds, int ubase, int nblk, const float* __restrict__ c, const float* __restrict__ ada_w, const float* __restrict__ ada_b, float* __restrict__ mod) {
  float (*sc)[1024] = (float (*)[1024])lds;
  float (*red)[4][64] = (float (*)[4][64])(lds + 16384);
  const int tid = otid();
  bool loaded = false;
  for (int u = ubase; u < 2 * 96; u += nblk) {
    if (!loaded) { for (int i = tid; i < 4096; i += NTHR) sc[i >> 10][i & 1023] = silu_f(c[i]); __syncthreads(); loaded = true; }
    const int l = u / 96, n = (u % 96) * 64 + (tid & 63), ks = tid >> 6;
    const float* w = ada_w + (size_t)l * 1024 * 6144 + n;
    float a0 = 0.f, a1 = 0.f, a2 = 0.f, a3 = 0.f;
#pragma unroll 8
    for (int k = ks * 128; k < ks * 128 + 128; ++k) {
      const float wv = w[(size_t)k * 6144];
      a0 += sc[0][k] * wv; a1 += sc[1][k] * wv; a2 += sc[2][k] * wv; a3 += sc[3][k] * wv;
    }
    red[ks][0][tid & 63] = a0; red[ks][1][tid & 63] = a1; red[ks][2][tid & 63] = a2; red[ks][3][tid & 63] = a3;
    __syncthreads();
    if (tid < 256) {
      const int b = tid >> 6, nn = tid & 63;
      float s = 0.f;
#pragma unroll
      for (int k = 0; k < 8; ++k) s += red[k][b][nn];
      const int ncol = (u % 96) * 64 + nn;
      mod[((size_t)l * 4 + b) * 6144 + ncol] = s + ada_b[(size_t)l * 6144 + ncol];
    }
    __syncthreads();
  }
}

struct TJob { const float* src; bf16_t* dst; int R, C, Cpad, grp, stride, off; };

DI void transpose_tile_wave(const TJob& J, int tr, int tc, float (*tile)[65], int lane) {
#pragma unroll 1
  for (int hf = 0; hf < 2; ++hf) {
    float4 v[8];
#pragma unroll
    for (int p = 0; p < 8; ++p) {
      const int r = (lane >> 4) + (hf * 8 + p) * 4, c4 = (lane & 15) * 4;
      const int gr = tr * 64 + r, gc = tc * 64 + c4;
      v[p] = make_float4(0.f, 0.f, 0.f, 0.f);
      if (gc + 3 < J.C) v[p] = *(const float4*)(J.src + (size_t)gr * J.C + gc);
      else { float t4[4] = {0.f, 0.f, 0.f, 0.f}; for (int q = 0; q < 4; ++q) if (gc + q < J.C) t4[q] = J.src[(size_t)gr * J.C + gc + q]; v[p] = make_float4(t4[0], t4[1], t4[2], t4[3]); }
    }
#pragma unroll
    for (int p = 0; p < 8; ++p) {
      const int r = (lane >> 4) + (hf * 8 + p) * 4, c4 = (lane & 15) * 4;
      tile[r][c4 + 0] = v[p].x; tile[r][c4 + 1] = v[p].y; tile[r][c4 + 2] = v[p].z; tile[r][c4 + 3] = v[p].w;
    }
  }
  __builtin_amdgcn_fence(__ATOMIC_RELEASE, "wavefront");
  __builtin_amdgcn_wave_barrier();
#pragma unroll
  for (int p = 0; p < 8; ++p) {
    const int n = (lane >> 3) + p * 8, kc = lane & 7;
    const int gc = tc * 64 + n;
    if (gc < J.Cpad) {
      const int drow = (gc / J.grp) * J.stride + J.off + (gc % J.grp);
      u32x4 o;
      o.x = cvtpk(tile[kc * 8 + 0][n], tile[kc * 8 + 1][n]); o.y = cvtpk(tile[kc * 8 + 2][n], tile[kc * 8 + 3][n]);
      o.z = cvtpk(tile[kc * 8 + 4][n], tile[kc * 8 + 5][n]); o.w = cvtpk(tile[kc * 8 + 6][n], tile[kc * 8 + 7][n]);
      *(u32x4*)(J.dst + (size_t)drow * J.R + tr * 64 + kc * 8) = o;
    }
  }
  __builtin_amdgcn_fence(__ATOMIC_RELEASE, "wavefront");
  __builtin_amdgcn_wave_barrier();
}

constexpr int WINT_ROWS = 3584;
constexpr int PREP_UNITS = 896 + 256 + 32 * 384;
DI void prep_unit(int u, const float* w_in, const float* w_out, const float* w1, const float* w3, const float* w2,
                  bf16_t* winT, bf16_t* woutT, bf16_t* w13T, bf16_t* w2T, float (*tile)[65], int lane) {
  TJob J; int tr, tc;
  if (u < 896) { J = TJob{w_in, winT, 1024, NIN, WINT_ROWS, 1 << 30, 0, 0}; tr = u % 16; tc = u / 16; }
  else if (u < 1152) { u -= 896; J = TJob{w_out, woutT, 1024, 1024, 1024, 1 << 30, 0, 0}; tr = u % 16; tc = u / 16; }
  else {
    u -= 1152; const int e = u / 384; int r = u % 384;
    if (r < 128) { J = TJob{w1 + (size_t)e * 1024 * 512, w13T + (size_t)e * 1024 * 1024, 1024, 512, 512, 32, 64, 0}; tr = r % 16; tc = r / 16; }
    else if (r < 256) { r -= 128; J = TJob{w3 + (size_t)e * 1024 * 512, w13T + (size_t)e * 1024 * 1024, 1024, 512, 512, 32, 64, 32}; tr = r % 16; tc = r / 16; }
    else { r -= 256; J = TJob{w2 + (size_t)e * 512 * 1024, w2T + (size_t)e * 1024 * 512, 512, 1024, 1024, 1 << 30, 0, 0}; tr = r % 8; tc = r / 8; }
  }
  transpose_tile_wave(J, tr, tc, tile, lane);
}

DI void prep_rt_unit(int u, const float* __restrict__ rgw, const float* __restrict__ rew, bf16_t* __restrict__ rt) {
#pragma unroll
  for (int q = 0; q < 4; ++q) {
    const int i = u * 2048 + q * NTHR + threadIdx.x;
    const int n = i >> 10, k = i & 1023;
    float v = 0.f;
    if (n < 4) v = rgw[k * 4 + n]; else if (n < 36) v = rew[k * 32 + (n - 4)];
    rt[i] = (bf16_t)(cvtpk(v, 0.f) & 0xffffu);
  }
}
constexpr int PREP_SMALL = 896 + 256;
constexpr int PREP_EXP_ITEMS = (32 * 384) / 8;
DI void prep_small_units(char* lds, int ubase, int nblk, const float* w_in, const float* w_out, const float* rgw, const float* rew, bf16_t* winT, bf16_t* woutT, bf16_t* rt) {
  const int tid = otid(), lane = tid & 63, wid = tid >> 6;
  float (*tile)[65] = (float (*)[65])(lds + wid * 16640);
  for (int u = ubase * 8 + wid; u < PREP_SMALL; u += nblk * 8) prep_unit(u, w_in, w_out, nullptr, nullptr, nullptr, winT, woutT, nullptr, nullptr, tile, lane);
  for (int u = ubase; u < 64; u += nblk) prep_rt_unit(u, rgw, rew, rt);
  __syncthreads();
}
DI void prep_exp_item(char* lds, int item, const float* w1, const float* w3, const float* w2, bf16_t* w13T, bf16_t* w2T) {
  const int tid = otid(), lane = tid & 63, wid = tid >> 6;
  float (*tile)[65] = (float (*)[65])(lds + wid * 16640);
  prep_unit(PREP_SMALL + item * 8 + wid, nullptr, nullptr, w1, w3, w2, nullptr, nullptr, w13T, w2T, tile, lane);
  __syncthreads();
}

DI void wave_sum4(float (&v)[4]) {
#pragma unroll
  for (int o = 32; o >= 1; o >>= 1) {
    float t[4];
#pragma unroll
    for (int r = 0; r < 4; ++r) t[r] = __shfl_xor(v[r], o);
#pragma unroll
    for (int r = 0; r < 4; ++r) v[r] += t[r];
  }
}
DI void rmsmod_phase(const float* __restrict__ x, const float* __restrict__ g, const float* __restrict__ mod_sh, const float* __restrict__ mod_sc, bf16_t* __restrict__ h) {
  const int tid_ = otid(); const int lane = tid_ & 63, wid = tid_ >> 6;
  for (int row0 = (blockIdx.x * 8 + wid) * 4; row0 < T; row0 += gridDim.x * 32) {
    const int b = row0 >> 13;
    float4 v[4][4]; float ss[4];
#pragma unroll
    for (int r = 0; r < 4; ++r) {
      const float* xr = x + (size_t)(row0 + r) * D;
      ss[r] = 0.f;
#pragma unroll
      for (int i = 0; i < 4; ++i) { v[r][i] = *(const float4*)(xr + i * 256 + lane * 4); }
    }
#pragma unroll
    for (int r = 0; r < 4; ++r)
#pragma unroll
      for (int i = 0; i < 4; ++i) ss[r] += v[r][i].x * v[r][i].x + v[r][i].y * v[r][i].y + v[r][i].z * v[r][i].z + v[r][i].w * v[r][i].w;
    wave_sum4(ss);
#pragma unroll
    for (int i = 0; i < 4; ++i) {
      const int col = i * 256 + lane * 4;
      const float4 gg = *(const float4*)(g + col), sc = *(const float4*)(mod_sc + (size_t)b * 6144 + col), sh = *(const float4*)(mod_sh + (size_t)b * 6144 + col);
#pragma unroll
      for (int r = 0; r < 4; ++r) {
        const float rstd = rsqrtf(ss[r] * (1.f / 1024.f) + EPS);
        const float o0 = v[r][i].x * rstd * gg.x * (1.f + sc.x) + sh.x, o1 = v[r][i].y * rstd * gg.y * (1.f + sc.y) + sh.y;
        const float o2 = v[r][i].z * rstd * gg.z * (1.f + sc.z) + sh.z, o3 = v[r][i].w * rstd * gg.w * (1.f + sc.w) + sh.w;
        u32x2 o; o.x = cvtpk(o0, o1); o.y = cvtpk(o2, o3);
        *(u32x2*)(h + (size_t)(row0 + r) * D + col) = o;
      }
    }
  }
}

enum { GM_INPROJ = 0, GM_OUTPROJ = 1, GM_ROUTER = 2, GM_MOE1 = 3, GM_MOE2 = 4 };
struct GemmP {
  const bf16_t* A; const bf16_t* Bt; int lda; int K;
  bf16_t* Obf; int ldo;
  const float* xin; float* xout; const float* gvec;
  float* logits;
  const unsigned* list; const int* cnt; const float* gate;
};
constexpr int GEMM_LDS = 98304 + 1024;

template <int MODE, int NJ, int VAR = 0>
DI void gemm_tile(char* lds, const GemmP& P, const bf16_t* __restrict__ Bt, int m0, int n0, int nvalid, const unsigned* lst, int ebase) {
  constexpr int BN = 32 * NJ, STG = 32768 + BN * 128, NBP = BN / 64;
  const int tid = otid(), lane = tid & 63, wid = __builtin_amdgcn_readfirstlane(tid >> 6), fr = lane & 15, fq = lane >> 4;
  const int wm = wid >> 1, wn = wid & 1;
  const int K = P.K;
  int* ridx = (int*)(lds + 2 * STG);
  if (MODE == GM_MOE1) {
    if (tid < 256) { const int r = tid < nvalid ? tid : 0; ridx[tid] = (int)(lst[r] >> 1); }
    __syncthreads();
  }
  const int prow = lane >> 3, pkc = (lane & 7) ^ (lane >> 3);
  const bf16_t* ap[4];
#pragma unroll
  for (int i = 0; i < 4; ++i) {
    const int row = 8 * (wid + 8 * i) + prow;
    size_t grow;
    if (MODE == GM_MOE1) grow = (size_t)ridx[row];
    else if (MODE == GM_MOE2) grow = (size_t)(ebase + (row < nvalid ? row : 0));
    else grow = (size_t)(m0 + row);
    ap[i] = P.A + grow * P.lda + pkc * 8;
  }
  const bf16_t* bp[NBP];
#pragma unroll
  for (int i = 0; i < NBP; ++i) {
    const int row = 8 * (wid + 8 * i) + prow;
    bp[i] = Bt + (size_t)(n0 + row) * K + pkc * 8;
  }
  f32x4 acc[4][NJ];
#pragma unroll
  for (int i = 0; i < 4; ++i)
#pragma unroll
    for (int j = 0; j < NJ; ++j) acc[i][j] = (f32x4){0.f, 0.f, 0.f, 0.f};
  LAS char* lds3 = (LAS char*)lds;
#define GEMM_STAGE(st, kt_) do { \
    _Pragma("unroll") for (int i = 0; i < 4; ++i) __builtin_amdgcn_global_load_lds((const unsigned*)(ap[i] + (kt_) * 64), (LAS unsigned*)(lds3 + (st) * STG + (wid + 8 * i) * 1024), 16, 0, 0); \
    _Pragma("unroll") for (int i = 0; i < NBP; ++i) __builtin_amdgcn_global_load_lds((const unsigned*)(bp[i] + (kt_) * 64), (LAS unsigned*)(lds3 + (st) * STG + 32768 + (wid + 8 * i) * 1024), 16, 0, 0); \
  } while (0)
#define GEMM_PIECE(st, kt_, q) do { \
    if ((q) < 4) __builtin_amdgcn_global_load_lds((const unsigned*)(ap[(q)] + (kt_) * 64), (LAS unsigned*)(lds3 + (st) * STG + (wid + 8 * (q)) * 1024), 16, 0, 0); \
    else if ((q) - 4 < NBP) __builtin_amdgcn_global_load_lds((const unsigned*)(bp[((q) - 4) < NBP ? (q) - 4 : 0] + (kt_) * 64), (LAS unsigned*)(lds3 + (st) * STG + 32768 + (wid + 8 * ((q) - 4)) * 1024), 16, 0, 0); \
  } while (0)
#define GEMM_LDA(i, base, ko) a[i] = *(const bf16x8*)((base) + (arow + (i) * 16) * 128 + (ko))
#define GEMM_LDB(j, base, ko) b[j] = *(const bf16x8*)((base) + 32768 + (brow + (j) * 16) * 128 + (ko))
#define GEMM_SB __builtin_amdgcn_sched_barrier(0)
#define GEMM_BLOCK(RL, DM, base, ko, st, kt_) do { \
    _Pragma("unroll") for (int j = 0; j < NJ; ++j) acc[0][j] = MFMA16(b[j], a[0], acc[0][j]); \
    if (RL) GEMM_LDA(0, base, ko); \
    if (DM) { GEMM_PIECE(st, kt_, 0); GEMM_PIECE(st, kt_, 1); } \
    GEMM_SB; \
    _Pragma("unroll") for (int j = 0; j < NJ; ++j) acc[1][j] = MFMA16(b[j], a[1], acc[1][j]); \
    if (RL) GEMM_LDA(1, base, ko); \
    if (DM) { GEMM_PIECE(st, kt_, 2); GEMM_PIECE(st, kt_, 3); } \
    GEMM_SB; \
    _Pragma("unroll") for (int j = 0; j < NJ; ++j) { \
      acc[2][j] = MFMA16(b[j], a[2], acc[2][j]); \
      acc[3][j] = MFMA16(b[j], a[3], acc[3][j]); \
      if (RL) GEMM_LDB(j, base, ko); \
      if (DM && (j & 1) == 0) GEMM_PIECE(st, kt_, 4 + (j >> 1)); \
      GEMM_SB; \
    } \
    if (RL) { GEMM_LDA(2, base, ko); GEMM_LDA(3, base, ko); } \
    GEMM_SB; \
  } while (0)
  const int nk = K >> 6;
  const int arow = wm * 64 + fr, brow = wn * (BN / 2) + fr, sw = fr & 7;
  const int ko0 = (fq ^ sw) << 4, ko1 = ((4 + fq) ^ sw) << 4;
  bf16x8 a[4], b[NJ];
  GEMM_STAGE(0, 0);
  asm volatile("s_waitcnt vmcnt(0)" ::: "memory");
  __syncthreads();
  if (VAR != 1) GEMM_STAGE(1, 1);
#pragma unroll
  for (int i = 0; i < 4; ++i) GEMM_LDA(i, lds, ko0);
#pragma unroll
  for (int j = 0; j < NJ; ++j) GEMM_LDB(j, lds, ko0);
  for (int kt = 0; kt < nk; ++kt) {
    const int cur = kt & 1;
    const char* sb = lds + cur * STG;
    const char* sn = lds + (cur ^ 1) * STG;
    GEMM_BLOCK(true, false, sb, ko1, 0, 0);
    asm volatile("s_waitcnt vmcnt(0) lgkmcnt(0)" ::: "memory");
    __syncthreads();
    const int kn = min(kt + 2, nk - 1);
    GEMM_BLOCK(true, VAR != 1, sn, ko0, cur, kn);
  }
  asm volatile("s_waitcnt vmcnt(0)" ::: "memory");
#undef GEMM_BLOCK
#undef GEMM_SB
#undef GEMM_LDA
#undef GEMM_LDB
#undef GEMM_PIECE
#undef GEMM_STAGE
  const int nw0 = n0 + wn * (BN / 2);
#pragma unroll
  for (int i = 0; i < 4; ++i) {
    const int ml = wm * 64 + i * 16 + fr;
    const int m = m0 + ml;
    if (MODE == GM_INPROJ) {
#pragma unroll
      for (int j = 0; j < NJ; ++j) {
        const int n = nw0 + j * 16 + fq * 4;
        if (n < P.ldo) {
          u32x2 o; o.x = cvtpk(acc[i][j][0], acc[i][j][1]); o.y = cvtpk(acc[i][j][2], acc[i][j][3]);
          *(u32x2*)(P.Obf + (size_t)m * P.ldo + n) = o;
        }
      }
    } else if (MODE == GM_OUTPROJ) {
      const int b = m >> 13;
#pragma unroll
      for (int j = 0; j < NJ; ++j) {
        const int n = nw0 + j * 16 + fq * 4;
        const float4 xi = *(const float4*)(P.xin + (size_t)m * D + n);
        const float4 gv = *(const float4*)(P.gvec + (size_t)b * 6144 + n);
        float4 o; o.x = xi.x + gv.x * acc[i][j][0]; o.y = xi.y + gv.y * acc[i][j][1]; o.z = xi.z + gv.z * acc[i][j][2]; o.w = xi.w + gv.w * acc[i][j][3];
        *(float4*)(P.xout + (size_t)m * D + n) = o;
      }
    } else if (MODE == GM_ROUTER) {
#pragma unroll
      for (int j = 0; j < NJ; ++j) {
        const int n = nw0 + j * 16 + fq * 4;
        if (n < 36) { float4 o; o.x = acc[i][j][0]; o.y = acc[i][j][1]; o.z = acc[i][j][2]; o.w = acc[i][j][3]; *(float4*)(P.logits + (size_t)m * 36 + n) = o; }
      }
    } else if (MODE == GM_MOE1) {
      if (ml < nvalid) {
#pragma unroll
        for (int jb2 = 0; jb2 < NJ / 4; ++jb2) {
          const int jb = (nw0 >> 6) + jb2;
#pragma unroll
          for (int j = 0; j < 2; ++j) {
            const int col = jb * 32 + j * 16 + fq * 4;
            float v[4];
#pragma unroll
            for (int q = 0; q < 4; ++q) v[q] = silu_f(acc[i][4 * jb2 + j][q]) * acc[i][4 * jb2 + j + 2][q];
            u32x2 o; o.x = cvtpk(v[0], v[1]); o.y = cvtpk(v[2], v[3]);
            *(u32x2*)(P.Obf + (size_t)(ebase + ml) * 512 + col) = o;
          }
        }
      }
    } else if (MODE == GM_MOE2) {
      if (ml < nvalid) {
        const unsigned slot = lst[ml];
        const float gt = P.gate[slot];
#pragma unroll
        for (int j = 0; j < NJ; ++j) {
          const int n = nw0 + j * 16 + fq * 4;
          u32x2 o; o.x = cvtpk(acc[i][j][0] * gt, acc[i][j][1] * gt); o.y = cvtpk(acc[i][j][2] * gt, acc[i][j][3] * gt);
          *(u32x2*)(P.Obf + (size_t)slot * 1024 + n) = o;
        }
      }
    }
  }
  __syncthreads();
}

template <int MODE, int NJ, int VAR = 0>
DI void gemm_phase(char* lds, const GemmP& P, int ntm, int ntn) {
  constexpr int BN = 32 * NJ;
  const int xcd = blockIdx.x & 7, bi = blockIdx.x >> 3, nbx = gridDim.x >> 3;
  const bool xo = (gridDim.x & 7) == 0;
  if (MODE == GM_MOE1 || MODE == GM_MOE2) {
    constexpr int NNT = 1024 / BN;
    if (xo) {
      int ce[4], tm[4], eb[4];
      {
        int acc_ = 0, q = 0;
#pragma unroll
        for (int k = 0; k < 4; ++k) {
          const int e = xcd + 8 * k;
          for (; q < e; ++q) acc_ += P.cnt[q];
          eb[k] = acc_; ce[k] = P.cnt[e]; tm[k] = (ce[k] + 255) >> 8;
        }
      }
      const int total = (tm[0] + tm[1] + tm[2] + tm[3]) * NNT;
      const int nfull = (total / nbx) * nbx;
      const int nhalf = (NJ == 8) ? 2 * (total - nfull) : 0;
      for (int it = bi; it < nfull + ((NJ == 8) ? nhalf : total - nfull); it += nbx) {
        const bool half = (NJ == 8) && it >= nfull;
        const int j = half ? nfull + ((it - nfull) >> 1) : it;
        int k = 0, r = j;
        if (r >= tm[0] * NNT) { r -= tm[0] * NNT; k = 1; if (r >= tm[1] * NNT) { r -= tm[1] * NNT; k = 2; if (r >= tm[2] * NNT) { r -= tm[2] * NNT; k = 3; } } }
        const int cek = k == 0 ? ce[0] : k == 1 ? ce[1] : k == 2 ? ce[2] : ce[3];
        const int ebk = k == 0 ? eb[0] : k == 1 ? eb[1] : k == 2 ? eb[2] : eb[3];
        const int e = xcd + 8 * k, mt = r / NNT, nt = r % NNT;
        const int nvalid = min(256, cek - mt * 256);
        const unsigned* lst = P.list + (size_t)e * 65536 + mt * 256;
        const bf16_t* Bt = P.Bt + (size_t)e * 1024 * P.K;
        if (half) gemm_tile<MODE, (NJ == 8) ? 4 : NJ, VAR>(lds, P, Bt, mt * 256, nt * BN + ((it - nfull) & 1) * (BN / 2), nvalid, lst, ebk + mt * 256);
        else gemm_tile<MODE, NJ, VAR>(lds, P, Bt, mt * 256, nt * BN, nvalid, lst, ebk + mt * 256);
      }
    } else {
      int total_mt = 0;
      for (int e = 0; e < 32; ++e) total_mt += (P.cnt[e] + 255) >> 8;
      const int total = total_mt * NNT;
      for (int u = blockIdx.x; u < total; u += gridDim.x) {
        int e = 0, rem = u, ebase = 0;
        for (;;) { const int c = P.cnt[e]; const int te = ((c + 255) >> 8) * NNT; if (rem < te) break; rem -= te; ebase += c; ++e; }
        const int ce = P.cnt[e], tme = (ce + 255) >> 8;
        const int nt = rem / tme, mt = rem % tme;
        const int nvalid = min(256, ce - mt * 256);
        const unsigned* lst = P.list + (size_t)e * 65536 + mt * 256;
        const bf16_t* Bt = P.Bt + (size_t)e * 1024 * P.K;
        gemm_tile<MODE, NJ, VAR>(lds, P, Bt, mt * 256, nt * BN, nvalid, lst, ebase + mt * 256);
      }
    }
  } else if (xo && (ntm & 7) == 0) {
    const int per = (ntm >> 3) * ntn;
    for (int j = bi; j < per; j += nbx) {
      const int mt = xcd + 8 * (j / ntn), nt = j % ntn;
      gemm_tile<MODE, NJ, VAR>(lds, P, P.Bt, mt * 256, nt * BN, 256, nullptr, 0);
    }
  } else {
    const int total = ntm * ntn;
    for (int u = blockIdx.x; u < total; u += gridDim.x) {
      const int nt = u / ntm, mt = u % ntm;
      gemm_tile<MODE, NJ, VAR>(lds, P, P.Bt, mt * 256, nt * BN, 256, nullptr, 0);
    }
  }
}

DI void kmean_unit(char* lds, int u, const bf16_t* __restrict__ proj, float* __restrict__ kmean) {
  float* red = (float*)lds;
  const int tid = otid();
  const int b = u >> 5, blk = u & 31;
  const int cc = tid % 48, rg = tid / 48;
  if (rg < 10) {
    const bf16_t* p = proj + (size_t)(b * S + blk * 256) * PLD + C_KM + cc * 8;
    float acc[8] = {0.f, 0.f, 0.f, 0.f, 0.f, 0.f, 0.f, 0.f};
#pragma unroll 13
    for (int r = rg; r < 256; r += 10) {
      const u32x4 v = *(const u32x4*)(p + (size_t)r * PLD);
      acc[0] += bflo(v.x); acc[1] += bfhi(v.x); acc[2] += bflo(v.y); acc[3] += bfhi(v.y);
      acc[4] += bflo(v.z); acc[5] += bfhi(v.z); acc[6] += bflo(v.w); acc[7] += bfhi(v.w);
    }
#pragma unroll
    for (int q = 0; q < 8; ++q) red[rg * 384 + cc * 8 + q] = acc[q];
  }
  __syncthreads();
  if (tid < 384) {
    float sm = 0.f;
#pragma unroll
    for (int g = 0; g < 10; ++g) sm += red[g * 384 + tid];
    kmean[((size_t)(b * 6 + tid / 64) * 32 + blk) * 64 + (tid & 63)] = sm * (1.f / 256.f);
  }
  __syncthreads();
}

constexpr int ATT_LDS = 32768;
constexpr float C2 = 0.125f * 1.4426950408889634f;
DI float max3f(float a, float b, float c) { return __builtin_fmaxf(__builtin_fmaxf(a, b), c); }
DI int crow(int r, int hi) { return (r & 3) + 8 * (r >> 2) + 4 * hi; }
typedef short v4i16_t __attribute__((ext_vector_type(4)));
DI s16x4 vtr(const LAS char* p) { return __builtin_bit_cast(s16x4, __builtin_amdgcn_ds_read_tr16_b64_v4i16((LAS v4i16_t*)p)); }

constexpr int ATT_ST = 65536;
struct AttState { float m, l; f32x16 o0, o1; };

template <int MODE>
DI void attn_stage(char* lds, int bufoff, const bf16_t* __restrict__ proj, int b, int h, int key0, int lane, int wid) {
  constexpr int KC = (MODE == 1) ? C_KD : C_KM, VC = (MODE == 1) ? C_VD : C_VM;
  LAS char* l3 = (LAS char*)lds + bufoff;
  const bf16_t* ks = proj + (size_t)(b * S + key0 + 8 * wid + (lane >> 3)) * PLD + KC + h * 64 + (((lane & 7) ^ (lane >> 3)) << 3);
  const bf16_t* vs = proj + (size_t)(b * S + key0 + 16 * (wid & 3) + (lane >> 2)) * PLD + VC + h * 64 + (wid >> 2) * 32 + ((lane & 3) << 3);
#pragma unroll
  for (int tt = 0; tt < 4; ++tt) {
    __builtin_amdgcn_global_load_lds((const unsigned*)(ks + (size_t)tt * 64 * PLD), (LAS unsigned*)(l3 + tt * 16384 + wid * 1024), 16, 0, 0);
    __builtin_amdgcn_global_load_lds((const unsigned*)(vs + (size_t)tt * 64 * PLD), (LAS unsigned*)(l3 + tt * 16384 + 8192 + (wid >> 2) * 4096 + (wid & 3) * 1024), 16, 0, 0);
  }
}

template <int MODE>
DI void attn_tile(char* lds, int tbuf, const bf16x8 (&qr)[4], AttState& st, uint2 w, int ktl, int qrel, int r32, int hi, int lane) {
  constexpr float THR = 8.f;
  const float NEGBIG = -3.0e38f;
  const char* kb = lds + tbuf;
  const int ksw = r32 & 7;
  f32x16 p0, p1;
  {
    f32x16 zz;
#pragma unroll
    for (int r = 0; r < 16; ++r) zz[r] = 0.f;
    const unsigned nmb = cvtpk(-st.m, 0.f);
    const bf16x8 kone = __builtin_bit_cast(bf16x8, (u32x4){hi ? 0u : 0x3F80u, 0u, 0u, 0u});
    const bf16x8 qm = __builtin_bit_cast(bf16x8, (u32x4){nmb, 0u, 0u, 0u});
    p0 = MFMA32(kone, qm, zz);
    p1 = MFMA32(kone, qm, zz);
  }
#pragma unroll
  for (int d0 = 0; d0 < 4; ++d0) {
    const int co = ((2 * d0 + hi) ^ ksw) << 4;
    const bf16x8 ka = *(const bf16x8*)(kb + r32 * 128 + co);
    const bf16x8 kc = *(const bf16x8*)(kb + (r32 + 32) * 128 + co);
    p0 = MFMA32(ka, qr[d0], p0);
    p1 = MFMA32(kc, qr[d0], p1);
  }
  if (MODE == 0) {
    const int kbase = ktl * 64 + 4 * hi;
#pragma unroll
    for (int r = 0; r < 16; ++r) {
      const int kv = kbase + (r & 3) + 8 * (r >> 2);
      if (kv > qrel) p0[r] = NEGBIG;
      if (kv + 32 > qrel) p1[r] = NEGBIG;
    }
  }
  float mxa = max3f(p0[0], p0[1], p1[0]), mxb = max3f(p0[2], p0[3], p1[1]);
  mxa = max3f(mxa, p1[2], p1[3]);
#pragma unroll
  for (int r = 4; r < 16; r += 4) { mxa = max3f(mxa, p0[r], p0[r + 1]); mxb = max3f(mxb, p0[r + 2], p0[r + 3]); mxa = max3f(mxa, p1[r], p1[r + 1]); mxb = max3f(mxb, p1[r + 2], p1[r + 3]); }
  float mx = fmaxf(mxa, mxb);
  mx = fmaxf(mx, __shfl_xor(mx, 32));
  if (__any(mx > THR)) {
    asm volatile("; rescale (rare)" ::: "memory");
    const float d0_ = (mx > THR) ? mx : 0.f;
    const float mnew = __uint_as_float(cvtpk(st.m + d0_, 0.f) << 16);
    const float d = mnew - st.m;
    st.m = mnew;
    const float alpha = fexp2(-d);
#pragma unroll
    for (int r = 0; r < 16; ++r) { st.o0[r] *= alpha; st.o1[r] *= alpha; p0[r] -= d; p1[r] -= d; }
    st.l *= alpha;
  }
#pragma unroll
  for (int r = 0; r < 16; ++r) { p0[r] = fexp2(p0[r]); p1[r] = fexp2(p1[r]); }
  if (MODE == 1) {
    const unsigned w0 = w.x >> (4 * hi), w1 = w.y >> (4 * hi);
#define DSA_MASK1(R, POS) { int k0_, k1_; asm("v_bfe_i32 %0, %1, " #POS ", 1" : "=v"(k0_) : "v"(w0)); asm("v_bfe_i32 %0, %1, " #POS ", 1" : "=v"(k1_) : "v"(w1)); \
      p0[R] = __uint_as_float(__float_as_uint(p0[R]) & (unsigned)k0_); p1[R] = __uint_as_float(__float_as_uint(p1[R]) & (unsigned)k1_); }
    DSA_MASK1(0, 0) DSA_MASK1(1, 1) DSA_MASK1(2, 2) DSA_MASK1(3, 3) DSA_MASK1(4, 8) DSA_MASK1(5, 9) DSA_MASK1(6, 10) DSA_MASK1(7, 11)
    DSA_MASK1(8, 16) DSA_MASK1(9, 17) DSA_MASK1(10, 18) DSA_MASK1(11, 19) DSA_MASK1(12, 24) DSA_MASK1(13, 25) DSA_MASK1(14, 26) DSA_MASK1(15, 27)
#undef DSA_MASK1
  }
  {
    typedef float f32x2 __attribute__((ext_vector_type(2)));
    f32x2 t[8];
#pragma unroll
    for (int k = 0; k < 8; ++k) t[k] = (f32x2){p0[2 * k], p0[2 * k + 1]} + (f32x2){p1[2 * k], p1[2 * k + 1]};
#pragma unroll
    for (int k = 0; k < 4; ++k) t[k] += t[k + 4];
    t[0] += t[2]; t[1] += t[3];
    t[0] += t[1];
    st.l += t[0].x + t[0].y;
  }
  bf16x8 pa[4];
#pragma unroll
  for (int ks = 0; ks < 2; ++ks) {
    u32x4 a, c;
    a.x = cvtpk(p0[8 * ks + 0], p0[8 * ks + 1]); a.y = cvtpk(p0[8 * ks + 2], p0[8 * ks + 3]); a.z = cvtpk(p0[8 * ks + 4], p0[8 * ks + 5]); a.w = cvtpk(p0[8 * ks + 6], p0[8 * ks + 7]);
    c.x = cvtpk(p1[8 * ks + 0], p1[8 * ks + 1]); c.y = cvtpk(p1[8 * ks + 2], p1[8 * ks + 3]); c.z = cvtpk(p1[8 * ks + 4], p1[8 * ks + 5]); c.w = cvtpk(p1[8 * ks + 6], p1[8 * ks + 7]);
    pa[ks] = __builtin_bit_cast(bf16x8, a); pa[ks + 2] = __builtin_bit_cast(bf16x8, c);
  }
  const LAS char* vb = (const LAS char*)lds + tbuf + 8192 + (4 * hi + ((lane & 15) >> 2)) * 64 + ((lane >> 4) & 1) * 32 + (lane & 3) * 8;
#pragma unroll
  for (int ks = 0; ks < 4; ++ks) {
    const s16x4 l0 = vtr(vb + ks * 1024), h0 = vtr(vb + ks * 1024 + 512);
    const s16x4 l1 = vtr(vb + 4096 + ks * 1024), h1 = vtr(vb + 4096 + ks * 1024 + 512);
    const bf16x8 f0 = (bf16x8){l0[0], l0[1], l0[2], l0[3], h0[0], h0[1], h0[2], h0[3]};
    const bf16x8 f1 = (bf16x8){l1[0], l1[1], l1[2], l1[3], h1[0], h1[1], h1[2], h1[3]};
    st.o0 = MFMA32(f0, pa[ks], st.o0);
    st.o1 = MFMA32(f1, pa[ks], st.o1);
  }
}

DI void attn_load_q(const bf16_t* __restrict__ qp, bf16x8 (&qr)[4]) {
#pragma unroll
  for (int d0 = 0; d0 < 4; ++d0) {
    const u32x4 v = *(const u32x4*)(qp + d0 * 16);
    u32x4 o;
    o.x = cvtpk(bflo(v.x) * C2, bfhi(v.x) * C2); o.y = cvtpk(bflo(v.y) * C2, bfhi(v.y) * C2);
    o.z = cvtpk(bflo(v.z) * C2, bfhi(v.z) * C2); o.w = cvtpk(bflo(v.w) * C2, bfhi(v.w) * C2);
    qr[d0] = __builtin_bit_cast(bf16x8, o);
  }
}
DI void attn_store(bf16_t* op, const AttState& st, float inv) {
#pragma unroll
  for (int g = 0; g < 4; ++g) {
    u32x2 a, c;
    a.x = cvtpk(st.o0[4 * g + 0] * inv, st.o0[4 * g + 1] * inv); a.y = cvtpk(st.o0[4 * g + 2] * inv, st.o0[4 * g + 3] * inv);
    c.x = cvtpk(st.o1[4 * g + 0] * inv, st.o1[4 * g + 1] * inv); c.y = cvtpk(st.o1[4 * g + 2] * inv, st.o1[4 * g + 3] * inv);
    *(u32x2*)(op + 8 * g) = a;
    *(u32x2*)(op + 32 + 8 * g) = c;
  }
}

DI void attn_dsa_unit(char* lds, const bf16_t* __restrict__ proj, bf16_t* __restrict__ mix, const uint2* __restrict__ bmt, int b, int h, int qb) {
  const int tid = otid(), lane = tid & 63, wid = __builtin_amdgcn_readfirstlane(tid >> 6), r32 = lane & 31, hi = lane >> 5;
  const int qrel = wid * 32 + r32, t = qb * 256 + qrel;
  const size_t tokq = (size_t)(b * S + t);
  bf16x8 qr[4];
  attn_load_q(proj + tokq * PLD + C_QD + h * 64 + hi * 8, qr);
  AttState st; st.m = 0.f; st.l = 0.f;
#pragma unroll
  for (int r = 0; r < 16; ++r) { st.o0[r] = 0.f; st.o1[r] = 0.f; }
  const uint2* bmp = bmt + (size_t)(b * 128) * 8192 + t;
  uint2 wn[4];
#pragma unroll
  for (int tt = 0; tt < 4; ++tt) wn[tt] = bmp[(size_t)tt * 8192];
  attn_stage<1>(lds, 0, proj, b, h, 0, lane, wid);
  const int ns = qb + 1;
  for (int s = 0; s < ns; ++s) {
    uint2 wc[4];
#pragma unroll
    for (int tt = 0; tt < 4; ++tt) wc[tt] = wn[tt];
    asm volatile("s_waitcnt vmcnt(0)" ::: "memory");
    __syncthreads();
    if (s + 1 < ns) {
#pragma unroll
      for (int tt = 0; tt < 4; ++tt) wn[tt] = bmp[(size_t)(4 * (s + 1) + tt) * 8192];
      attn_stage<1>(lds, ((s + 1) & 1) * ATT_ST, proj, b, h, (s + 1) * 256, lane, wid);
    }
#pragma unroll
    for (int tt = 0; tt < 4; ++tt) attn_tile<1>(lds, (s & 1) * ATT_ST + tt * 16384, qr, st, wc[tt], 0, qrel, r32, hi, lane);
  }
  float l = st.l; l += __shfl_xor(l, 32);
  attn_store(mix + tokq * D + 640 + h * 64 + 4 * hi, st, 1.f / l);
  __syncthreads();
}

DI void attn_own_unit(char* lds, const bf16_t* __restrict__ proj, bf16_t* __restrict__ part_o, float2* __restrict__ part_ml, int b, int h, int qb) {
  const int tid = otid(), lane = tid & 63, wid = __builtin_amdgcn_readfirstlane(tid >> 6), r32 = lane & 31, hi = lane >> 5;
  const int qrel = wid * 32 + r32, t = qb * 256 + qrel;
  const size_t tokq = (size_t)(b * S + t);
  attn_stage<0>(lds, 0, proj, b, h, qb * 256, lane, wid);
  bf16x8 qr[4];
  attn_load_q(proj + tokq * PLD + C_QM + h * 64 + hi * 8, qr);
  AttState st; st.m = 0.f; st.l = 0.f;
#pragma unroll
  for (int r = 0; r < 16; ++r) { st.o0[r] = 0.f; st.o1[r] = 0.f; }
  asm volatile("s_waitcnt vmcnt(0)" ::: "memory");
  __syncthreads();
#pragma unroll
  for (int tt = 0; tt < 4; ++tt) attn_tile<0>(lds, tt * 16384, qr, st, make_uint2(0u, 0u), tt, qrel, r32, hi, lane);
  float l = st.l; l += __shfl_xor(l, 32);
  const size_t pi = (tokq * 6 + h) * 4 + 3;
  if (hi == 0) st_wt64((unsigned long long*)&part_ml[pi], ((unsigned long long)__float_as_uint(l) << 32) | __float_as_uint(st.m));
  attn_store(part_o + pi * 64 + 4 * hi, st, 1.f / l);
  __syncthreads();
}

DI void attn_gather_unit(char* lds, const bf16_t* __restrict__ proj, bf16_t* __restrict__ part_o, float2* __restrict__ part_ml, int b, int h, int j, const unsigned* __restrict__ lst, int nent) {
  const int tid = otid(), lane = tid & 63, wid = __builtin_amdgcn_readfirstlane(tid >> 6), r32 = lane & 31, hi = lane >> 5;
  attn_stage<2>(lds, 0, proj, b, h, j * 256, lane, wid);
  asm volatile("s_waitcnt vmcnt(0)" ::: "memory");
  __syncthreads();
  const int ntile = (nent + 31) >> 5;
  for (int qt = wid; qt < ntile; qt += 8) {
    const int qi = qt * 32 + r32;
    const bool valid = qi < nent;
    const unsigned e = lst[valid ? qi : 0];
    const int t = (int)(e & 0x1FFFu), pslot = (int)(e >> 13);
    const size_t tokq = (size_t)(b * S + t);
    bf16x8 qr[4];
    attn_load_q(proj + tokq * PLD + C_QM + h * 64 + hi * 8, qr);
    AttState st; st.m = 0.f; st.l = 0.f;
#pragma unroll
    for (int r = 0; r < 16; ++r) { st.o0[r] = 0.f; st.o1[r] = 0.f; }
#pragma unroll
    for (int tt = 0; tt < 4; ++tt) attn_tile<2>(lds, tt * 16384, qr, st, make_uint2(0u, 0u), 0, 0, r32, hi, lane);
    float l = st.l; l += __shfl_xor(l, 32);
    if (valid) {
      const size_t pi = (tokq * 6 + h) * 4 + pslot;
      if (hi == 0) st_wt64((unsigned long long*)&part_ml[pi], ((unsigned long long)__float_as_uint(l) << 32) | __float_as_uint(st.m));
      attn_store(part_o + pi * 64 + 4 * hi, st, 1.f / l);
    }
  }
  __syncthreads();
}

DI void gate_unit(char* lds, int u, const bf16_t* __restrict__ proj, const float* __restrict__ kmean, unsigned* __restrict__ mcnt, unsigned* __restrict__ mlist) {
  unsigned* lc = (unsigned*)lds;
  unsigned* lb = lc + 192;
  float* kml = (float*)(lds + 2048);
  const int tid = otid();
  if (tid < 192) lc[tid] = 0u;
  const int tok = u * 64 + (tid & 63), head = tid >> 6;
  const int b = tok >> 13, t = tok & (S - 1), own = t >> 8;
  for (int i = tid; i < 6 * 32 * 16; i += NTHR) {
    const int jb = (i >> 4) & 31;
    if (jb < own) *(float4*)(kml + i * 4) = *(const float4*)(kmean + (size_t)b * 6 * 32 * 64 + i * 4);
  }
  __syncthreads();
  int sj[3] = {-1, -1, -1}; unsigned sp[3] = {0u, 0u, 0u};
  if (tid < 384) {
    u32x4 q[8];
    const bf16_t* qp = proj + (size_t)tok * PLD + C_QM + head * 64;
#pragma unroll
    for (int i = 0; i < 8; ++i) q[i] = *(const u32x4*)(qp + i * 8);
    float v1 = -INFINITY, v2 = -INFINITY, v3 = -INFINITY; int i1 = -1, i2 = -1, i3 = -1;
    for (int j = 0; j < own; ++j) {
      const float* km = kml + (head * 32 + j) * 64;
      float g = 0.f;
#pragma unroll
      for (int i = 0; i < 8; ++i) {
        const float4 ka = *(const float4*)(km + i * 8), kb = *(const float4*)(km + i * 8 + 4);
        g += bflo(q[i].x) * ka.x + bfhi(q[i].x) * ka.y + bflo(q[i].y) * ka.z + bfhi(q[i].y) * ka.w;
        g += bflo(q[i].z) * kb.x + bfhi(q[i].z) * kb.y + bflo(q[i].w) * kb.z + bfhi(q[i].w) * kb.w;
      }
      if (g > v1) { v3 = v2; i3 = i2; v2 = v1; i2 = i1; v1 = g; i1 = j; }
      else if (g > v2) { v3 = v2; i3 = i2; v2 = g; i2 = j; }
      else if (g > v3) { v3 = g; i3 = j; }
    }
    sj[0] = i1; sj[1] = i2; sj[2] = i3;
#pragma unroll
    for (int p = 0; p < 3; ++p) if (sj[p] >= 0) sp[p] = atomicAdd(&lc[head * 32 + sj[p]], 1u);
  }
  __syncthreads();
  if (tid < 192 && lc[tid]) lb[tid] = atomicAdd(&mcnt[(b * 6 + (tid >> 5)) * 32 + (tid & 31)], lc[tid]);
  __syncthreads();
  if (tid < 384) {
#pragma unroll
    for (int p = 0; p < 3; ++p) if (sj[p] >= 0) {
      const int c = (b * 6 + head) * 32 + sj[p];
      st_wt32(&mlist[(size_t)c * 8192 + lb[head * 32 + sj[p]] + sp[p]], (unsigned)t | ((unsigned)p << 13));
    }
  }
  __syncthreads();
}

DI void conv_unit(char* lds, int u, const bf16_t* __restrict__ proj, bf16_t* __restrict__ mix, const float* __restrict__ conv_w, const float* __restrict__ conv_b,
                  const float* __restrict__ ln_g, const float* __restrict__ ln_b);
DI void attn_queue_phase(char* lds, const bf16_t* proj, bf16_t* mix, const uint2* bmt, bf16_t* part_o, float2* part_ml, const unsigned* mcnt, const unsigned* mlist, unsigned* qhead,
                         const float* w1, const float* w3, const float* w2, bf16_t* w13T, bf16_t* w2T,
                         const float* conv_w, const float* conv_b, const float* ln_g, const float* ln_b) {
  unsigned* pfx = (unsigned*)(lds + 133120);
  unsigned* qw = (unsigned*)(lds + 133120 + 3328);
  const int tid = otid(), lane = tid & 63;
  if (tid < 64) {
    unsigned loc[12]; unsigned sum = 0u;
#pragma unroll
    for (int i = 0; i < 12; ++i) { loc[i] = (mcnt[tid * 12 + i] + 2047u) >> 11; sum += loc[i]; }
    unsigned run = scan_add(sum) - sum;
    if (lane == 0) pfx[0] = 0u;
#pragma unroll
    for (int i = 0; i < 12; ++i) { run += loc[i]; pfx[tid * 12 + i + 1] = run; }
  }
  __syncthreads();
  const int nsp = (int)pfx[768];
  const int natt = 768 + nsp + 768;
  const int nconv = T / 64;
  const int total = natt + nconv + PREP_EXP_ITEMS;
  int qlast = 0;
  for (;;) {
    if (tid == 0) qw[0] = atomicAdd(qhead, 1u);
    __syncthreads();
    const int q = (int)qw[0];
    __syncthreads();
    if (q >= natt) { qlast = q; break; }
    if (q < 768) {
      const int qb = 31 - q / 24, bh = q % 24;
      attn_dsa_unit(lds, proj, mix, bmt, bh / 6, bh % 6, qb);
    } else if (q < 768 + nsp) {
      const unsigned item = (unsigned)(q - 768);
      int lo = 0, hi = 768;
      while (hi - lo > 1) { const int mid = (lo + hi) >> 1; if (pfx[mid] <= item) lo = mid; else hi = mid; }
      const int c = lo, chunk = (int)(item - pfx[c]);
      const int nent = min(2048, (int)mcnt[c] - chunk * 2048);
      attn_gather_unit(lds, proj, part_o, part_ml, c / 192, (c >> 5) % 6, c & 31, mlist + (size_t)c * 8192 + chunk * 2048, nent);
    } else {
      const int o = q - 768 - nsp, qb = 31 - o / 24, bh = o % 24;
      attn_own_unit(lds, proj, part_o, part_ml, bh / 6, bh % 6, qb);
    }
  }
  for (int q = qlast; q < total;) {
    if (q < natt + nconv) conv_unit(lds, q - natt, proj, mix, conv_w, conv_b, ln_g, ln_b);
    else prep_exp_item(lds, q - natt - nconv, w1, w3, w2, w13T, w2T);
    if (tid == 0) qw[0] = atomicAdd(qhead, 1u);
    __syncthreads();
    q = (int)qw[0];
    __syncthreads();
  }
}

constexpr int SEL_CAP = 1024, SEL_G = 512, SEL_K = 256;
constexpr int SEL_LDS = 131072 + 512 + 4096 + 4096;
constexpr int SEL_DUMMY = 131072 + 512 + 4096;
DI unsigned fkey(float f) { const unsigned u = __float_as_uint(f); return (u & 0x80000000u) ? ~u : (u | 0x80000000u); }

DI float fkey_inv(unsigned k) { const unsigned u = (k & 0x80000000u) ? (k & 0x7fffffffu) : ~k; return __uint_as_float(u); }
DI int sbin(float s, float lo, float sc) { return min(63, __float2int_rd((s - lo) * sc)); }
DI int hist_scan(const unsigned* h, int lane, int K) {
  const unsigned Sx = scan_add(h[63 - lane]);
  const unsigned long long m = __ballot(Sx >= (unsigned)K);
  return m ? (63 - (int)__builtin_ctzll(m)) : -1;
}
DI void sel_row_maint(uint2* rowbuf, unsigned* cntp, float* taup, unsigned* hist, bool last, int K = SEL_K, bool thr = false, bool raw = false, uint2* tmp = nullptr) {
  const int lane = otid() & 63;
  int n = (int)*cntp; if (n > SEL_CAP) n = SEL_CAP;
  const int lim = thr ? K - 1 : (last ? SEL_K : (SEL_CAP - SEL_G));
  if (thr && n <= lim) { if (lane == 0) { *cntp = 0u; *taup = -INFINITY; } }
  if (n > lim) {
    unsigned ky[16], kx[16];
    unsigned kmin = 0xffffffffu, kmax = 0u;
#pragma unroll
    for (int i = 0; i < 16; ++i) {
      const int idx = lane + 64 * i; uint2 v = make_uint2(0u, 0u);
      if (64 * i < n) { if (idx < n) { v = rowbuf[idx]; if (raw) v.y = fkey(__uint_as_float(v.y)); kmin = min(kmin, v.y); kmax = max(kmax, v.y); } }
      ky[i] = v.y; kx[i] = v.x;
    }
    kmin = red_min(kmin); kmax = red_max(kmax);
    const float lo = fkey_inv(kmin), range = fkey_inv(kmax) - lo, sc = range > 0.f ? 64.f / range : 0.f;
    hist[lane] = 0u;
    int bn[16];
#pragma unroll
    for (int i = 0; i < 16; ++i) { const int idx = lane + 64 * i; bn[i] = -1; if (64 * i < n) { if (idx < n) { bn[i] = max(0, sbin(fkey_inv(ky[i]), lo, sc)); atomicAdd(&hist[bn[i]], 1u); } } }
    const int L = hist_scan(hist, lane, K);
    unsigned ka = 0xffffffffu, kb = 0xffffffffu;
    int ckeep = 0;
#pragma unroll
    for (int i = 0; i < 16; ++i) { if (64 * i < n) { if (bn[i] >= L) { ka = min(ka, ky[i]); ++ckeep; } if (bn[i] > L) kb = min(kb, ky[i]); } }
    ka = red_min(ka); kb = red_min(kb); ckeep = (int)red_add((unsigned)ckeep);
    if (thr) { if (lane == 0) { *cntp = 0u; *taup = fkey_inv(ka); } return; }
    unsigned theta = ka, phi = 0u;
    int nsel = ckeep;
    if (last || ckeep > SEL_CAP - SEL_G) {
      unsigned av = ka, hi = (kb != 0xffffffffu) ? kb - 1u : kmax;
      int ca = -1;
      const int mL = (int)hist[L];
      if (tmp != nullptr && mL <= 64) {
        const unsigned long long ltm = (1ull << lane) - 1ull;
        int gb = 0;
#pragma unroll
        for (int i = 0; i < 16; ++i) {
          if (64 * i < n) {
            const bool inl = (bn[i] == L);
            const unsigned long long bal = __ballot(inl);
            if (inl) tmp[gb + __popcll(bal & ltm)] = make_uint2(kx[i], ky[i]);
            gb += __popcll(bal);
          }
        }
        const uint2 ev = tmp[lane];
        const bool ok = lane < mL;
        const unsigned ey = ok ? ev.y : 0u, ex = ev.x;
        const int needl = SEL_K - (ckeep - mL);
        while (av < hi) {
          const unsigned d = hi - av, mid = av + (d >> 1) + (d & 1u);
          const int c = __popcll(__ballot(ok && ey >= mid));
          if (c >= needl) { av = mid; ca = c; } else hi = mid - 1u;
          if (c == needl) break;
        }
        theta = av;
        if (ca != needl) {
          const int cgt = __popcll(__ballot(ok && ey > theta));
          const int need = needl - cgt;
          for (int bit = 31; bit >= 0; --bit) {
            const unsigned cand = phi | (1u << bit);
            const int c = __popcll(__ballot(ok && ey == theta && ex >= cand));
            if (c >= need) phi = cand;
            if (c == need) break;
          }
        }
      } else {
        while (av < hi) {
          const unsigned d = hi - av, mid = av + (d >> 1) + (d & 1u);
          int c = 0;
#pragma unroll
          for (int i = 0; i < 16; ++i) { if (64 * i < n) c += __popcll(__ballot(ky[i] >= mid)); }
          if (c >= SEL_K) { av = mid; ca = c; } else hi = mid - 1u;
          if (c == SEL_K) break;
        }
        theta = av;
        if (ca != SEL_K) {
          int cgt = 0;
#pragma unroll
          for (int i = 0; i < 16; ++i) cgt += __popcll(__ballot(ky[i] > theta));
          const int need = SEL_K - cgt;
          for (int bit = 31; bit >= 0; --bit) {
            const unsigned cand = phi | (1u << bit);
            int c = 0;
#pragma unroll
            for (int i = 0; i < 16; ++i) c += __popcll(__ballot(ky[i] == theta && kx[i] >= cand));
            if (c >= need) phi = cand;
            if (c == need) break;
          }
        }
      }
      nsel = SEL_K;
    }
    const unsigned long long lt = (1ull << lane) - 1ull;
    int base = 0;
#pragma unroll
    for (int i = 0; i < 16; ++i) {
      if (64 * i < n) {
        const bool sl = (ky[i] > theta) || (ky[i] == theta && kx[i] >= phi);
        const unsigned long long bal = __ballot(sl);
        const int pos = base + __popcll(bal & lt);
        if (sl && pos < SEL_CAP) rowbuf[pos] = make_uint2(kx[i], ky[i]);
        base += __popcll(bal);
      }
    }
    if (lane == 0) { *cntp = (unsigned)nsel; *taup = fkey_inv(theta); }
  }
}

constexpr int SEL_CTL = 131072, SEL_HIST = 131072 + 512;
template <int SM>
DI void dsa_select_unit(char* lds, const bf16_t* __restrict__ proj, uint2* __restrict__ bmt, int b, int rg) {
  uint2* buf = (uint2*)lds;
  unsigned* cnt = (unsigned*)(lds + SEL_CTL);
  float* tauf = (float*)(cnt + 16);
  unsigned* flag = cnt + 32;
  unsigned* hist = (unsigned*)(lds + SEL_HIST);
  const int tid = otid(), lane = tid & 63, wid = __builtin_amdgcn_readfirstlane(tid >> 6), fr = lane & 15, fq = lane >> 4;
  const int t0 = rg * 16, t = t0 + fr;
  if (tid < 16) { cnt[tid] = 0u; tauf[tid] = -INFINITY; }
  if (tid == 0) flag[0] = 0u;
  const bf16_t* qrow = proj + (size_t)(b * S + t) * PLD;
  bf16x8 qf[8][2]; float w[8];
#pragma unroll
  for (int hh = 0; hh < 8; ++hh) {
    qf[hh][0] = *(const bf16x8*)(qrow + C_QI + hh * 64 + fq * 8);
    qf[hh][1] = *(const bf16x8*)(qrow + C_QI + hh * 64 + 32 + fq * 8);
    w[hh] = bf2f(qrow[C_WI + hh]);
  }
  const int ntile = rg + 1;
  const bf16_t* kbase = proj + (size_t)(b * S + fr) * PLD + C_KI + fq * 8;
  bf16x8 q9[2];
#pragma unroll
  for (int s = 0; s < 2; ++s) {
    float f[8];
#pragma unroll
    for (int j = 0; j < 8; ++j) {
      float a = 0.f;
#pragma unroll
      for (int hh = 0; hh < 8; ++hh) a += w[hh] * bf2f((bf16_t)qf[hh][s][j]);
      f[j] = a;
    }
    u32x4 o; o.x = cvtpk(f[0], f[1]); o.y = cvtpk(f[2], f[3]); o.z = cvtpk(f[4], f[5]); o.w = cvtpk(f[6], f[7]);
    q9[s] = __builtin_bit_cast(bf16x8, o);
  }
  unsigned dmask = 0u;
#pragma unroll
  for (int r = 0; r < 4; ++r) dmask |= (fq * 4 + r <= fr) ? (1u << r) : 0u;
  __syncthreads();
  uint2* const dummy = (uint2*)(lds + SEL_DUMMY) + tid;
  auto stream = [&](int first, int step, int kend, float tv, bool raw) {
    bf16x8 kf[4][2];
#pragma unroll
    for (int i = 0; i < 4; ++i) {
      const int kt = first + i * step;
      if (kt < kend) { const bf16_t* kp = kbase + (size_t)kt * 16 * PLD; kf[i][0] = *(const bf16x8*)kp; kf[i][1] = *(const bf16x8*)(kp + 32); }
    }
    for (int kb0 = first; kb0 < kend; kb0 += 4 * step) {
      bf16x8 kn[4][2];
#pragma unroll
      for (int i = 0; i < 4; ++i) {
        const int kt = kb0 + (4 + i) * step;
        if (kt < kend) { const bf16_t* kp = kbase + (size_t)kt * 16 * PLD; kn[i][0] = *(const bf16x8*)kp; kn[i][1] = *(const bf16x8*)(kp + 32); }
      }
      f32x4 sv[4];
      unsigned pmask = 0u;
      {
        const f32x4 z = (f32x4){0.f, 0.f, 0.f, 0.f};
        f32x4 xb[3];
        f32x4 acc = z;
#define SEL_PAIR(n) do { const int i_ = (n) / 9, j_ = (n) % 9; \
          const f32x4 t_ = MFMA16(kf[i_][0], j_ ? qf[j_ ? j_ - 1 : 0][0] : q9[0], z); \
          xb[(n) % 3] = MFMA16(kf[i_][1], j_ ? qf[j_ ? j_ - 1 : 0][1] : q9[1], t_); } while (0)
        SEL_PAIR(0); SEL_PAIR(1);
#pragma unroll
        for (int n = 0; n < 36; ++n) {
          if (n + 2 < 36) SEL_PAIR(n + 2);
          __builtin_amdgcn_sched_barrier(0);
          const int i = n / 9, j = n % 9;
          if (j == 0) acc = xb[n % 3];
          else {
#pragma unroll
            for (int r = 0; r < 4; ++r) { float v = fmaf(fabsf(xb[n % 3][r]), w[j - 1], acc[r]); asm volatile("" : "+v"(v)); acc[r] = v; }
          }
          if (j == 8) {
            const int kt = kb0 + i * step;
            sv[i] = acc;
            if (SM == 1) { asm volatile("" :: "v"(acc[0]), "v"(acc[1]), "v"(acc[2]), "v"(acc[3])); }
            else {
              const unsigned allow = (kt < kend) ? ((kt == ntile - 1) ? dmask : 0xfu) : 0u;
              unsigned pm = 0u;
#pragma unroll
              for (int r = 0; r < 4; ++r) pm |= (acc[r] >= tv) ? (1u << r) : 0u;
              pmask |= (pm & allow) << (i * 4);
            }
          }
          __builtin_amdgcn_sched_barrier(0);
        }
#undef SEL_PAIR
      }
      if (SM != 1) {
        const int np = __popc(pmask);
        unsigned slot = 0u;
        if (np) slot = atomicAdd(&cnt[fr], (unsigned)np);
        if (slot + (unsigned)np > (unsigned)SEL_CAP) slot = (unsigned)(SEL_CAP - 16);
        uint2* rb = buf + fr * SEL_CAP;
#pragma unroll
        for (int i = 0; i < 4; ++i) {
          const unsigned xb = ~(unsigned)((kb0 + i * step) * 16 + fq * 4);
#pragma unroll
          for (int r = 0; r < 4; ++r) {
            const int e = i * 4 + r;
            const unsigned pos = slot + (unsigned)__popc(pmask & ((1u << e) - 1u));
            uint2* dst = ((pmask >> e) & 1u) ? (rb + pos) : dummy;
            *dst = make_uint2(xb - (unsigned)r, raw ? __float_as_uint(sv[i][r]) : fkey(sv[i][r]));
          }
        }
      }
#pragma unroll
      for (int i = 0; i < 4; ++i) { kf[i][0] = kn[i][0]; kf[i][1] = kn[i][1]; }
    }
  };
  bool done = false;
  if (SM == 0 || SM == 3) {
    if (ntile > 64) {
      stream(8 * wid, 64, ntile, -INFINITY, true);
      __syncthreads();
#pragma unroll 1
      for (int rr = 0; rr < 2; ++rr) {
        const int row = 2 * wid + rr;
        const int ns = (int)cnt[row], nrow = t0 + row + 1;
        const int K = min(ns, (2 * SEL_K * ns + nrow - 1) / nrow);
        sel_row_maint(buf + row * SEL_CAP, &cnt[row], &tauf[row], hist + wid * 64, false, max(K, 1), true, true);
      }
      __syncthreads();
      stream(wid, 8, ntile, tauf[fr], true);
      __syncthreads();
      if (tid < 16) { const unsigned c = cnt[tid]; if (c < (unsigned)SEL_K || c > (unsigned)SEL_CAP) atomicOr(&flag[0], 1u); }
      __syncthreads();
      done = (flag[0] == 0u);
      if (done) {
#pragma unroll 1
        for (int rr = 0; rr < 2; ++rr) { const int row = 2 * wid + rr; sel_row_maint(buf + row * SEL_CAP, &cnt[row], &tauf[row], hist + wid * 64, true, SEL_K, false, true, (uint2*)(lds + SEL_DUMMY) + wid * 64); }
      }
      __syncthreads();
      if (!done && tid < 16) { cnt[tid] = 0u; tauf[tid] = -INFINITY; }
      __syncthreads();
    }
  }
  if (!done) {
    const int nround = (ntile + 31) >> 5;
    for (int rd = 0; rd < nround; ++rd) {
      stream(rd * 32 + wid, 8, min(ntile, rd * 32 + 32), tauf[fr], false);
      __syncthreads();
      const bool last = (rd == nround - 1);
      if (SM == 1 || SM == 2) continue;
#pragma unroll 1
      for (int rr = 0; rr < 2; ++rr) {
        const int row = 2 * wid + rr;
        sel_row_maint(buf + row * SEL_CAP, &cnt[row], &tauf[row], hist + wid * 64, last, SEL_K, false, false, (uint2*)(lds + SEL_DUMMY) + wid * 64);
      }
      __syncthreads();
    }
  }
  if (SM != 0) { __syncthreads(); return; }
#pragma unroll
  for (int i = 0; i < 8; ++i) { const int wd = tid + NTHR * i; *(unsigned*)(lds + (wd >> 8) * 8192 + 4096 + (wd & 255) * 4) = 0u; }
  __syncthreads();
  {
    const int row = tid >> 5;
    int n = (int)cnt[row]; if (n > SEL_K) n = SEL_K;
    unsigned* img = (unsigned*)(lds + row * 8192 + 4096);
#pragma unroll
    for (int i = 0; i < 8; ++i) {
      const int e = (tid & 31) + 32 * i;
      if (e < n) { const unsigned idx = ~buf[row * SEL_CAP + e].x; atomicOr(&img[idx >> 5], 1u << (idx & 31)); }
    }
  }
  __syncthreads();
  {
    const int ntw = 4 * (t0 >> 8) + 4;
    const int r = tid & 15;
    const unsigned* img = (const unsigned*)(lds + r * 8192 + 4096);
    for (int tile = tid >> 4; tile < ntw; tile += 32)
      bmt[((size_t)(b * 128 + tile)) * 8192 + t0 + r] = make_uint2(img[2 * tile], img[2 * tile + 1]);
  }
  __syncthreads();
}

constexpr int MIX_LDS = 94 * 256 * 4;
DI void conv_unit(char* lds, int u, const bf16_t* __restrict__ proj, bf16_t* __restrict__ mix, const float* __restrict__ conv_w, const float* __restrict__ conv_b,
                  const float* __restrict__ ln_g, const float* __restrict__ ln_b) {
  float* ut = (float*)lds;
  const int tid = otid(), lane = tid & 63, wid = tid >> 6;
  {
    const int tok0 = u * 64, b = tok0 >> 13, t0 = tok0 & (S - 1);
#pragma unroll
    for (int it = 0; it < 6; ++it) {
      const int task = tid + it * NTHR;
      if (task >= 94 * 32) break;
      const int row = task >> 5, cc = (task & 31) * 8;
      const int tt = t0 - 30 + row;
      float uv[8] = {0.f, 0.f, 0.f, 0.f, 0.f, 0.f, 0.f, 0.f};
      if (tt >= 0) {
        const bf16_t* pr = proj + (size_t)(b * S + tt) * PLD;
        const u32x4 a = *(const u32x4*)(pr + C_CA + cc), g = *(const u32x4*)(pr + C_CG + cc);
        const float av[8] = {bflo(a.x), bfhi(a.x), bflo(a.y), bfhi(a.y), bflo(a.z), bfhi(a.z), bflo(a.w), bfhi(a.w)};
        const float gv[8] = {bflo(g.x), bfhi(g.x), bflo(g.y), bfhi(g.y), bflo(g.z), bfhi(g.z), bflo(g.w), bfhi(g.w)};
#pragma unroll
        for (int q = 0; q < 8; ++q) uv[q] = av[q] * frcp(1.f + fexp2(gv[q] * -1.4426950408889634f));
      }
      *(float4*)(ut + row * 256 + cc) = make_float4(uv[0], uv[1], uv[2], uv[3]);
      *(float4*)(ut + row * 256 + cc + 4) = make_float4(uv[4], uv[5], uv[6], uv[7]);
    }
    __syncthreads();
    const int c = tid & 255, half = tid >> 8;
    float cw[31];
#pragma unroll
    for (int w = 0; w < 31; ++w) cw[w] = conv_w[w * 256 + c];
    float y[32];
    const float cb = conv_b[c];
#pragma unroll
    for (int o = 0; o < 32; ++o) y[o] = cb;
#pragma unroll
    for (int rho = 0; rho < 62; ++rho) {
      const float uvv = ut[(half * 32 + rho) * 256 + c];
#pragma unroll
      for (int o = 0; o < 32; ++o) { if (rho - o >= 0 && rho - o <= 30) y[o] += uvv * cw[rho - o]; }
    }
    __syncthreads();
#pragma unroll
    for (int o = 0; o < 32; ++o) ut[(half * 32 + o) * 256 + c] = y[o];
    __syncthreads();
    {
      const float4 gg = *(const float4*)(ln_g + lane * 4), bb = *(const float4*)(ln_b + lane * 4);
#pragma unroll 1
      for (int i4 = 0; i4 < 8; i4 += 4) {
        float4 v[4]; float sm[4], vr[4];
#pragma unroll
        for (int r = 0; r < 4; ++r) { v[r] = *(const float4*)(ut + (wid * 8 + i4 + r) * 256 + lane * 4); sm[r] = v[r].x + v[r].y + v[r].z + v[r].w; }
        wave_sum4(sm);
#pragma unroll
        for (int r = 0; r < 4; ++r) {
          const float mu = sm[r] * (1.f / 256.f);
          v[r].x -= mu; v[r].y -= mu; v[r].z -= mu; v[r].w -= mu;
          vr[r] = v[r].x * v[r].x + v[r].y * v[r].y + v[r].z * v[r].z + v[r].w * v[r].w;
        }
        wave_sum4(vr);
#pragma unroll
        for (int r = 0; r < 4; ++r) {
          const float rs = rsqrtf(vr[r] * (1.f / 256.f) + EPS);
          const float z0 = v[r].x * rs * gg.x + bb.x, z1 = v[r].y * rs * gg.y + bb.y, z2 = v[r].z * rs * gg.z + bb.z, z3 = v[r].w * rs * gg.w + bb.w;
          u32x2 o; o.x = cvtpk(silu_f(z0), silu_f(z1)); o.y = cvtpk(silu_f(z2), silu_f(z3));
          *(u32x2*)(mix + (size_t)(tok0 + wid * 8 + i4 + r) * D + 384 + lane * 4) = o;
        }
      }
    }
    __syncthreads();
  }
}

DI void mixfin_phase(bf16_t* __restrict__ mix, const float* __restrict__ mg, const float* __restrict__ dg, const bf16_t* __restrict__ part_o, const float2* __restrict__ part_ml) {
  const int tid = otid(), lane = tid & 63, wid = tid >> 6;
  for (int u = blockIdx.x; u < T / 64; u += gridDim.x) {
    const int tok0 = u * 64, t0 = tok0 & (S - 1);
    {
      const int nsel = min(3, t0 >> 8);
#pragma unroll 4
      for (int i = 0; i < 8; ++i) {
        const int tl = wid * 8 + i;
        const size_t tok = (size_t)(tok0 + tl);
        bf16_t* mr = mix + tok * D;
        float av[8] = {0.f, 0.f, 0.f, 0.f, 0.f, 0.f, 0.f, 0.f};
#pragma unroll
        for (int ch = 0; ch < 2; ++ch) {
          if (ch == 0 || lane < 32) {
            const int col = ch * 256 + lane * 4, hh = col >> 6, d0 = col & 63;
            const size_t pb = (tok * 6 + hh) * 4;
            const float2 ml3 = part_ml[pb + 3];
            float2 mls[3]; float M = ml3.x;
#pragma unroll
            for (int p = 0; p < 3; ++p) { mls[p] = make_float2(-1e30f, 0.f); if (p < nsel) { mls[p] = part_ml[pb + p]; M = fmaxf(M, mls[p].x); } }
            float wsum = 0.f, acc4[4] = {0.f, 0.f, 0.f, 0.f};
#pragma unroll
            for (int p = 0; p < 4; ++p) {
              if (p == 3 || p < nsel) {
                const float2 mlp = (p == 3) ? ml3 : mls[p < 3 ? p : 0];
                const float wgt = mlp.y * fexp2(mlp.x - M);
                const u32x2 ov = *(const u32x2*)(part_o + (pb + p) * 64 + d0);
                wsum += wgt;
                acc4[0] += wgt * bflo(ov.x); acc4[1] += wgt * bfhi(ov.x); acc4[2] += wgt * bflo(ov.y); acc4[3] += wgt * bfhi(ov.y);
              }
            }
            const float iw = 1.f / wsum;
#pragma unroll
            for (int q = 0; q < 4; ++q) av[ch * 4 + q] = acc4[q] * iw;
          }
        }
        {
          const float ss = wave_sum(av[0] * av[0] + av[1] * av[1] + av[2] * av[2] + av[3] * av[3] + av[4] * av[4] + av[5] * av[5] + av[6] * av[6] + av[7] * av[7]);
          const float rs = rsqrtf(ss * (1.f / 384.f) + EPS);
          const float4 g0 = *(const float4*)(mg + lane * 4);
          u32x2 o; o.x = cvtpk(av[0] * rs * g0.x, av[1] * rs * g0.y); o.y = cvtpk(av[2] * rs * g0.z, av[3] * rs * g0.w);
          *(u32x2*)(mr + lane * 4) = o;
          if (lane < 32) {
            const float4 g1 = *(const float4*)(mg + 256 + lane * 4);
            u32x2 o2; o2.x = cvtpk(av[4] * rs * g1.x, av[5] * rs * g1.y); o2.y = cvtpk(av[6] * rs * g1.z, av[7] * rs * g1.w);
            *(u32x2*)(mr + 256 + lane * 4) = o2;
          }
        }
        {
          bf16_t* pp = mr + 640;
          const u32x2 a = *(const u32x2*)(pp + lane * 4);
          u32x2 c2 = (u32x2){0u, 0u};
          if (lane < 32) c2 = *(const u32x2*)(pp + 256 + lane * 4);
          const float a0 = bflo(a.x), a1 = bfhi(a.x), a2 = bflo(a.y), a3 = bfhi(a.y);
          const float c0 = bflo(c2.x), c1 = bfhi(c2.x), c2f = bflo(c2.y), c3 = bfhi(c2.y);
          const float ss = wave_sum(a0 * a0 + a1 * a1 + a2 * a2 + a3 * a3 + c0 * c0 + c1 * c1 + c2f * c2f + c3 * c3);
          const float rs = rsqrtf(ss * (1.f / 384.f) + EPS);
          const float4 g0 = *(const float4*)(dg + lane * 4);
          u32x2 o; o.x = cvtpk(a0 * rs * g0.x, a1 * rs * g0.y); o.y = cvtpk(a2 * rs * g0.z, a3 * rs * g0.w);
          *(u32x2*)(pp + lane * 4) = o;
          if (lane < 32) {
            const float4 g1 = *(const float4*)(dg + 256 + lane * 4);
            u32x2 o2; o2.x = cvtpk(c0 * rs * g1.x, c1 * rs * g1.y); o2.y = cvtpk(c2f * rs * g1.z, c3 * rs * g1.w);
            *(u32x2*)(pp + 256 + lane * 4) = o2;
          }
        }
      }
    }
    __syncthreads();
  }
}

DI void route_phase(char* lds, const float* __restrict__ logits, const float* __restrict__ rgb, const float* __restrict__ reb, unsigned* __restrict__ list, int* __restrict__ cnt, float* __restrict__ gate) {
  unsigned* lcnt = (unsigned*)lds;
  unsigned* lbase = lcnt + 32;
  const int tid = otid();
  for (int u = blockIdx.x; u < T / NTHR; u += gridDim.x) {
    if (tid < 32) lcnt[tid] = 0u;
    __syncthreads();
    const int tok = u * NTHR + tid;
    const float* lg = logits + (size_t)tok * 36;
    float gl[4];
#pragma unroll
    for (int i = 0; i < 4; ++i) gl[i] = lg[i] + rgb[i];
    int gi = 0; float gm = gl[0];
#pragma unroll
    for (int i = 1; i < 4; ++i) if (gl[i] > gm) { gm = gl[i]; gi = i; }
    float gs = 0.f;
#pragma unroll
    for (int i = 0; i < 4; ++i) gs += __expf(gl[i] - gm);
    const float gw = 1.f / gs;
    float e1 = -INFINITY, e2 = -INFINITY; int j1 = 0, j2 = 0;
    for (int j = 0; j < 8; ++j) {
      const float v = lg[4 + gi * 8 + j] + reb[gi * 8 + j];
      if (v > e1) { e2 = e1; j2 = j1; e1 = v; j1 = j; }
      else if (v > e2) { e2 = v; j2 = j; }
    }
    const float p2 = 1.f / (1.f + __expf(e1 - e2)), p1 = 1.f - p2;
    const int ex1 = gi * 8 + j1, ex2 = gi * 8 + j2;
    gate[tok * 2] = gw * p1; gate[tok * 2 + 1] = gw * p2;
    const unsigned pos1 = atomicAdd(&lcnt[ex1], 1u);
    const unsigned pos2 = atomicAdd(&lcnt[ex2], 1u);
    __syncthreads();
    if (tid < 32) lbase[tid] = (unsigned)atomicAdd(&cnt[tid], (int)lcnt[tid]);
    __syncthreads();
    st_wt32(&list[(size_t)ex1 * 65536 + lbase[ex1] + pos1], (unsigned)(tok * 2));
    st_wt32(&list[(size_t)ex2 * 65536 + lbase[ex2] + pos2], (unsigned)(tok * 2 + 1));
    __syncthreads();
  }
}

DI void combine_phase(float* __restrict__ xio, const bf16_t* __restrict__ ys, const float* __restrict__ g2, int final_mode,
                      const float* __restrict__ g, const float* __restrict__ mod_sh, const float* __restrict__ mod_sc, bf16_t* __restrict__ h) {
  const int tid_ = otid(); const int lane = tid_ & 63, wid = tid_ >> 6;
  for (int row0 = (blockIdx.x * 8 + wid) * 2; row0 < T; row0 += gridDim.x * 16) {
    const int b = row0 >> 13;
    float4 v[2][4]; float ssa[4] = {0.f, 0.f, 0.f, 0.f};
    u32x2 ya[2][4], yc[2][4];
#pragma unroll
    for (int r = 0; r < 2; ++r) {
      const float* xr = xio + (size_t)(row0 + r) * D;
      const bf16_t* y0 = ys + (size_t)(row0 + r) * 2048;
#pragma unroll
      for (int i = 0; i < 4; ++i) {
        const int col = i * 256 + lane * 4;
        v[r][i] = *(const float4*)(xr + col);
        ya[r][i] = *(const u32x2*)(y0 + col); yc[r][i] = *(const u32x2*)(y0 + 1024 + col);
      }
    }
#pragma unroll
    for (int i = 0; i < 4; ++i) {
      const int col = i * 256 + lane * 4;
      const float4 gg = *(const float4*)(g2 + (size_t)b * 6144 + col);
#pragma unroll
      for (int r = 0; r < 2; ++r) {
        v[r][i].x += gg.x * (bflo(ya[r][i].x) + bflo(yc[r][i].x)); v[r][i].y += gg.y * (bfhi(ya[r][i].x) + bfhi(yc[r][i].x));
        v[r][i].z += gg.z * (bflo(ya[r][i].y) + bflo(yc[r][i].y)); v[r][i].w += gg.w * (bfhi(ya[r][i].y) + bfhi(yc[r][i].y));
        ssa[r] += v[r][i].x * v[r][i].x + v[r][i].y * v[r][i].y + v[r][i].z * v[r][i].z + v[r][i].w * v[r][i].w;
      }
    }
    wave_sum4(ssa);
#pragma unroll
    for (int i = 0; i < 4; ++i) {
      const int col = i * 256 + lane * 4;
      const float4 gg = *(const float4*)(g + col);
      float4 sc = make_float4(0.f, 0.f, 0.f, 0.f), sh = sc;
      if (!final_mode) { sc = *(const float4*)(mod_sc + (size_t)b * 6144 + col); sh = *(const float4*)(mod_sh + (size_t)b * 6144 + col); }
#pragma unroll
      for (int r = 0; r < 2; ++r) {
        const float rstd = rsqrtf(ssa[r] * (1.f / 1024.f) + EPS);
        float* xr = xio + (size_t)(row0 + r) * D;
        if (final_mode) {
          *(float4*)(xr + col) = make_float4(v[r][i].x * rstd * gg.x, v[r][i].y * rstd * gg.y, v[r][i].z * rstd * gg.z, v[r][i].w * rstd * gg.w);
        } else {
          *(float4*)(xr + col) = v[r][i];
          u32x2 o;
          o.x = cvtpk(v[r][i].x * rstd * gg.x * (1.f + sc.x) + sh.x, v[r][i].y * rstd * gg.y * (1.f + sc.y) + sh.y);
          o.y = cvtpk(v[r][i].z * rstd * gg.z * (1.f + sc.z) + sh.z, v[r][i].w * rstd * gg.w * (1.f + sc.w) + sh.w);
          *(u32x2*)(h + (size_t)(row0 + r) * D + col) = o;
        }
      }
    }
  }
}

#define XB_TMO      128
#define XB_XCNT(j)  (256  + 64 * (j))
#define XB_XSUB(j)  (1280 + 64 * (j))
#define XB_XGEN(j)  (2304 + 64 * (j))
#define XB_TOP      3328
#define XB_TOPGEN   3392
#define XCD_BAR_WORDS 3456
#define XB_SPIN_CAP (1u << 18)
DI unsigned xb_ld(unsigned* p) { return __hip_atomic_load(p, __ATOMIC_RELAXED, __HIP_MEMORY_SCOPE_AGENT); }
DI unsigned xb_add(unsigned* p, unsigned v) { return __hip_atomic_fetch_add(p, v, __ATOMIC_RELAXED, __HIP_MEMORY_SCOPE_AGENT); }
DI unsigned xb_xcc_id() { return (unsigned)__builtin_amdgcn_s_getreg((3 << 11) | 20) & 0xFu; }
#define XB_SPIN(cond, bar) do { unsigned _sp = 0; while (cond) { __builtin_amdgcn_s_sleep(1); \
    if ((++_sp & 255u) == 0u) { if (xb_ld(&(bar)[XB_TMO])) break; if (_sp > XB_SPIN_CAP) { atomicAdd(&(bar)[XB_TMO], 1u); break; } } } } while (0)
struct XcdBarrier { unsigned* bar; unsigned x; volatile LAS unsigned* st; };
DI XcdBarrier xcd_barrier_post(unsigned* bar, volatile LAS unsigned* st) {
  XcdBarrier b; b.bar = bar; b.x = xb_xcc_id(); b.st = st;
  if (threadIdx.x == 0) (void)xb_add(&bar[XB_XCNT(b.x)], 1u);
  return b;
}
DI void xcd_barrier_complete(unsigned* bar, unsigned x, unsigned& nloc, unsigned& nx) {
  const unsigned G = gridDim.x * gridDim.y * gridDim.z;
  unsigned sum, cnt, mine, sp = 0u;
  for (;;) {
    sum = 0u; cnt = 0u; mine = 0u;
#pragma unroll
    for (unsigned j = 0; j < 16; ++j) { const unsigned c = xb_ld(&bar[XB_XCNT(j)]); sum += c; cnt += (c > 0u) ? 1u : 0u; mine = (j == x) ? c : mine; }
    if (sum == G) break;
    __builtin_amdgcn_s_sleep(1);
    if ((++sp & 255u) == 0u) { if (xb_ld(&bar[XB_TMO])) break; if (sp > XB_SPIN_CAP) { atomicAdd(&bar[XB_TMO], 1u); break; } }
  }
  nloc = mine > 0u ? mine : 1u; nx = cnt > 0u ? cnt : 1u;
}
DI void xcd_barrier(const XcdBarrier& b) {
  asm volatile("s_waitcnt vmcnt(0)" ::: "memory");
  __syncthreads();
  if (threadIdx.x == 0) {
    unsigned* bar = b.bar;
    __builtin_amdgcn_s_waitcnt(0);
    unsigned nloc = b.st[0], nx = b.st[1];
    if (nloc == 0u) { xcd_barrier_complete(bar, b.x, nloc, nx); b.st[0] = nloc; b.st[1] = nx; }
    const unsigned old = xb_add(&bar[XB_XSUB(b.x)], 1u);
    const unsigned gen = old / nloc;
    if (old + 1u == (gen + 1u) * nloc) {
      __builtin_amdgcn_fence(__ATOMIC_RELEASE, "");
      asm volatile("s_waitcnt vmcnt(0)" ::: "memory");
      const unsigned og = xb_add(&bar[XB_TOP], 1u);
      const unsigned tg = og / nx;
      if (og + 1u == (tg + 1u) * nx) xb_add(&bar[XB_TOPGEN], 1u);
      else XB_SPIN(xb_ld(&bar[XB_TOPGEN]) == tg, bar);
      __builtin_amdgcn_fence(__ATOMIC_ACQUIRE, "");
      xb_add(&bar[XB_XGEN(b.x)], 1u);
      asm volatile("s_waitcnt vmcnt(0)" ::: "memory");
    } else {
      XB_SPIN(xb_ld(&bar[XB_XGEN(b.x)]) == gen, bar);
      __builtin_amdgcn_fence(__ATOMIC_ACQUIRE, "");
      asm volatile("s_waitcnt vmcnt(0)" ::: "memory");
    }
  }
  __syncthreads();
}

struct MegaP {
  const float *x, *c, *ada_w, *ada_b, *norm1_g, *w_in, *conv_w, *conv_b, *cln_g, *cln_b, *moba_g, *dsa_g, *w_out, *norm2_g, *rgw, *rgb, *rew, *reb, *w1, *w3, *w2, *final_g;
  float* out; char* ws;
};
constexpr int LDS_BST = 143360;
constexpr int MEGA_LDS = LDS_BST + 16;
constexpr int CW_BAR = 1024;
#ifndef PROBE
#define PROBE 0
#endif
#define NREP(k) ((PROBE == (k)) ? 2 : 1)

__global__ void __launch_bounds__(NTHR) mega(MegaP p) {
  extern __shared__ __attribute__((aligned(16))) char lds[];
  cg::grid_group grid = cg::this_grid();
  char* ws = p.ws;
  unsigned* ctl = (unsigned*)(ws + WS_CTL);
  float* mod = (float*)(ws + WS_MOD);
  float* kmean = (float*)(ws + WS_KMEAN);
  float* gate = (float*)(ws + WS_GATE);
  float* logits = (float*)(ws + WS_LOGIT);
  unsigned* list = (unsigned*)(ws + WS_LIST);
  bf16_t* winT = (bf16_t*)(ws + WS_WINT);
  bf16_t* woutT = (bf16_t*)(ws + WS_WOUTT);
  bf16_t* rt = (bf16_t*)(ws + WS_RT);
  bf16_t* w13T = (bf16_t*)(ws + WS_W13T);
  bf16_t* w2T = (bf16_t*)(ws + WS_W2T);
  bf16_t* hb = (bf16_t*)(ws + WS_HB);
  uint2* bmt = (uint2*)(ws + WS_BMT);
  bf16_t* proj = (bf16_t*)(ws + WS_PROJ);
  bf16_t* act = (bf16_t*)(ws + WS_ACT);
  bf16_t* ys = (bf16_t*)(ws + WS_YS);
  bf16_t* part_o = (bf16_t*)(ws + WS_PARTO);
  float2* part_ml = (float2*)(ws + WS_PARTML);
  unsigned* mlist = (unsigned*)(ws + WS_MLIST);
  float* out = p.out;
  const int nblk = gridDim.x, bid = blockIdx.x;
  volatile LAS unsigned* bst = (volatile LAS unsigned*)(LAS char*)(lds + LDS_BST);
  if (threadIdx.x < 2) bst[threadIdx.x] = 0u;
  __syncthreads();
  const XcdBarrier xb = xcd_barrier_post(ctl + CW_BAR, bst);
#define GSYNC() xcd_barrier(xb)
  grid.sync();

  {
    const int mb = nblk - 1 - bid;
    mod_units(lds, mb, nblk, p.c, p.ada_w, p.ada_b, mod);
    prep_small_units(lds, bid, nblk, p.w_in, p.w_out, p.rgw, p.rew, winT, woutT, rt);
  }
  GSYNC();
  rmsmod_phase(p.x, p.norm1_g, mod + 0, mod + 1024, hb);
  GSYNC();

  for (int l = 0; l < 2; ++l) {
    char* wsl = p.ws; asm volatile("" : "+s"(wsl));
    unsigned* ctl = (unsigned*)(wsl + WS_CTL);
    float* mod = (float*)(wsl + WS_MOD);
    float* kmean = (float*)(wsl + WS_KMEAN);
    float* gate = (float*)(wsl + WS_GATE);
    float* logits = (float*)(wsl + WS_LOGIT);
    unsigned* list = (unsigned*)(wsl + WS_LIST);
    bf16_t* winT = (bf16_t*)(wsl + WS_WINT);
    bf16_t* woutT = (bf16_t*)(wsl + WS_WOUTT);
    bf16_t* rt = (bf16_t*)(wsl + WS_RT);
    bf16_t* w13T = (bf16_t*)(wsl + WS_W13T);
    bf16_t* w2T = (bf16_t*)(wsl + WS_W2T);
    bf16_t* hb = (bf16_t*)(wsl + WS_HB);
    uint2* bmt = (uint2*)(wsl + WS_BMT);
    bf16_t* proj = (bf16_t*)(wsl + WS_PROJ);
    bf16_t* act = (bf16_t*)(wsl + WS_ACT);
    bf16_t* ys = (bf16_t*)(wsl + WS_YS);
    bf16_t* part_o = (bf16_t*)(wsl + WS_PARTO);
    float2* part_ml = (float2*)(wsl + WS_PARTML);
    unsigned* mlist = (unsigned*)(wsl + WS_MLIST);
    const float* modl = mod + (size_t)l * 4 * 6144;
    if (PROBE == 13) { GemmP P{}; P.A = hb; P.Bt = winT; P.lda = 1024; P.K = 1024; P.Obf = proj; P.ldo = PLD; gemm_phase<GM_INPROJ, 8, 1>(lds, P, T / 256, 14); GSYNC(); }
    if (PROBE == 14) { GemmP P{}; P.A = hb; P.Bt = winT; P.lda = 1024; P.K = 1024; P.Obf = proj; P.ldo = PLD; gemm_phase<GM_INPROJ, 8, 2>(lds, P, T / 256, 14); GSYNC(); }
    for (int rep = 0; rep < NREP(1); ++rep) {
      { GemmP P{}; P.A = hb; P.Bt = winT; P.lda = 1024; P.K = 1024; P.Obf = proj; P.ldo = PLD; gemm_phase<GM_INPROJ, 8>(lds, P, T / 256, 14); }
      GSYNC();
    }
    for (int u = bid; u < NB * 32; u += nblk) kmean_unit(lds, u, proj, kmean);
    GSYNC();
    unsigned* mcnt = ctl + CW_MC + l * 768;
    if (PROBE >= 10 && PROBE <= 12) {
      for (int u = bid; u < NB * 512; u += nblk) dsa_select_unit<(PROBE >= 10 && PROBE <= 12) ? PROBE - 9 : 1>(lds, proj, bmt, u & 3, 511 - (u >> 2));
      GSYNC();
    }
    for (int rep = 0; rep < NREP(2); ++rep) {
      unsigned* sq = ctl + CW_Q + 4 + 2 * rep + l;
      unsigned* qw = (unsigned*)(lds + SEL_LDS + 64);
      for (;;) {
        if (otid() == 0) qw[0] = atomicAdd(sq, 1u);
        __syncthreads();
        const int u = (int)qw[0];
        __syncthreads();
        if (u >= NB * 512 + T / 64) break;
        if (u < NB * 512) dsa_select_unit<0>(lds, proj, bmt, u & 3, 511 - (u >> 2));
        else if (rep == 0) gate_unit(lds, u - NB * 512, proj, kmean, mcnt, mlist);
      }
      GSYNC();
    }
    if (PROBE == 3) {
      attn_queue_phase(lds, proj, hb, bmt, part_o, part_ml, mcnt, mlist, ctl + CW_Q + 2 + l, p.w1 + (size_t)l * 32 * 1024 * 512, p.w3 + (size_t)l * 32 * 1024 * 512, p.w2 + (size_t)l * 32 * 512 * 1024, w13T, w2T,
                     p.conv_w + (size_t)l * 31 * 256, p.conv_b + l * 256, p.cln_g + l * 256, p.cln_b + l * 256);
      GSYNC();
    }
    attn_queue_phase(lds, proj, hb, bmt, part_o, part_ml, mcnt, mlist, ctl + CW_Q + l, p.w1 + (size_t)l * 32 * 1024 * 512, p.w3 + (size_t)l * 32 * 1024 * 512, p.w2 + (size_t)l * 32 * 512 * 1024, w13T, w2T,
                     p.conv_w + (size_t)l * 31 * 256, p.conv_b + l * 256, p.cln_g + l * 256, p.cln_b + l * 256);
    GSYNC();
    mixfin_phase(hb, p.moba_g + l * 384, p.dsa_g + l * 384, part_o, part_ml);
    GSYNC();
    { GemmP P{}; P.A = hb; P.Bt = woutT; P.lda = 1024; P.K = 1024; P.xin = (l == 0) ? p.x : out; P.xout = out; P.gvec = modl + 2048; gemm_phase<GM_OUTPROJ, 8>(lds, P, T / 256, 4); }
    GSYNC();
    for (int rep = 0; rep < NREP(4); ++rep) {
      rmsmod_phase(out, p.norm2_g + l * 1024, modl + 3072, modl + 4096, hb);
      GSYNC();
    }
    for (int rep = 0; rep < NREP(5); ++rep) {
      { GemmP P{}; P.A = hb; P.Bt = rt; P.lda = 1024; P.K = 1024; P.logits = logits; gemm_phase<GM_ROUTER, 4>(lds, P, T / 256, 1); }
      GSYNC();
    }
    int* cntl = (int*)(ctl + CW_CNT + l * 32);
    route_phase(lds, logits, p.rgb + l * 4, p.reb + l * 32, list, cntl, gate);
    GSYNC();
    for (int rep = 0; rep < NREP(6); ++rep) {
      { GemmP P{}; P.A = hb; P.Bt = w13T; P.lda = 1024; P.K = 1024; P.Obf = act; P.list = list; P.cnt = cntl; P.gate = gate; gemm_phase<GM_MOE1, 8>(lds, P, 0, 0); }
      GSYNC();
    }
    for (int rep = 0; rep < NREP(7); ++rep) {
      { GemmP P{}; P.A = act; P.Bt = w2T; P.lda = 512; P.K = 512; P.Obf = ys; P.list = list; P.cnt = cntl; P.gate = gate; gemm_phase<GM_MOE2, 8>(lds, P, 0, 0); }
      GSYNC();
    }
    for (int rep = 0; rep < NREP(9) - 1; ++rep) { GSYNC(); GSYNC(); GSYNC(); GSYNC(); GSYNC(); GSYNC(); GSYNC(); GSYNC(); GSYNC(); GSYNC(); }
    if (l == 0) {
      const float* mod1 = mod + (size_t)4 * 6144;
      combine_phase(out, ys, modl + 5120, 0, p.norm1_g + 1024, mod1 + 0, mod1 + 1024, hb);
      prep_small_units(lds, bid, nblk, p.w_in + (size_t)1024 * NIN, p.w_out + (size_t)1024 * 1024, p.rgw + 4096, p.rew + 32768, winT, woutT, rt);
      GSYNC();
    } else {
      combine_phase(out, ys, modl + 5120, 1, p.final_g, nullptr, nullptr, nullptr);
    }
  }
}

extern "C" void kernel_launch(void* const* d_in, const int* in_sizes, int n_in, void* d_out, int out_size, void* d_ws, size_t ws_size, hipStream_t stream) {
  if (ws_size < WS_END) return;
  MegaP p{};
  p.x = (const float*)d_in[0]; p.c = (const float*)d_in[1]; p.ada_w = (const float*)d_in[2]; p.ada_b = (const float*)d_in[3]; p.norm1_g = (const float*)d_in[4];
  p.w_in = (const float*)d_in[5]; p.conv_w = (const float*)d_in[6]; p.conv_b = (const float*)d_in[7]; p.cln_g = (const float*)d_in[8]; p.cln_b = (const float*)d_in[9];
  p.moba_g = (const float*)d_in[10]; p.dsa_g = (const float*)d_in[11]; p.w_out = (const float*)d_in[12]; p.norm2_g = (const float*)d_in[13]; p.rgw = (const float*)d_in[14];
  p.rgb = (const float*)d_in[15]; p.rew = (const float*)d_in[16]; p.reb = (const float*)d_in[17]; p.w1 = (const float*)d_in[18]; p.w3 = (const float*)d_in[19];
  p.w2 = (const float*)d_in[20]; p.final_g = (const float*)d_in[21];
  p.out = (float*)d_out; p.ws = (char*)d_ws;
  static int grid_blocks = 0;
  if (!grid_blocks) {
    int dev = 0, cus = 0, per_cu = 0;
    (void)hipGetDevice(&dev);
    (void)hipDeviceGetAttribute(&cus, hipDeviceAttributeMultiprocessorCount, dev);
    (void)hipFuncSetAttribute((const void*)mega, hipFuncAttributeMaxDynamicSharedMemorySize, MEGA_LDS);
    (void)hipOccupancyMaxActiveBlocksPerMultiprocessor(&per_cu, (const void*)mega, NTHR, MEGA_LDS);
    if (per_cu < 1) per_cu = 1;
    if (per_cu > 1) per_cu = 1;
    grid_blocks = cus * per_cu;
  }
  (void)hipMemsetAsync((char*)d_ws + WS_CTL, 0, 32768, stream);
  void* args[] = {&p};
  (void)hipLaunchCooperativeKernel((const void*)mega, dim3(grid_blocks), dim3(NTHR), args, MEGA_LDS, stream);
}
```

```cpp
#include <hip/hip_runtime.h>
#include <hip/hip_cooperative_groups.h>
namespace cg = cooperative_groups;
#include <stdint.h>

#define DI __device__ __forceinline__
typedef unsigned short bf16_t;
typedef short bf16x8 __attribute__((ext_vector_type(8)));
typedef short s16x4 __attribute__((ext_vector_type(4)));
typedef float f32x4 __attribute__((ext_vector_type(4)));
typedef float f32x16 __attribute__((ext_vector_type(16)));
typedef unsigned u32x4 __attribute__((ext_vector_type(4)));
typedef unsigned u32x2 __attribute__((ext_vector_type(2)));
typedef float f32x2_t __attribute__((ext_vector_type(2)));
typedef __bf16 bf16x2_t __attribute__((ext_vector_type(2)));
#define LAS __attribute__((address_space(3)))

constexpr int NB = 4, S = 8192, T = NB * S, D = 1024;
constexpr int PLD = 3456;
constexpr int C_QM = 0, C_KM = 384, C_VM = 768, C_CA = 1152, C_CG = 1408, C_QD = 1664, C_KD = 2048, C_VD = 2432, C_QI = 2816, C_KI = 3328, C_WI = 3392;
constexpr int NIN = 3400;
constexpr float EPS = 1e-6f;
constexpr int NTHR = 512;

constexpr size_t MiB = 1u << 20;
constexpr size_t WS_CTL = 0;
constexpr size_t WS_MOD = 1 * MiB;
constexpr size_t WS_KMEAN = WS_MOD + 256 * 1024;
constexpr size_t WS_SELM = WS_KMEAN + 256 * 1024;
constexpr size_t WS_GATE = WS_SELM + 1 * MiB;
constexpr size_t WS_LOGIT = WS_GATE + 512 * 1024;
constexpr size_t WS_LIST = WS_LOGIT + 5 * MiB;
constexpr size_t WS_WINT = WS_LIST + 8 * MiB;
constexpr size_t WS_WOUTT = WS_WINT + 7 * MiB;
constexpr size_t WS_RT = WS_WOUTT + 2 * MiB;
constexpr size_t WS_W13T = WS_RT + 1 * MiB;
constexpr size_t WS_W2T = WS_W13T + 64 * MiB;
constexpr size_t WS_HB = WS_W2T + 32 * MiB;
constexpr size_t WS_BMT = WS_HB + 64 * MiB;
constexpr size_t WS_PROJ = WS_BMT + 32 * MiB;
constexpr size_t WS_ACT = WS_PROJ;
constexpr size_t WS_YS = WS_PROJ + 64 * MiB;
constexpr size_t WS_PARTO = WS_PROJ + 216 * MiB;
constexpr size_t WS_PARTML = WS_PARTO + 96 * MiB;
constexpr size_t WS_MLIST = WS_PARTML + 6 * MiB;
constexpr size_t WS_END = WS_MLIST + 24 * MiB;
constexpr int CW_CNT = 0;
constexpr int CW_Q = 64;
constexpr int CW_MC = 5120;

DI int otid() { int t = threadIdx.x; asm volatile("" : "+v"(t)); return t; }
DI void st_wt32(unsigned* p, unsigned v) { __hip_atomic_store(p, v, __ATOMIC_RELAXED, __HIP_MEMORY_SCOPE_AGENT); }
DI void st_wt64(unsigned long long* p, unsigned long long v) { __hip_atomic_store(p, v, __ATOMIC_RELAXED, __HIP_MEMORY_SCOPE_AGENT); }
DI float bf2f(bf16_t b) { return __uint_as_float(((unsigned)b) << 16); }
DI float bflo(unsigned u) { return __uint_as_float(u << 16); }
DI float bfhi(unsigned u) { return __uint_as_float(u & 0xffff0000u); }
DI unsigned cvtpk(float lo, float hi) { f32x2_t v = {lo, hi}; bf16x2_t b = __builtin_convertvector(v, bf16x2_t); return __builtin_bit_cast(unsigned, b); }
DI float fexp2(float x) { return __builtin_amdgcn_exp2f(x); }
DI float frcp(float x) { return __builtin_amdgcn_rcpf(x); }
DI float silu_f(float x) { return x * frcp(1.f + fexp2(x * -1.4426950408889634f)); }
DI float wave_sum(float v) {
#pragma unroll
  for (int o = 32; o >= 1; o >>= 1) v += __shfl_xor(v, o);
  return v;
}
#define DPP_STEP(OPF, v, ident, ctrl, rmask) v = OPF(v, (unsigned)__builtin_amdgcn_update_dpp((int)(ident), (int)(v), ctrl, rmask, 0xf, false))
DI unsigned opadd(unsigned a, unsigned b) { return a + b; }
DI unsigned opmin(unsigned a, unsigned b) { return min(a, b); }
DI unsigned opmax(unsigned a, unsigned b) { return max(a, b); }
DI unsigned scan_add(unsigned v) {
  DPP_STEP(opadd, v, 0u, 0x111, 0xf); DPP_STEP(opadd, v, 0u, 0x112, 0xf); DPP_STEP(opadd, v, 0u, 0x114, 0xf); DPP_STEP(opadd, v, 0u, 0x118, 0xf);
  DPP_STEP(opadd, v, 0u, 0x142, 0xa); DPP_STEP(opadd, v, 0u, 0x143, 0xc); return v;
}
DI unsigned red_add(unsigned v) { return (unsigned)__builtin_amdgcn_readlane((int)scan_add(v), 63); }
DI unsigned red_min(unsigned v) {
  DPP_STEP(opmin, v, 0xffffffffu, 0x111, 0xf); DPP_STEP(opmin, v, 0xffffffffu, 0x112, 0xf); DPP_STEP(opmin, v, 0xffffffffu, 0x114, 0xf); DPP_STEP(opmin, v, 0xffffffffu, 0x118, 0xf);
  DPP_STEP(opmin, v, 0xffffffffu, 0x142, 0xa); DPP_STEP(opmin, v, 0xffffffffu, 0x143, 0xc); return (unsigned)__builtin_amdgcn_readlane((int)v, 63);
}
DI unsigned red_max(unsigned v) {
  DPP_STEP(opmax, v, 0u, 0x111, 0xf); DPP_STEP(opmax, v, 0u, 0x112, 0xf); DPP_STEP(opmax, v, 0u, 0x114, 0xf); DPP_STEP(opmax, v, 0u, 0x118, 0xf);
  DPP_STEP(opmax, v, 0u, 0x142, 0xa); DPP_STEP(opmax, v, 0u, 0x143, 0xc); return (unsigned)__builtin_amdgcn_readlane((int)v, 63);
}
#define MFMA16(a, b, c) __builtin_amdgcn_mfma_f32_16x16x32_bf16((a), (b), (c), 0, 0, 0)
#define MFMA32(a, b, c) __builtin_amdgcn_mfma_f32_32x32x16_bf16((a), (b), (c), 0, 0, 0)

DI void mod_units(char* lds, int ubase, int nblk, const float* __restrict__ c, const float* __restrict__ ada_w, const float* __restrict__ ada_b, float* __restrict__ mod) {
  float (*sc)[1024] = (float (*)[1024])lds;
  float (*red)[4][64] = (float (*)[4][64])(lds + 16384);
  const int tid = otid();
  bool loaded = false;
  for (int u = ubase; u < 2 * 96; u += nblk) {
    if (!loaded) { for (int i = tid; i < 4096; i += NTHR) sc[i >> 10][i & 1023] = silu_f(c[i]); __syncthreads(); loaded = true; }
    const int l = u / 96, n = (u % 96) * 64 + (tid & 63), ks = tid >> 6;
    const float* w = ada_w + (size_t)l * 1024 * 6144 + n;
    float a0 = 0.f, a1 = 0.f, a2 = 0.f, a3 = 0.f;
#pragma unroll 8
    for (int k = ks * 128; k < ks * 128 + 128; ++k) {
      const float wv = w[(size_t)k * 6144];
      a0 += sc[0][k] * wv; a1 += sc[1][k] * wv; a2 += sc[2][k] * wv; a3 += sc[3][k] * wv;
    }
    red[ks][0][tid & 63] = a0; red[ks][1][tid & 63] = a1; red[ks][2][tid & 63] = a2; red[ks][3][tid & 63] = a3;
    __syncthreads();
    if (tid < 256) {
      const int b = tid >> 6, nn = tid & 63;
      float s = 0.f;
#pragma unroll
      for (int k = 0; k < 8; ++k) s += red[k][b][nn];
      const int ncol = (u % 96) * 64 + nn;
      mod[((size_t)l * 4 + b) * 6144 + ncol] = s + ada_b[(size_t)l * 6144 + ncol];
    }
    __syncthreads();
  }
}

struct TJob { const float* src; bf16_t* dst; int R, C, Cpad, grp, stride, off; };

DI void transpose_tile_wave(const TJob& J, int tr, int tc, float (*tile)[65], int lane) {
#pragma unroll 1
  for (int hf = 0; hf < 2; ++hf) {
    float4 v[8];
#pragma unroll
    for (int p = 0; p < 8; ++p) {
      const int r = (lane >> 4) + (hf * 8 + p) * 4, c4 = (lane & 15) * 4;
      const int gr = tr * 64 + r, gc = tc * 64 + c4;
      v[p] = make_float4(0.f, 0.f, 0.f, 0.f);
      if (gc + 3 < J.C) v[p] = *(const float4*)(J.src + (size_t)gr * J.C + gc);
      else { float t4[4] = {0.f, 0.f, 0.f, 0.f}; for (int q = 0; q < 4; ++q) if (gc + q < J.C) t4[q] = J.src[(size_t)gr * J.C + gc + q]; v[p] = make_float4(t4[0], t4[1], t4[2], t4[3]); }
    }
#pragma unroll
    for (int p = 0; p < 8; ++p) {
      const int r = (lane >> 4) + (hf * 8 + p) * 4, c4 = (lane & 15) * 4;
      tile[r][c4 + 0] = v[p].x; tile[r][c4 + 1] = v[p].y; tile[r][c4 + 2] = v[p].z; tile[r][c4 + 3] = v[p].w;
    }
  }
  __builtin_amdgcn_fence(__ATOMIC_RELEASE, "wavefront");
  __builtin_amdgcn_wave_barrier();
#pragma unroll
  for (int p = 0; p < 8; ++p) {
    const int n = (lane >> 3) + p * 8, kc = lane & 7;
    const int gc = tc * 64 + n;
    if (gc < J.Cpad) {
      const int drow = (gc / J.grp) * J.stride + J.off + (gc % J.grp);
      u32x4 o;
      o.x = cvtpk(tile[kc * 8 + 0][n], tile[kc * 8 + 1][n]); o.y = cvtpk(tile[kc * 8 + 2][n], tile[kc * 8 + 3][n]);
      o.z = cvtpk(tile[kc * 8 + 4][n], tile[kc * 8 + 5][n]); o.w = cvtpk(tile[kc * 8 + 6][n], tile[kc * 8 + 7][n]);
      *(u32x4*)(J.dst + (size_t)drow * J.R + tr * 64 + kc * 8) = o;
    }
  }
  __builtin_amdgcn_fence(__ATOMIC_RELEASE, "wavefront");
  __builtin_amdgcn_wave_barrier();
}

constexpr int WINT_ROWS = 3584;
constexpr int PREP_UNITS = 896 + 256 + 32 * 384;
DI void prep_unit(int u, const float* w_in, const float* w_out, const float* w1, const float* w3, const float* w2,
                  bf16_t* winT, bf16_t* woutT, bf16_t* w13T, bf16_t* w2T, float (*tile)[65], int lane) {
  TJob J; int tr, tc;
  if (u < 896) { J = TJob{w_in, winT, 1024, NIN, WINT_ROWS, 1 << 30, 0, 0}; tr = u % 16; tc = u / 16; }
  else if (u < 1152) { u -= 896; J = TJob{w_out, woutT, 1024, 1024, 1024, 1 << 30, 0, 0}; tr = u % 16; tc = u / 16; }
  else {
    u -= 1152; const int e = u / 384; int r = u % 384;
    if (r < 128) { J = TJob{w1 + (size_t)e * 1024 * 512, w13T + (size_t)e * 1024 * 1024, 1024, 512, 512, 32, 64, 0}; tr = r % 16; tc = r / 16; }
    else if (r < 256) { r -= 128; J = TJob{w3 + (size_t)e * 1024 * 512, w13T + (size_t)e * 1024 * 1024, 1024, 512, 512, 32, 64, 32}; tr = r % 16; tc = r / 16; }
    else { r -= 256; J = TJob{w2 + (size_t)e * 512 * 1024, w2T + (size_t)e * 1024 * 512, 512, 1024, 1024, 1 << 30, 0, 0}; tr = r % 8; tc = r / 8; }
  }
  transpose_tile_wave(J, tr, tc, tile, lane);
}

DI void prep_rt_unit(int u, const float* __restrict__ rgw, const float* __restrict__ rew, bf16_t* __restrict__ rt) {
#pragma unroll
  for (int q = 0; q < 4; ++q) {
    const int i = u * 2048 + q * NTHR + threadIdx.x;
    const int n = i >> 10, k = i & 1023;
    float v = 0.f;
    if (n < 4) v = rgw[k * 4 + n]; else if (n < 36) v = rew[k * 32 + (n - 4)];
    rt[i] = (bf16_t)(cvtpk(v, 0.f) & 0xffffu);
  }
}
constexpr int PREP_SMALL = 896 + 256;
constexpr int PREP_EXP_ITEMS = (32 * 384) / 8;
DI void prep_small_units(char* lds, int ubase, int nblk, const float* w_in, const float* w_out, const float* rgw, const float* rew, bf16_t* winT, bf16_t* woutT, bf16_t* rt) {
  const int tid = otid(), lane = tid & 63, wid = tid >> 6;
  float (*tile)[65] = (float (*)[65])(lds + wid * 16640);
  for (int u = ubase * 8 + wid; u < PREP_SMALL; u += nblk * 8) prep_unit(u, w_in, w_out, nullptr, nullptr, nullptr, winT, woutT, nullptr, nullptr, tile, lane);
  for (int u = ubase; u < 64; u += nblk) prep_rt_unit(u, rgw, rew, rt);
  __syncthreads();
}
DI void prep_exp_item(char* lds, int item, const float* w1, const float* w3, const float* w2, bf16_t* w13T, bf16_t* w2T) {
  const int tid = otid(), lane = tid & 63, wid = tid >> 6;
  float (*tile)[65] = (float (*)[65])(lds + wid * 16640);
  prep_unit(PREP_SMALL + item * 8 + wid, nullptr, nullptr, w1, w3, w2, nullptr, nullptr, w13T, w2T, tile, lane);
  __syncthreads();
}

DI void wave_sum4(float (&v)[4]) {
#pragma unroll
  for (int o = 32; o >= 1; o >>= 1) {
    float t[4];
#pragma unroll
    for (int r = 0; r < 4; ++r) t[r] = __shfl_xor(v[r], o);
#pragma unroll
    for (int r = 0; r < 4; ++r) v[r] += t[r];
  }
}
DI void rmsmod_phase(const float* __restrict__ x, const float* __restrict__ g, const float* __restrict__ mod_sh, const float* __restrict__ mod_sc, bf16_t* __restrict__ h) {
  const int tid_ = otid(); const int lane = tid_ & 63, wid = tid_ >> 6;
  for (int row0 = (blockIdx.x * 8 + wid) * 4; row0 < T; row0 += gridDim.x * 32) {
    const int b = row0 >> 13;
    float4 v[4][4]; float ss[4];
#pragma unroll
    for (int r = 0; r < 4; ++r) {
      const float* xr = x + (size_t)(row0 + r) * D;
      ss[r] = 0.f;
#pragma unroll
      for (int i = 0; i < 4; ++i) { v[r][i] = *(const float4*)(xr + i * 256 + lane * 4); }
    }
#pragma unroll
    for (int r = 0; r < 4; ++r)
#pragma unroll
      for (int i = 0; i < 4; ++i) ss[r] += v[r][i].x * v[r][i].x + v[r][i].y * v[r][i].y + v[r][i].z * v[r][i].z + v[r][i].w * v[r][i].w;
    wave_sum4(ss);
#pragma unroll
    for (int i = 0; i < 4; ++i) {
      const int col = i * 256 + lane * 4;
      const float4 gg = *(const float4*)(g + col), sc = *(const float4*)(mod_sc + (size_t)b * 6144 + col), sh = *(const float4*)(mod_sh + (size_t)b * 6144 + col);
#pragma unroll
      for (int r = 0; r < 4; ++r) {
        const float rstd = rsqrtf(ss[r] * (1.f / 1024.f) + EPS);
        const float o0 = v[r][i].x * rstd * gg.x * (1.f + sc.x) + sh.x, o1 = v[r][i].y * rstd * gg.y * (1.f + sc.y) + sh.y;
        const float o2 = v[r][i].z * rstd * gg.z * (1.f + sc.z) + sh.z, o3 = v[r][i].w * rstd * gg.w * (1.f + sc.w) + sh.w;
        u32x2 o; o.x = cvtpk(o0, o1); o.y = cvtpk(o2, o3);
        *(u32x2*)(h + (size_t)(row0 + r) * D + col) = o;
      }
    }
  }
}

enum { GM_INPROJ = 0, GM_OUTPROJ = 1, GM_ROUTER = 2, GM_MOE1 = 3, GM_MOE2 = 4 };
struct GemmP {
  const bf16_t* A; const bf16_t* Bt; int lda; int K;
  bf16_t* Obf; int ldo;
  const float* xin; float* xout; const float* gvec;
  float* logits;
  const unsigned* list; const int* cnt; const float* gate;
};
constexpr int GEMM_LDS = 98304 + 1024;

template <int MODE, int NJ, int VAR = 0>
DI void gemm_tile(char* lds, const GemmP& P, const bf16_t* __restrict__ Bt, int m0, int n0, int nvalid, const unsigned* lst, int ebase) {
  constexpr int BN = 32 * NJ, STG = 32768 + BN * 128, NBP = BN / 64;
  const int tid = otid(), lane = tid & 63, wid = __builtin_amdgcn_readfirstlane(tid >> 6), fr = lane & 15, fq = lane >> 4;
  const int wm = wid >> 1, wn = wid & 1;
  const int K = P.K;
  int* ridx = (int*)(lds + 2 * STG);
  if (MODE == GM_MOE1) {
    if (tid < 256) { const int r = tid < nvalid ? tid : 0; ridx[tid] = (int)(lst[r] >> 1); }
    __syncthreads();
  }
  const int prow = lane >> 3, pkc = (lane & 7) ^ (lane >> 3);
  const bf16_t* ap[4];
#pragma unroll
  for (int i = 0; i < 4; ++i) {
    const int row = 8 * (wid + 8 * i) + prow;
    size_t grow;
    if (MODE == GM_MOE1) grow = (size_t)ridx[row];
    else if (MODE == GM_MOE2) grow = (size_t)(ebase + (row < nvalid ? row : 0));
    else grow = (size_t)(m0 + row);
    ap[i] = P.A + grow * P.lda + pkc * 8;
  }
  const bf16_t* bp[NBP];
#pragma unroll
  for (int i = 0; i < NBP; ++i) {
    const int row = 8 * (wid + 8 * i) + prow;
    bp[i] = Bt + (size_t)(n0 + row) * K + pkc * 8;
  }
  f32x4 acc[4][NJ];
#pragma unroll
  for (int i = 0; i < 4; ++i)
#pragma unroll
    for (int j = 0; j < NJ; ++j) acc[i][j] = (f32x4){0.f, 0.f, 0.f, 0.f};
  LAS char* lds3 = (LAS char*)lds;
#define GEMM_STAGE(st, kt_) do { \
    _Pragma("unroll") for (int i = 0; i < 4; ++i) __builtin_amdgcn_global_load_lds((const unsigned*)(ap[i] + (kt_) * 64), (LAS unsigned*)(lds3 + (st) * STG + (wid + 8 * i) * 1024), 16, 0, 0); \
    _Pragma("unroll") for (int i = 0; i < NBP; ++i) __builtin_amdgcn_global_load_lds((const unsigned*)(bp[i] + (kt_) * 64), (LAS unsigned*)(lds3 + (st) * STG + 32768 + (wid + 8 * i) * 1024), 16, 0, 0); \
  } while (0)
#define GEMM_PIECE(st, kt_, q) do { \
    if ((q) < 4) __builtin_amdgcn_global_load_lds((const unsigned*)(ap[(q)] + (kt_) * 64), (LAS unsigned*)(lds3 + (st) * STG + (wid + 8 * (q)) * 1024), 16, 0, 0); \
    else if ((q) - 4 < NBP) __builtin_amdgcn_global_load_lds((const unsigned*)(bp[((q) - 4) < NBP ? (q) - 4 : 0] + (kt_) * 64), (LAS unsigned*)(lds3 + (st) * STG + 32768 + (wid + 8 * ((q) - 4)) * 1024), 16, 0, 0); \
  } while (0)
#define GEMM_LDA(i, base, ko) a[i] = *(const bf16x8*)((base) + (arow + (i) * 16) * 128 + (ko))
#define GEMM_LDB(j, base, ko) b[j] = *(const bf16x8*)((base) + 32768 + (brow + (j) * 16) * 128 + (ko))
#define GEMM_SB __builtin_amdgcn_sched_barrier(0)
#define GEMM_BLOCK(RL, DM, base, ko, st, kt_) do { \
    _Pragma("unroll") for (int j = 0; j < NJ; ++j) acc[0][j] = MFMA16(b[j], a[0], acc[0][j]); \
    if (RL) GEMM_LDA(0, base, ko); \
    if (DM) { GEMM_PIECE(st, kt_, 0); GEMM_PIECE(st, kt_, 1); } \
    GEMM_SB; \
    _Pragma("unroll") for (int j = 0; j < NJ; ++j) acc[1][j] = MFMA16(b[j], a[1], acc[1][j]); \
    if (RL) GEMM_LDA(1, base, ko); \
    if (DM) { GEMM_PIECE(st, kt_, 2); GEMM_PIECE(st, kt_, 3); } \
    GEMM_SB; \
    _Pragma("unroll") for (int j = 0; j < NJ; ++j) { \
      acc[2][j] = MFMA16(b[j], a[2], acc[2][j]); \
      acc[3][j] = MFMA16(b[j], a[3], acc[3][j]); \
      if (RL) GEMM_LDB(j, base, ko); \
      if (DM && (j & 1) == 0) GEMM_PIECE(st, kt_, 4 + (j >> 1)); \
      GEMM_SB; \
    } \
    if (RL) { GEMM_LDA(2, base, ko); GEMM_LDA(3, base, ko); } \
    GEMM_SB; \
  } while (0)
  const int nk = K >> 6;
  const int arow = wm * 64 + fr, brow = wn * (BN / 2) + fr, sw = fr & 7;
  const int ko0 = (fq ^ sw) << 4, ko1 = ((4 + fq) ^ sw) << 4;
  bf16x8 a[4], b[NJ];
  GEMM_STAGE(0, 0);
  asm volatile("s_waitcnt vmcnt(0)" ::: "memory");
  __syncthreads();
  if (VAR != 1) GEMM_STAGE(1, 1);
#pragma unroll
  for (int i = 0; i < 4; ++i) GEMM_LDA(i, lds, ko0);
#pragma unroll
  for (int j = 0; j < NJ; ++j) GEMM_LDB(j, lds, ko0);
  for (int kt = 0; kt < nk; ++kt) {
    const int cur = kt & 1;
    const char* sb = lds + cur * STG;
    const char* sn = lds + (cur ^ 1) * STG;
    GEMM_BLOCK(true, false, sb, ko1, 0, 0);
    asm volatile("s_waitcnt vmcnt(0) lgkmcnt(0)" ::: "memory");
    __syncthreads();
    const int kn = min(kt + 2, nk - 1);
    GEMM_BLOCK(true, VAR != 1, sn, ko0, cur, kn);
  }
  asm volatile("s_waitcnt vmcnt(0)" ::: "memory");
#undef GEMM_BLOCK
#undef GEMM_SB
#undef GEMM_LDA
#undef GEMM_LDB
#undef GEMM_PIECE
#undef GEMM_STAGE
  const int nw0 = n0 + wn * (BN / 2);
#pragma unroll
  for (int i = 0; i < 4; ++i) {
    const int ml = wm * 64 + i * 16 + fr;
    const int m = m0 + ml;
    if (MODE == GM_INPROJ) {
#pragma unroll
      for (int j = 0; j < NJ; ++j) {
        const int n = nw0 + j * 16 + fq * 4;
        if (n < P.ldo) {
          u32x2 o; o.x = cvtpk(acc[i][j][0], acc[i][j][1]); o.y = cvtpk(acc[i][j][2], acc[i][j][3]);
          *(u32x2*)(P.Obf + (size_t)m * P.ldo + n) = o;
        }
      }
    } else if (MODE == GM_OUTPROJ) {
      const int b = m >> 13;
#pragma unroll
      for (int j = 0; j < NJ; ++j) {
        const int n = nw0 + j * 16 + fq * 4;
        const float4 xi = *(const float4*)(P.xin + (size_t)m * D + n);
        const float4 gv = *(const float4*)(P.gvec + (size_t)b * 6144 + n);
        float4 o; o.x = xi.x + gv.x * acc[i][j][0]; o.y = xi.y + gv.y * acc[i][j][1]; o.z = xi.z + gv.z * acc[i][j][2]; o.w = xi.w + gv.w * acc[i][j][3];
        *(float4*)(P.xout + (size_t)m * D + n) = o;
      }
    } else if (MODE == GM_ROUTER) {
#pragma unroll
      for (int j = 0; j < NJ; ++j) {
        const int n = nw0 + j * 16 + fq * 4;
        if (n < 36) { float4 o; o.x = acc[i][j][0]; o.y = acc[i][j][1]; o.z = acc[i][j][2]; o.w = acc[i][j][3]; *(float4*)(P.logits + (size_t)m * 36 + n) = o; }
      }
    } else if (MODE == GM_MOE1) {
      if (ml < nvalid) {
#pragma unroll
        for (int jb2 = 0; jb2 < NJ / 4; ++jb2) {
          const int jb = (nw0 >> 6) + jb2;
#pragma unroll
          for (int j = 0; j < 2; ++j) {
            const int col = jb * 32 + j * 16 + fq * 4;
            float v[4];
#pragma unroll
            for (int q = 0; q < 4; ++q) v[q] = silu_f(acc[i][4 * jb2 + j][q]) * acc[i][4 * jb2 + j + 2][q];
            u32x2 o; o.x = cvtpk(v[0], v[1]); o.y = cvtpk(v[2], v[3]);
            *(u32x2*)(P.Obf + (size_t)(ebase + ml) * 512 + col) = o;
          }
        }
      }
    } else if (MODE == GM_MOE2) {
      if (ml < nvalid) {
        const unsigned slot = lst[ml];
        const float gt = P.gate[slot];
#pragma unroll
        for (int j = 0; j < NJ; ++j) {
          const int n = nw0 + j * 16 + fq * 4;
          u32x2 o; o.x = cvtpk(acc[i][j][0] * gt, acc[i][j][1] * gt); o.y = cvtpk(acc[i][j][2] * gt, acc[i][j][3] * gt);
          *(u32x2*)(P.Obf + (size_t)slot * 1024 + n) = o;
        }
      }
    }
  }
  __syncthreads();
}

template <int MODE, int NJ, int VAR = 0>
DI void gemm_phase(char* lds, const GemmP& P, int ntm, int ntn) {
  constexpr int BN = 32 * NJ;
  const int xcd = blockIdx.x & 7, bi = blockIdx.x >> 3, nbx = gridDim.x >> 3;
  const bool xo = (gridDim.x & 7) == 0;
  if (MODE == GM_MOE1 || MODE == GM_MOE2) {
    constexpr int NNT = 1024 / BN;
    if (xo) {
      int ce[4], tm[4], eb[4];
      {
        int acc_ = 0, q = 0;
#pragma unroll
        for (int k = 0; k < 4; ++k) {
          const int e = xcd + 8 * k;
          for (; q < e; ++q) acc_ += P.cnt[q];
          eb[k] = acc_; ce[k] = P.cnt[e]; tm[k] = (ce[k] + 255) >> 8;
        }
      }
      const int total = (tm[0] + tm[1] + tm[2] + tm[3]) * NNT;
      const int nfull = (total / nbx) * nbx;
      const int nhalf = (NJ == 8) ? 2 * (total - nfull) : 0;
      for (int it = bi; it < nfull + ((NJ == 8) ? nhalf : total - nfull); it += nbx) {
        const bool half = (NJ == 8) && it >= nfull;
        const int j = half ? nfull + ((it - nfull) >> 1) : it;
        int k = 0, r = j;
        if (r >= tm[0] * NNT) { r -= tm[0] * NNT; k = 1; if (r >= tm[1] * NNT) { r -= tm[1] * NNT; k = 2; if (r >= tm[2] * NNT) { r -= tm[2] * NNT; k = 3; } } }
        const int cek = k == 0 ? ce[0] : k == 1 ? ce[1] : k == 2 ? ce[2] : ce[3];
        const int ebk = k == 0 ? eb[0] : k == 1 ? eb[1] : k == 2 ? eb[2] : eb[3];
        const int e = xcd + 8 * k, mt = r / NNT, nt = r % NNT;
        const int nvalid = min(256, cek - mt * 256);
        const unsigned* lst = P.list + (size_t)e * 65536 + mt * 256;
        const bf16_t* Bt = P.Bt + (size_t)e * 1024 * P.K;
        if (half) gemm_tile<MODE, (NJ == 8) ? 4 : NJ, VAR>(lds, P, Bt, mt * 256, nt * BN + ((it - nfull) & 1) * (BN / 2), nvalid, lst, ebk + mt * 256);
        else gemm_tile<MODE, NJ, VAR>(lds, P, Bt, mt * 256, nt * BN, nvalid, lst, ebk + mt * 256);
      }
    } else {
      int total_mt = 0;
      for (int e = 0; e < 32; ++e) total_mt += (P.cnt[e] + 255) >> 8;
      const int total = total_mt * NNT;
      for (int u = blockIdx.x; u < total; u += gridDim.x) {
        int e = 0, rem = u, ebase = 0;
        for (;;) { const int c = P.cnt[e]; const int te = ((c + 255) >> 8) * NNT; if (rem < te) break; rem -= te; ebase += c; ++e; }
        const int ce = P.cnt[e], tme = (ce + 255) >> 8;
        const int nt = rem / tme, mt = rem % tme;
        const int nvalid = min(256, ce - mt * 256);
        const unsigned* lst = P.list + (size_t)e * 65536 + mt * 256;
        const bf16_t* Bt = P.Bt + (size_t)e * 1024 * P.K;
        gemm_tile<MODE, NJ, VAR>(lds, P, Bt, mt * 256, nt * BN, nvalid, lst, ebase + mt * 256);
      }
    }
  } else if (xo && (ntm & 7) == 0) {
    const int per = (ntm >> 3) * ntn;
    for (int j = bi; j < per; j += nbx) {
      const int mt = xcd + 8 * (j / ntn), nt = j % ntn;
      gemm_tile<MODE, NJ, VAR>(lds, P, P.Bt, mt * 256, nt * BN, 256, nullptr, 0);
    }
  } else {
    const int total = ntm * ntn;
    for (int u = blockIdx.x; u < total; u += gridDim.x) {
      const int nt = u / ntm, mt = u % ntm;
      gemm_tile<MODE, NJ, VAR>(lds, P, P.Bt, mt * 256, nt * BN, 256, nullptr, 0);
    }
  }
}

DI void kmean_unit(char* lds, int u, const bf16_t* __restrict__ proj, float* __restrict__ kmean) {
  float* red = (float*)lds;
  const int tid = otid();
  const int b = u >> 5, blk = u & 31;
  const int cc = tid % 48, rg = tid / 48;
  if (rg < 10) {
    const bf16_t* p = proj + (size_t)(b * S + blk * 256) * PLD + C_KM + cc * 8;
    float acc[8] = {0.f, 0.f, 0.f, 0.f, 0.f, 0.f, 0.f, 0.f};
#pragma unroll 13
    for (int r = rg; r < 256; r += 10) {
      const u32x4 v = *(const u32x4*)(p + (size_t)r * PLD);
      acc[0] += bflo(v.x); acc[1] += bfhi(v.x); acc[2] += bflo(v.y); acc[3] += bfhi(v.y);
      acc[4] += bflo(v.z); acc[5] += bfhi(v.z); acc[6] += bflo(v.w); acc[7] += bfhi(v.w);
    }
#pragma unroll
    for (int q = 0; q < 8; ++q) red[rg * 384 + cc * 8 + q] = acc[q];
  }
  __syncthreads();
  if (tid < 384) {
    float sm = 0.f;
#pragma unroll
    for (int g = 0; g < 10; ++g) sm += red[g * 384 + tid];
    kmean[((size_t)(b * 6 + tid / 64) * 32 + blk) * 64 + (tid & 63)] = sm * (1.f / 256.f);
  }
  __syncthreads();
}

constexpr int ATT_LDS = 32768;
constexpr float C2 = 0.125f * 1.4426950408889634f;
DI float max3f(float a, float b, float c) { return __builtin_fmaxf(__builtin_fmaxf(a, b), c); }
DI int crow(int r, int hi) { return (r & 3) + 8 * (r >> 2) + 4 * hi; }
typedef short v4i16_t __attribute__((ext_vector_type(4)));
DI s16x4 vtr(const LAS char* p) { return __builtin_bit_cast(s16x4, __builtin_amdgcn_ds_read_tr16_b64_v4i16((LAS v4i16_t*)p)); }

constexpr int ATT_ST = 65536;
struct AttState { float m, l; f32x16 o0, o1; };

template <int MODE>
DI void attn_stage(char* lds, int bufoff, const bf16_t* __restrict__ proj, int b, int h, int key0, int lane, int wid) {
  constexpr int KC = (MODE == 1) ? C_KD : C_KM, VC = (MODE == 1) ? C_VD : C_VM;
  LAS char* l3 = (LAS char*)lds + bufoff;
  const bf16_t* ks = proj + (size_t)(b * S + key0 + 8 * wid + (lane >> 3)) * PLD + KC + h * 64 + (((lane & 7) ^ (lane >> 3)) << 3);
  const bf16_t* vs = proj + (size_t)(b * S + key0 + 16 * (wid & 3) + (lane >> 2)) * PLD + VC + h * 64 + (wid >> 2) * 32 + ((lane & 3) << 3);
#pragma unroll
  for (int tt = 0; tt < 4; ++tt) {
    __builtin_amdgcn_global_load_lds((const unsigned*)(ks + (size_t)tt * 64 * PLD), (LAS unsigned*)(l3 + tt * 16384 + wid * 1024), 16, 0, 0);
    __builtin_amdgcn_global_load_lds((const unsigned*)(vs + (size_t)tt * 64 * PLD), (LAS unsigned*)(l3 + tt * 16384 + 8192 + (wid >> 2) * 4096 + (wid & 3) * 1024), 16, 0, 0);
  }
}

template <int MODE>
DI void attn_tile(char* lds, int tbuf, const bf16x8 (&qr)[4], AttState& st, uint2 w, int ktl, int qrel, int r32, int hi, int lane) {
  constexpr float THR = 8.f;
  const float NEGBIG = -3.0e38f;
  const char* kb = lds + tbuf;
  const int ksw = r32 & 7;
  f32x16 p0, p1;
  {
    f32x16 zz;
#pragma unroll
    for (int r = 0; r < 16; ++r) zz[r] = 0.f;
    const unsigned nmb = cvtpk(-st.m, 0.f);
    const bf16x8 kone = __builtin_bit_cast(bf16x8, (u32x4){hi ? 0u : 0x3F80u, 0u, 0u, 0u});
    const bf16x8 qm = __builtin_bit_cast(bf16x8, (u32x4){nmb, 0u, 0u, 0u});
    p0 = MFMA32(kone, qm, zz);
    p1 = MFMA32(kone, qm, zz);
  }
#pragma unroll
  for (int d0 = 0; d0 < 4; ++d0) {
    const int co = ((2 * d0 + hi) ^ ksw) << 4;
    const bf16x8 ka = *(const bf16x8*)(kb + r32 * 128 + co);
    const bf16x8 kc = *(const bf16x8*)(kb + (r32 + 32) * 128 + co);
    p0 = MFMA32(ka, qr[d0], p0);
    p1 = MFMA32(kc, qr[d0], p1);
  }
  if (MODE == 0) {
    const int kbase = ktl * 64 + 4 * hi;
#pragma unroll
    for (int r = 0; r < 16; ++r) {
      const int kv = kbase + (r & 3) + 8 * (r >> 2);
      if (kv > qrel) p0[r] = NEGBIG;
      if (kv + 32 > qrel) p1[r] = NEGBIG;
    }
  }
  float mxa = max3f(p0[0], p0[1], p1[0]), mxb = max3f(p0[2], p0[3], p1[1]);
  mxa = max3f(mxa, p1[2], p1[3]);
#pragma unroll
  for (int r = 4; r < 16; r += 4) { mxa = max3f(mxa, p0[r], p0[r + 1]); mxb = max3f(mxb, p0[r + 2], p0[r + 3]); mxa = max3f(mxa, p1[r], p1[r + 1]); mxb = max3f(mxb, p1[r + 2], p1[r + 3]); }
  float mx = fmaxf(mxa, mxb);
  mx = fmaxf(mx, __shfl_xor(mx, 32));
  if (__any(mx > THR)) {
    asm volatile("; rescale (rare)" ::: "memory");
    const float d0_ = (mx > THR) ? mx : 0.f;
    const float mnew = __uint_as_float(cvtpk(st.m + d0_, 0.f) << 16);
    const float d = mnew - st.m;
    st.m = mnew;
    const float alpha = fexp2(-d);
#pragma unroll
    for (int r = 0; r < 16; ++r) { st.o0[r] *= alpha; st.o1[r] *= alpha; p0[r] -= d; p1[r] -= d; }
    st.l *= alpha;
  }
#pragma unroll
  for (int r = 0; r < 16; ++r) { p0[r] = fexp2(p0[r]); p1[r] = fexp2(p1[r]); }
  bf16x8 pa[4];
  if (MODE == 1) {
    typedef unsigned short u16x2_t __attribute__((ext_vector_type(2)));
    typedef __bf16 bf2_t __attribute__((ext_vector_type(2)));
    const unsigned w0 = w.x >> (2 * hi), w1 = w.y >> (2 * hi);
    const bf2_t ones = __builtin_bit_cast(bf2_t, 0x3F803F80u);
    float la = 0.f, lb = 0.f;
#pragma unroll
    for (int ks = 0; ks < 2; ++ks) {
      unsigned av[4], cv[4];
#pragma unroll
      for (int m = 0; m < 4; ++m) {
        const int x = 8 * ks + 4 * (m >> 1) + (m & 1);
        const unsigned ta = (w0 >> x) & 0x00010001u, tc = (w1 >> x) & 0x00010001u;
        const unsigned ua = cvtpk(p0[8 * ks + 2 * m], p0[8 * ks + 2 * m + 1]), uc = cvtpk(p1[8 * ks + 2 * m], p1[8 * ks + 2 * m + 1]);
        av[m] = __builtin_bit_cast(unsigned, __builtin_bit_cast(u16x2_t, ua) * __builtin_bit_cast(u16x2_t, ta));
        cv[m] = __builtin_bit_cast(unsigned, __builtin_bit_cast(u16x2_t, uc) * __builtin_bit_cast(u16x2_t, tc));
        la = __builtin_amdgcn_fdot2_f32_bf16(__builtin_bit_cast(bf2_t, av[m]), ones, la, false);
        lb = __builtin_amdgcn_fdot2_f32_bf16(__builtin_bit_cast(bf2_t, cv[m]), ones, lb, false);
      }
      pa[ks] = __builtin_bit_cast(bf16x8, (u32x4){av[0], av[1], av[2], av[3]});
      pa[ks + 2] = __builtin_bit_cast(bf16x8, (u32x4){cv[0], cv[1], cv[2], cv[3]});
    }
    st.l += la + lb;
  } else {
    {
      typedef float f32x2 __attribute__((ext_vector_type(2)));
      f32x2 t[8];
#pragma unroll
      for (int k = 0; k < 8; ++k) t[k] = (f32x2){p0[2 * k], p0[2 * k + 1]} + (f32x2){p1[2 * k], p1[2 * k + 1]};
#pragma unroll
      for (int k = 0; k < 4; ++k) t[k] += t[k + 4];
      t[0] += t[2]; t[1] += t[3];
      t[0] += t[1];
      st.l += t[0].x + t[0].y;
    }
#pragma unroll
    for (int ks = 0; ks < 2; ++ks) {
      u32x4 a, c;
      a.x = cvtpk(p0[8 * ks + 0], p0[8 * ks + 1]); a.y = cvtpk(p0[8 * ks + 2], p0[8 * ks + 3]); a.z = cvtpk(p0[8 * ks + 4], p0[8 * ks + 5]); a.w = cvtpk(p0[8 * ks + 6], p0[8 * ks + 7]);
      c.x = cvtpk(p1[8 * ks + 0], p1[8 * ks + 1]); c.y = cvtpk(p1[8 * ks + 2], p1[8 * ks + 3]); c.z = cvtpk(p1[8 * ks + 4], p1[8 * ks + 5]); c.w = cvtpk(p1[8 * ks + 6], p1[8 * ks + 7]);
      pa[ks] = __builtin_bit_cast(bf16x8, a); pa[ks + 2] = __builtin_bit_cast(bf16x8, c);
    }
  }
  const LAS char* vb = (const LAS char*)lds + tbuf + 8192 + (4 * hi + ((lane & 15) >> 2)) * 64 + ((lane >> 4) & 1) * 32 + (lane & 3) * 8;
#pragma unroll
  for (int ks = 0; ks < 4; ++ks) {
    const s16x4 l0 = vtr(vb + ks * 1024), h0 = vtr(vb + ks * 1024 + 512);
    const s16x4 l1 = vtr(vb + 4096 + ks * 1024), h1 = vtr(vb + 4096 + ks * 1024 + 512);
    const bf16x8 f0 = (bf16x8){l0[0], l0[1], l0[2], l0[3], h0[0], h0[1], h0[2], h0[3]};
    const bf16x8 f1 = (bf16x8){l1[0], l1[1], l1[2], l1[3], h1[0], h1[1], h1[2], h1[3]};
    st.o0 = MFMA32(f0, pa[ks], st.o0);
    st.o1 = MFMA32(f1, pa[ks], st.o1);
  }
}

DI void attn_load_q(const bf16_t* __restrict__ qp, bf16x8 (&qr)[4]) {
#pragma unroll
  for (int d0 = 0; d0 < 4; ++d0) {
    const u32x4 v = *(const u32x4*)(qp + d0 * 16);
    u32x4 o;
    o.x = cvtpk(bflo(v.x) * C2, bfhi(v.x) * C2); o.y = cvtpk(bflo(v.y) * C2, bfhi(v.y) * C2);
    o.z = cvtpk(bflo(v.z) * C2, bfhi(v.z) * C2); o.w = cvtpk(bflo(v.w) * C2, bfhi(v.w) * C2);
    qr[d0] = __builtin_bit_cast(bf16x8, o);
  }
}
DI void attn_store(bf16_t* op, const AttState& st, float inv) {
#pragma unroll
  for (int g = 0; g < 4; ++g) {
    u32x2 a, c;
    a.x = cvtpk(st.o0[4 * g + 0] * inv, st.o0[4 * g + 1] * inv); a.y = cvtpk(st.o0[4 * g + 2] * inv, st.o0[4 * g + 3] * inv);
    c.x = cvtpk(st.o1[4 * g + 0] * inv, st.o1[4 * g + 1] * inv); c.y = cvtpk(st.o1[4 * g + 2] * inv, st.o1[4 * g + 3] * inv);
    *(u32x2*)(op + 8 * g) = a;
    *(u32x2*)(op + 32 + 8 * g) = c;
  }
}

DI void attn_dsa_unit(char* lds, const bf16_t* __restrict__ proj, bf16_t* __restrict__ mix, const uint2* __restrict__ bmt, int b, int h, int qb) {
  const int tid = otid(), lane = tid & 63, wid = __builtin_amdgcn_readfirstlane(tid >> 6), r32 = lane & 31, hi = lane >> 5;
  const int qrel = wid * 32 + r32, t = qb * 256 + qrel;
  const size_t tokq = (size_t)(b * S + t);
  bf16x8 qr[4];
  attn_load_q(proj + tokq * PLD + C_QD + h * 64 + hi * 8, qr);
  AttState st; st.m = 0.f; st.l = 0.f;
#pragma unroll
  for (int r = 0; r < 16; ++r) { st.o0[r] = 0.f; st.o1[r] = 0.f; }
  const uint2* bmp = bmt + (size_t)(b * 128) * 8192 + t;
  uint2 wn[4];
#pragma unroll
  for (int tt = 0; tt < 4; ++tt) wn[tt] = bmp[(size_t)tt * 8192];
  attn_stage<1>(lds, 0, proj, b, h, 0, lane, wid);
  const int ns = qb + 1;
  for (int s = 0; s < ns; ++s) {
    uint2 wc[4];
#pragma unroll
    for (int tt = 0; tt < 4; ++tt) wc[tt] = wn[tt];
    asm volatile("s_waitcnt vmcnt(0)" ::: "memory");
    __syncthreads();
    if (s + 1 < ns) {
#pragma unroll
      for (int tt = 0; tt < 4; ++tt) wn[tt] = bmp[(size_t)(4 * (s + 1) + tt) * 8192];
      attn_stage<1>(lds, ((s + 1) & 1) * ATT_ST, proj, b, h, (s + 1) * 256, lane, wid);
    }
#pragma unroll
    for (int tt = 0; tt < 4; ++tt) attn_tile<1>(lds, (s & 1) * ATT_ST + tt * 16384, qr, st, wc[tt], 0, qrel, r32, hi, lane);
  }
  float l = st.l; l += __shfl_xor(l, 32);
  attn_store(mix + tokq * D + 640 + h * 64 + 4 * hi, st, 1.f / l);
  __syncthreads();
}

DI void attn_own_unit(char* lds, const bf16_t* __restrict__ proj, bf16_t* __restrict__ part_o, float2* __restrict__ part_ml, int b, int h, int qb) {
  const int tid = otid(), lane = tid & 63, wid = __builtin_amdgcn_readfirstlane(tid >> 6), r32 = lane & 31, hi = lane >> 5;
  const int qrel = wid * 32 + r32, t = qb * 256 + qrel;
  const size_t tokq = (size_t)(b * S + t);
  attn_stage<0>(lds, 0, proj, b, h, qb * 256, lane, wid);
  bf16x8 qr[4];
  attn_load_q(proj + tokq * PLD + C_QM + h * 64 + hi * 8, qr);
  AttState st; st.m = 0.f; st.l = 0.f;
#pragma unroll
  for (int r = 0; r < 16; ++r) { st.o0[r] = 0.f; st.o1[r] = 0.f; }
  asm volatile("s_waitcnt vmcnt(0)" ::: "memory");
  __syncthreads();
#pragma unroll
  for (int tt = 0; tt < 4; ++tt) attn_tile<0>(lds, tt * 16384, qr, st, make_uint2(0u, 0u), tt, qrel, r32, hi, lane);
  float l = st.l; l += __shfl_xor(l, 32);
  const size_t pi = (tokq * 6 + h) * 4 + 3;
  if (hi == 0) st_wt64((unsigned long long*)&part_ml[pi], ((unsigned long long)__float_as_uint(l) << 32) | __float_as_uint(st.m));
  attn_store(part_o + pi * 64 + 4 * hi, st, 1.f / l);
  __syncthreads();
}

DI void attn_gather_unit(char* lds, const bf16_t* __restrict__ proj, bf16_t* __restrict__ part_o, float2* __restrict__ part_ml, int b, int h, int j, const unsigned* __restrict__ lst, int nent) {
  const int tid = otid(), lane = tid & 63, wid = __builtin_amdgcn_readfirstlane(tid >> 6), r32 = lane & 31, hi = lane >> 5;
  attn_stage<2>(lds, 0, proj, b, h, j * 256, lane, wid);
  asm volatile("s_waitcnt vmcnt(0)" ::: "memory");
  __syncthreads();
  const int ntile = (nent + 31) >> 5;
  for (int qt = wid; qt < ntile; qt += 8) {
    const int qi = qt * 32 + r32;
    const bool valid = qi < nent;
    const unsigned e = lst[valid ? qi : 0];
    const int t = (int)(e & 0x1FFFu), pslot = (int)(e >> 13);
    const size_t tokq = (size_t)(b * S + t);
    bf16x8 qr[4];
    attn_load_q(proj + tokq * PLD + C_QM + h * 64 + hi * 8, qr);
    AttState st; st.m = 0.f; st.l = 0.f;
#pragma unroll
    for (int r = 0; r < 16; ++r) { st.o0[r] = 0.f; st.o1[r] = 0.f; }
#pragma unroll
    for (int tt = 0; tt < 4; ++tt) attn_tile<2>(lds, tt * 16384, qr, st, make_uint2(0u, 0u), 0, 0, r32, hi, lane);
    float l = st.l; l += __shfl_xor(l, 32);
    if (valid) {
      const size_t pi = (tokq * 6 + h) * 4 + pslot;
      if (hi == 0) st_wt64((unsigned long long*)&part_ml[pi], ((unsigned long long)__float_as_uint(l) << 32) | __float_as_uint(st.m));
      attn_store(part_o + pi * 64 + 4 * hi, st, 1.f / l);
    }
  }
  __syncthreads();
}

DI void gate_unit(char* lds, int u, const bf16_t* __restrict__ proj, const float* __restrict__ kmean, unsigned* __restrict__ mcnt, unsigned* __restrict__ mlist) {
  unsigned* lc = (unsigned*)lds;
  unsigned* lb = lc + 192;
  float* kml = (float*)(lds + 2048);
  const int tid = otid();
  if (tid < 192) lc[tid] = 0u;
  const int tok = u * 64 + (tid & 63), head = tid >> 6;
  const int b = tok >> 13, t = tok & (S - 1), own = t >> 8;
  for (int i = tid; i < 6 * 32 * 16; i += NTHR) {
    const int jb = (i >> 4) & 31;
    if (jb < own) *(float4*)(kml + i * 4) = *(const float4*)(kmean + (size_t)b * 6 * 32 * 64 + i * 4);
  }
  __syncthreads();
  int sj[3] = {-1, -1, -1}; unsigned sp[3] = {0u, 0u, 0u};
  if (tid < 384) {
    u32x4 q[8];
    const bf16_t* qp = proj + (size_t)tok * PLD + C_QM + head * 64;
#pragma unroll
    for (int i = 0; i < 8; ++i) q[i] = *(const u32x4*)(qp + i * 8);
    float v1 = -INFINITY, v2 = -INFINITY, v3 = -INFINITY; int i1 = -1, i2 = -1, i3 = -1;
    for (int j = 0; j < own; ++j) {
      const float* km = kml + (head * 32 + j) * 64;
      float g = 0.f;
#pragma unroll
      for (int i = 0; i < 8; ++i) {
        const float4 ka = *(const float4*)(km + i * 8), kb = *(const float4*)(km + i * 8 + 4);
        g += bflo(q[i].x) * ka.x + bfhi(q[i].x) * ka.y + bflo(q[i].y) * ka.z + bfhi(q[i].y) * ka.w;
        g += bflo(q[i].z) * kb.x + bfhi(q[i].z) * kb.y + bflo(q[i].w) * kb.z + bfhi(q[i].w) * kb.w;
      }
      if (g > v1) { v3 = v2; i3 = i2; v2 = v1; i2 = i1; v1 = g; i1 = j; }
      else if (g > v2) { v3 = v2; i3 = i2; v2 = g; i2 = j; }
      else if (g > v3) { v3 = g; i3 = j; }
    }
    sj[0] = i1; sj[1] = i2; sj[2] = i3;
#pragma unroll
    for (int p = 0; p < 3; ++p) if (sj[p] >= 0) sp[p] = atomicAdd(&lc[head * 32 + sj[p]], 1u);
  }
  __syncthreads();
  if (tid < 192 && lc[tid]) lb[tid] = atomicAdd(&mcnt[(b * 6 + (tid >> 5)) * 32 + (tid & 31)], lc[tid]);
  __syncthreads();
  if (tid < 384) {
#pragma unroll
    for (int p = 0; p < 3; ++p) if (sj[p] >= 0) {
      const int c = (b * 6 + head) * 32 + sj[p];
      st_wt32(&mlist[(size_t)c * 8192 + lb[head * 32 + sj[p]] + sp[p]], (unsigned)t | ((unsigned)p << 13));
    }
  }
  __syncthreads();
}

DI void conv_unit(char* lds, int u, const bf16_t* __restrict__ proj, bf16_t* __restrict__ mix, const float* __restrict__ conv_w, const float* __restrict__ conv_b,
                  const float* __restrict__ ln_g, const float* __restrict__ ln_b);
DI void attn_queue_phase(char* lds, const bf16_t* proj, bf16_t* mix, const uint2* bmt, bf16_t* part_o, float2* part_ml, const unsigned* mcnt, const unsigned* mlist, unsigned* qhead,
                         const float* w1, const float* w3, const float* w2, bf16_t* w13T, bf16_t* w2T,
                         const float* conv_w, const float* conv_b, const float* ln_g, const float* ln_b) {
  unsigned* pfx = (unsigned*)(lds + 133120);
  unsigned* qw = (unsigned*)(lds + 133120 + 3328);
  const int tid = otid(), lane = tid & 63;
  if (tid < 64) {
    unsigned loc[12]; unsigned sum = 0u;
#pragma unroll
    for (int i = 0; i < 12; ++i) { loc[i] = (mcnt[tid * 12 + i] + 2047u) >> 11; sum += loc[i]; }
    unsigned run = scan_add(sum) - sum;
    if (lane == 0) pfx[0] = 0u;
#pragma unroll
    for (int i = 0; i < 12; ++i) { run += loc[i]; pfx[tid * 12 + i + 1] = run; }
  }
  __syncthreads();
  const int nsp = (int)pfx[768];
  const int natt = 768 + nsp + 768;
  const int nconv = T / 64;
  const int total = natt + nconv + PREP_EXP_ITEMS;
  int qlast = 0;
  for (;;) {
    if (tid == 0) qw[0] = atomicAdd(qhead, 1u);
    __syncthreads();
    const int q = (int)qw[0];
    __syncthreads();
    if (q >= natt) { qlast = q; break; }
    if (q < 768) {
      const int qb = 31 - q / 24, bh = q % 24;
      attn_dsa_unit(lds, proj, mix, bmt, bh / 6, bh % 6, qb);
    } else if (q < 768 + nsp) {
      const unsigned item = (unsigned)(q - 768);
      int lo = 0, hi = 768;
      while (hi - lo > 1) { const int mid = (lo + hi) >> 1; if (pfx[mid] <= item) lo = mid; else hi = mid; }
      const int c = lo, chunk = (int)(item - pfx[c]);
      const int nent = min(2048, (int)mcnt[c] - chunk * 2048);
      attn_gather_unit(lds, proj, part_o, part_ml, c / 192, (c >> 5) % 6, c & 31, mlist + (size_t)c * 8192 + chunk * 2048, nent);
    } else {
      const int o = q - 768 - nsp, qb = 31 - o / 24, bh = o % 24;
      attn_own_unit(lds, proj, part_o, part_ml, bh / 6, bh % 6, qb);
    }
  }
  for (int q = qlast; q < total;) {
    if (q < natt + nconv) conv_unit(lds, q - natt, proj, mix, conv_w, conv_b, ln_g, ln_b);
    else prep_exp_item(lds, q - natt - nconv, w1, w3, w2, w13T, w2T);
    if (tid == 0) qw[0] = atomicAdd(qhead, 1u);
    __syncthreads();
    q = (int)qw[0];
    __syncthreads();
  }
}

constexpr int SEL_CAP = 1024, SEL_G = 512, SEL_K = 256;
constexpr int SEL_LDS = 131072 + 512 + 4096 + 4096;
constexpr int SEL_DUMMY = 131072 + 512 + 4096;
DI unsigned fkey(float f) { const unsigned u = __float_as_uint(f); return (u & 0x80000000u) ? ~u : (u | 0x80000000u); }

DI float fkey_inv(unsigned k) { const unsigned u = (k & 0x80000000u) ? (k & 0x7fffffffu) : ~k; return __uint_as_float(u); }
DI int sbin(float s, float lo, float sc) { return min(63, __float2int_rd((s - lo) * sc)); }
DI int hist_scan(const unsigned* h, int lane, int K) {
  const unsigned Sx = scan_add(h[63 - lane]);
  const unsigned long long m = __ballot(Sx >= (unsigned)K);
  return m ? (63 - (int)__builtin_ctzll(m)) : -1;
}
DI void sel_row_maint(uint2* rowbuf, unsigned* cntp, float* taup, unsigned* hist, bool last, int K = SEL_K, bool thr = false, bool raw = false, uint2* tmp = nullptr) {
  const int lane = otid() & 63;
  int n = (int)*cntp; if (n > SEL_CAP) n = SEL_CAP;
  const int lim = thr ? K - 1 : (last ? SEL_K : (SEL_CAP - SEL_G));
  if (thr && n <= lim) { if (lane == 0) { *cntp = 0u; *taup = -INFINITY; } }
  if (n > lim) {
    unsigned ky[16], kx[16];
    unsigned kmin = 0xffffffffu, kmax = 0u;
#pragma unroll
    for (int i = 0; i < 16; ++i) {
      const int idx = lane + 64 * i; uint2 v = make_uint2(0u, 0u);
      if (64 * i < n) { if (idx < n) { v = rowbuf[idx]; if (raw) v.y = fkey(__uint_as_float(v.y)); kmin = min(kmin, v.y); kmax = max(kmax, v.y); } }
      ky[i] = v.y; kx[i] = v.x;
    }
    kmin = red_min(kmin); kmax = red_max(kmax);
    const float lo = fkey_inv(kmin), range = fkey_inv(kmax) - lo, sc = range > 0.f ? 64.f / range : 0.f;
    hist[lane] = 0u;
    int bn[16];
#pragma unroll
    for (int i = 0; i < 16; ++i) { const int idx = lane + 64 * i; bn[i] = -1; if (64 * i < n) { if (idx < n) { bn[i] = max(0, sbin(fkey_inv(ky[i]), lo, sc)); atomicAdd(&hist[bn[i]], 1u); } } }
    const int L = hist_scan(hist, lane, K);
    unsigned ka = 0xffffffffu, kb = 0xffffffffu;
    int ckeep = 0;
#pragma unroll
    for (int i = 0; i < 16; ++i) { if (64 * i < n) { if (bn[i] >= L) { ka = min(ka, ky[i]); ++ckeep; } if (bn[i] > L) kb = min(kb, ky[i]); } }
    ka = red_min(ka); kb = red_min(kb); ckeep = (int)red_add((unsigned)ckeep);
    if (thr) { if (lane == 0) { *cntp = 0u; *taup = fkey_inv(ka); } return; }
    unsigned theta = ka, phi = 0u;
    int nsel = ckeep;
    if (last || ckeep > SEL_CAP - SEL_G) {
      unsigned av = ka, hi = (kb != 0xffffffffu) ? kb - 1u : kmax;
      int ca = -1;
      const int mL = (int)hist[L];
      if (tmp != nullptr && mL <= 64) {
        const unsigned long long ltm = (1ull << lane) - 1ull;
        int gb = 0;
#pragma unroll
        for (int i = 0; i < 16; ++i) {
          if (64 * i < n) {
            const bool inl = (bn[i] == L);
            const unsigned long long bal = __ballot(inl);
            if (inl) tmp[gb + __popcll(bal & ltm)] = make_uint2(kx[i], ky[i]);
            gb += __popcll(bal);
          }
        }
        const uint2 ev = tmp[lane];
        const bool ok = lane < mL;
        const unsigned ey = ok ? ev.y : 0u, ex = ev.x;
        const int needl = SEL_K - (ckeep - mL);
        while (av < hi) {
          const unsigned d = hi - av, mid = av + (d >> 1) + (d & 1u);
          const int c = __popcll(__ballot(ok && ey >= mid));
          if (c >= needl) { av = mid; ca = c; } else hi = mid - 1u;
          if (c == needl) break;
        }
        theta = av;
        if (ca != needl) {
          const int cgt = __popcll(__ballot(ok && ey > theta));
          const int need = needl - cgt;
          for (int bit = 31; bit >= 0; --bit) {
            const unsigned cand = phi | (1u << bit);
            const int c = __popcll(__ballot(ok && ey == theta && ex >= cand));
            if (c >= need) phi = cand;
            if (c == need) break;
          }
        }
      } else {
        while (av < hi) {
          const unsigned d = hi - av, mid = av + (d >> 1) + (d & 1u);
          int c = 0;
#pragma unroll
          for (int i = 0; i < 16; ++i) { if (64 * i < n) c += __popcll(__ballot(ky[i] >= mid)); }
          if (c >= SEL_K) { av = mid; ca = c; } else hi = mid - 1u;
          if (c == SEL_K) break;
        }
        theta = av;
        if (ca != SEL_K) {
          int cgt = 0;
#pragma unroll
          for (int i = 0; i < 16; ++i) cgt += __popcll(__ballot(ky[i] > theta));
          const int need = SEL_K - cgt;
          for (int bit = 31; bit >= 0; --bit) {
            const unsigned cand = phi | (1u << bit);
            int c = 0;
#pragma unroll
            for (int i = 0; i < 16; ++i) c += __popcll(__ballot(ky[i] == theta && kx[i] >= cand));
            if (c >= need) phi = cand;
            if (c == need) break;
          }
        }
      }
      nsel = SEL_K;
    }
    const unsigned long long lt = (1ull << lane) - 1ull;
    int base = 0;
#pragma unroll
    for (int i = 0; i < 16; ++i) {
      if (64 * i < n) {
        const bool sl = (ky[i] > theta) || (ky[i] == theta && kx[i] >= phi);
        const unsigned long long bal = __ballot(sl);
        const int pos = base + __popcll(bal & lt);
        if (sl && pos < SEL_CAP) rowbuf[pos] = make_uint2(kx[i], ky[i]);
        base += __popcll(bal);
      }
    }
    if (lane == 0) { *cntp = (unsigned)nsel; *taup = fkey_inv(theta); }
  }
}

constexpr int SEL_CTL = 131072, SEL_HIST = 131072 + 512;
template <int SM>
DI void dsa_select_unit(char* lds, const bf16_t* __restrict__ proj, uint2* __restrict__ bmt, int b, int rg) {
  uint2* buf = (uint2*)lds;
  unsigned* cnt = (unsigned*)(lds + SEL_CTL);
  float* tauf = (float*)(cnt + 16);
  unsigned* flag = cnt + 32;
  unsigned* hist = (unsigned*)(lds + SEL_HIST);
  const int tid = otid(), lane = tid & 63, wid = __builtin_amdgcn_readfirstlane(tid >> 6), fr = lane & 15, fq = lane >> 4;
  const int t0 = rg * 16, t = t0 + fr;
  if (tid < 16) { cnt[tid] = 0u; tauf[tid] = -INFINITY; }
  if (tid == 0) flag[0] = 0u;
  const bf16_t* qrow = proj + (size_t)(b * S + t) * PLD;
  bf16x8 qf[8][2]; float w[8];
#pragma unroll
  for (int hh = 0; hh < 8; ++hh) {
    qf[hh][0] = *(const bf16x8*)(qrow + C_QI + hh * 64 + fq * 8);
    qf[hh][1] = *(const bf16x8*)(qrow + C_QI + hh * 64 + 32 + fq * 8);
    w[hh] = bf2f(qrow[C_WI + hh]);
  }
  const int ntile = rg + 1;
  const bf16_t* kbase = proj + (size_t)(b * S + fr) * PLD + C_KI + fq * 8;
  bf16x8 q9[2];
#pragma unroll
  for (int s = 0; s < 2; ++s) {
    float f[8];
#pragma unroll
    for (int j = 0; j < 8; ++j) {
      float a = 0.f;
#pragma unroll
      for (int hh = 0; hh < 8; ++hh) a += w[hh] * bf2f((bf16_t)qf[hh][s][j]);
      f[j] = a;
    }
    u32x4 o; o.x = cvtpk(f[0], f[1]); o.y = cvtpk(f[2], f[3]); o.z = cvtpk(f[4], f[5]); o.w = cvtpk(f[6], f[7]);
    q9[s] = __builtin_bit_cast(bf16x8, o);
  }
  unsigned dmask = 0u;
#pragma unroll
  for (int r = 0; r < 4; ++r) dmask |= (fq * 4 + r <= fr) ? (1u << r) : 0u;
  __syncthreads();
  uint2* const dummy = (uint2*)(lds + SEL_DUMMY) + tid;
  auto stream = [&](int first, int step, int kend, float tv, bool raw) {
    bf16x8 kf[4][2];
#pragma unroll
    for (int i = 0; i < 4; ++i) {
      const int kt = first + i * step;
      if (kt < kend) { const bf16_t* kp = kbase + (size_t)kt * 16 * PLD; kf[i][0] = *(const bf16x8*)kp; kf[i][1] = *(const bf16x8*)(kp + 32); }
    }
    for (int kb0 = first; kb0 < kend; kb0 += 4 * step) {
      bf16x8 kn[4][2];
#pragma unroll
      for (int i = 0; i < 4; ++i) {
        const int kt = kb0 + (4 + i) * step;
        if (kt < kend) { const bf16_t* kp = kbase + (size_t)kt * 16 * PLD; kn[i][0] = *(const bf16x8*)kp; kn[i][1] = *(const bf16x8*)(kp + 32); }
      }
      f32x4 sv[4];
      unsigned pmask = 0u;
      {
        const f32x4 z = (f32x4){0.f, 0.f, 0.f, 0.f};
        f32x4 xb[3];
        f32x4 acc = z;
#define SEL_PAIR(n) do { const int i_ = (n) / 9, j_ = (n) % 9; \
          const f32x4 t_ = MFMA16(kf[i_][0], j_ ? qf[j_ ? j_ - 1 : 0][0] : q9[0], z); \
          xb[(n) % 3] = MFMA16(kf[i_][1], j_ ? qf[j_ ? j_ - 1 : 0][1] : q9[1], t_); } while (0)
        SEL_PAIR(0); SEL_PAIR(1);
#pragma unroll
        for (int n = 0; n < 36; ++n) {
          if (n + 2 < 36) SEL_PAIR(n + 2);
          __builtin_amdgcn_sched_barrier(0);
          const int i = n / 9, j = n % 9;
          if (j == 0) acc = xb[n % 3];
          else {
#pragma unroll
            for (int r = 0; r < 4; ++r) { float v = fmaf(fabsf(xb[n % 3][r]), w[j - 1], acc[r]); asm volatile("" : "+v"(v)); acc[r] = v; }
          }
          if (j == 8) {
            const int kt = kb0 + i * step;
            sv[i] = acc;
            if (SM == 1) { asm volatile("" :: "v"(acc[0]), "v"(acc[1]), "v"(acc[2]), "v"(acc[3])); }
            else {
              const unsigned allow = (kt < kend) ? ((kt == ntile - 1) ? dmask : 0xfu) : 0u;
              unsigned pm = 0u;
#pragma unroll
              for (int r = 0; r < 4; ++r) pm |= (acc[r] >= tv) ? (1u << r) : 0u;
              pmask |= (pm & allow) << (i * 4);
            }
          }
          __builtin_amdgcn_sched_barrier(0);
        }
#undef SEL_PAIR
      }
      if (SM != 1) {
        const int np = __popc(pmask);
        unsigned slot = 0u;
        if (np) slot = atomicAdd(&cnt[fr], (unsigned)np);
        if (slot + (unsigned)np > (unsigned)SEL_CAP) slot = (unsigned)(SEL_CAP - 16);
        uint2* rb = buf + fr * SEL_CAP;
#pragma unroll
        for (int i = 0; i < 4; ++i) {
          const unsigned xb = ~(unsigned)((kb0 + i * step) * 16 + fq * 4);
#pragma unroll
          for (int r = 0; r < 4; ++r) {
            const int e = i * 4 + r;
            const unsigned pos = slot + (unsigned)__popc(pmask & ((1u << e) - 1u));
            uint2* dst = ((pmask >> e) & 1u) ? (rb + pos) : dummy;
            *dst = make_uint2(xb - (unsigned)r, raw ? __float_as_uint(sv[i][r]) : fkey(sv[i][r]));
          }
        }
      }
#pragma unroll
      for (int i = 0; i < 4; ++i) { kf[i][0] = kn[i][0]; kf[i][1] = kn[i][1]; }
    }
  };
  bool done = false;
  if (SM == 0 || SM == 3) {
    if (ntile > 64) {
      stream(8 * wid, 64, ntile, -INFINITY, true);
      __syncthreads();
#pragma unroll 1
      for (int rr = 0; rr < 2; ++rr) {
        const int row = 2 * wid + rr;
        const int ns = (int)cnt[row], nrow = t0 + row + 1;
        const int K = min(ns, (2 * SEL_K * ns + nrow - 1) / nrow);
        sel_row_maint(buf + row * SEL_CAP, &cnt[row], &tauf[row], hist + wid * 64, false, max(K, 1), true, true);
      }
      __syncthreads();
      stream(wid, 8, ntile, tauf[fr], true);
      __syncthreads();
      if (tid < 16) { const unsigned c = cnt[tid]; if (c < (unsigned)SEL_K || c > (unsigned)SEL_CAP) atomicOr(&flag[0], 1u); }
      __syncthreads();
      done = (flag[0] == 0u);
      if (done) {
#pragma unroll 1
        for (int rr = 0; rr < 2; ++rr) { const int row = 2 * wid + rr; sel_row_maint(buf + row * SEL_CAP, &cnt[row], &tauf[row], hist + wid * 64, true, SEL_K, false, true, (uint2*)(lds + SEL_DUMMY) + wid * 64); }
      }
      __syncthreads();
      if (!done && tid < 16) { cnt[tid] = 0u; tauf[tid] = -INFINITY; }
      __syncthreads();
    }
  }
  if (!done) {
    const int nround = (ntile + 31) >> 5;
    for (int rd = 0; rd < nround; ++rd) {
      stream(rd * 32 + wid, 8, min(ntile, rd * 32 + 32), tauf[fr], false);
      __syncthreads();
      const bool last = (rd == nround - 1);
      if (SM == 1 || SM == 2) continue;
#pragma unroll 1
      for (int rr = 0; rr < 2; ++rr) {
        const int row = 2 * wid + rr;
        sel_row_maint(buf + row * SEL_CAP, &cnt[row], &tauf[row], hist + wid * 64, last, SEL_K, false, false, (uint2*)(lds + SEL_DUMMY) + wid * 64);
      }
      __syncthreads();
    }
  }
  if (SM != 0) { __syncthreads(); return; }
#pragma unroll
  for (int i = 0; i < 8; ++i) { const int wd = tid + NTHR * i; *(unsigned*)(lds + (wd >> 8) * 8192 + 4096 + (wd & 255) * 4) = 0u; }
  __syncthreads();
  {
    const int row = tid >> 5;
    int n = (int)cnt[row]; if (n > SEL_K) n = SEL_K;
    unsigned* img = (unsigned*)(lds + row * 8192 + 4096);
#pragma unroll
    for (int i = 0; i < 8; ++i) {
      const int e = (tid & 31) + 32 * i;
      if (e < n) { const unsigned idx = ~buf[row * SEL_CAP + e].x; atomicOr(&img[idx >> 5], 1u << (((idx & 31) >> 1) + 16 * (idx & 1))); }
    }
  }
  __syncthreads();
  {
    const int ntw = 4 * (t0 >> 8) + 4;
    const int r = tid & 15;
    const unsigned* img = (const unsigned*)(lds + r * 8192 + 4096);
    for (int tile = tid >> 4; tile < ntw; tile += 32)
      bmt[((size_t)(b * 128 + tile)) * 8192 + t0 + r] = make_uint2(img[2 * tile], img[2 * tile + 1]);
  }
  __syncthreads();
}

constexpr int MIX_LDS = 94 * 256 * 4;
DI void conv_unit(char* lds, int u, const bf16_t* __restrict__ proj, bf16_t* __restrict__ mix, const float* __restrict__ conv_w, const float* __restrict__ conv_b,
                  const float* __restrict__ ln_g, const float* __restrict__ ln_b) {
  float* ut = (float*)lds;
  const int tid = otid(), lane = tid & 63, wid = tid >> 6;
  {
    const int tok0 = u * 64, b = tok0 >> 13, t0 = tok0 & (S - 1);
#pragma unroll
    for (int it = 0; it < 6; ++it) {
      const int task = tid + it * NTHR;
      if (task >= 94 * 32) break;
      const int row = task >> 5, cc = (task & 31) * 8;
      const int tt = t0 - 30 + row;
      float uv[8] = {0.f, 0.f, 0.f, 0.f, 0.f, 0.f, 0.f, 0.f};
      if (tt >= 0) {
        const bf16_t* pr = proj + (size_t)(b * S + tt) * PLD;
        const u32x4 a = *(const u32x4*)(pr + C_CA + cc), g = *(const u32x4*)(pr + C_CG + cc);
        const float av[8] = {bflo(a.x), bfhi(a.x), bflo(a.y), bfhi(a.y), bflo(a.z), bfhi(a.z), bflo(a.w), bfhi(a.w)};
        const float gv[8] = {bflo(g.x), bfhi(g.x), bflo(g.y), bfhi(g.y), bflo(g.z), bfhi(g.z), bflo(g.w), bfhi(g.w)};
#pragma unroll
        for (int q = 0; q < 8; ++q) uv[q] = av[q] * frcp(1.f + fexp2(gv[q] * -1.4426950408889634f));
      }
      *(float4*)(ut + row * 256 + cc) = make_float4(uv[0], uv[1], uv[2], uv[3]);
      *(float4*)(ut + row * 256 + cc + 4) = make_float4(uv[4], uv[5], uv[6], uv[7]);
    }
    __syncthreads();
    const int c = tid & 255, half = tid >> 8;
    float cw[31];
#pragma unroll
    for (int w = 0; w < 31; ++w) cw[w] = conv_w[w * 256 + c];
    float y[32];
    const float cb = conv_b[c];
#pragma unroll
    for (int o = 0; o < 32; ++o) y[o] = cb;
#pragma unroll
    for (int rho = 0; rho < 62; ++rho) {
      const float uvv = ut[(half * 32 + rho) * 256 + c];
#pragma unroll
      for (int o = 0; o < 32; ++o) { if (rho - o >= 0 && rho - o <= 30) y[o] += uvv * cw[rho - o]; }
    }
    __syncthreads();
#pragma unroll
    for (int o = 0; o < 32; ++o) ut[(half * 32 + o) * 256 + c] = y[o];
    __syncthreads();
    {
      const float4 gg = *(const float4*)(ln_g + lane * 4), bb = *(const float4*)(ln_b + lane * 4);
#pragma unroll 1
      for (int i4 = 0; i4 < 8; i4 += 4) {
        float4 v[4]; float sm[4], vr[4];
#pragma unroll
        for (int r = 0; r < 4; ++r) { v[r] = *(const float4*)(ut + (wid * 8 + i4 + r) * 256 + lane * 4); sm[r] = v[r].x + v[r].y + v[r].z + v[r].w; }
        wave_sum4(sm);
#pragma unroll
        for (int r = 0; r < 4; ++r) {
          const float mu = sm[r] * (1.f / 256.f);
          v[r].x -= mu; v[r].y -= mu; v[r].z -= mu; v[r].w -= mu;
          vr[r] = v[r].x * v[r].x + v[r].y * v[r].y + v[r].z * v[r].z + v[r].w * v[r].w;
        }
        wave_sum4(vr);
#pragma unroll
        for (int r = 0; r < 4; ++r) {
          const float rs = rsqrtf(vr[r] * (1.f / 256.f) + EPS);
          const float z0 = v[r].x * rs * gg.x + bb.x, z1 = v[r].y * rs * gg.y + bb.y, z2 = v[r].z * rs * gg.z + bb.z, z3 = v[r].w * rs * gg.w + bb.w;
          u32x2 o; o.x = cvtpk(silu_f(z0), silu_f(z1)); o.y = cvtpk(silu_f(z2), silu_f(z3));
          *(u32x2*)(mix + (size_t)(tok0 + wid * 8 + i4 + r) * D + 384 + lane * 4) = o;
        }
      }
    }
    __syncthreads();
  }
}

DI void mixfin_phase(bf16_t* __restrict__ mix, const float* __restrict__ mg, const float* __restrict__ dg, const bf16_t* __restrict__ part_o, const float2* __restrict__ part_ml) {
  const int tid = otid(), lane = tid & 63, wid = tid >> 6;
  for (int u = blockIdx.x; u < T / 64; u += gridDim.x) {
    const int tok0 = u * 64, t0 = tok0 & (S - 1);
    {
      const int nsel = min(3, t0 >> 8);
#pragma unroll 4
      for (int i = 0; i < 8; ++i) {
        const int tl = wid * 8 + i;
        const size_t tok = (size_t)(tok0 + tl);
        bf16_t* mr = mix + tok * D;
        float av[8] = {0.f, 0.f, 0.f, 0.f, 0.f, 0.f, 0.f, 0.f};
#pragma unroll
        for (int ch = 0; ch < 2; ++ch) {
          if (ch == 0 || lane < 32) {
            const int col = ch * 256 + lane * 4, hh = col >> 6, d0 = col & 63;
            const size_t pb = (tok * 6 + hh) * 4;
            const float2 ml3 = part_ml[pb + 3];
            float2 mls[3]; float M = ml3.x;
#pragma unroll
            for (int p = 0; p < 3; ++p) { mls[p] = make_float2(-1e30f, 0.f); if (p < nsel) { mls[p] = part_ml[pb + p]; M = fmaxf(M, mls[p].x); } }
            float wsum = 0.f, acc4[4] = {0.f, 0.f, 0.f, 0.f};
#pragma unroll
            for (int p = 0; p < 4; ++p) {
              if (p == 3 || p < nsel) {
                const float2 mlp = (p == 3) ? ml3 : mls[p < 3 ? p : 0];
                const float wgt = mlp.y * fexp2(mlp.x - M);
                const u32x2 ov = *(const u32x2*)(part_o + (pb + p) * 64 + d0);
                wsum += wgt;
                acc4[0] += wgt * bflo(ov.x); acc4[1] += wgt * bfhi(ov.x); acc4[2] += wgt * bflo(ov.y); acc4[3] += wgt * bfhi(ov.y);
              }
            }
            const float iw = 1.f / wsum;
#pragma unroll
            for (int q = 0; q < 4; ++q) av[ch * 4 + q] = acc4[q] * iw;
          }
        }
        {
          const float ss = wave_sum(av[0] * av[0] + av[1] * av[1] + av[2] * av[2] + av[3] * av[3] + av[4] * av[4] + av[5] * av[5] + av[6] * av[6] + av[7] * av[7]);
          const float rs = rsqrtf(ss * (1.f / 384.f) + EPS);
          const float4 g0 = *(const float4*)(mg + lane * 4);
          u32x2 o; o.x = cvtpk(av[0] * rs * g0.x, av[1] * rs * g0.y); o.y = cvtpk(av[2] * rs * g0.z, av[3] * rs * g0.w);
          *(u32x2*)(mr + lane * 4) = o;
          if (lane < 32) {
            const float4 g1 = *(const float4*)(mg + 256 + lane * 4);
            u32x2 o2; o2.x = cvtpk(av[4] * rs * g1.x, av[5] * rs * g1.y); o2.y = cvtpk(av[6] * rs * g1.z, av[7] * rs * g1.w);
            *(u32x2*)(mr + 256 + lane * 4) = o2;
          }
        }
        {
          bf16_t* pp = mr + 640;
          const u32x2 a = *(const u32x2*)(pp + lane * 4);
          u32x2 c2 = (u32x2){0u, 0u};
          if (lane < 32) c2 = *(const u32x2*)(pp + 256 + lane * 4);
          const float a0 = bflo(a.x), a1 = bfhi(a.x), a2 = bflo(a.y), a3 = bfhi(a.y);
          const float c0 = bflo(c2.x), c1 = bfhi(c2.x), c2f = bflo(c2.y), c3 = bfhi(c2.y);
          const float ss = wave_sum(a0 * a0 + a1 * a1 + a2 * a2 + a3 * a3 + c0 * c0 + c1 * c1 + c2f * c2f + c3 * c3);
          const float rs = rsqrtf(ss * (1.f / 384.f) + EPS);
          const float4 g0 = *(const float4*)(dg + lane * 4);
          u32x2 o; o.x = cvtpk(a0 * rs * g0.x, a1 * rs * g0.y); o.y = cvtpk(a2 * rs * g0.z, a3 * rs * g0.w);
          *(u32x2*)(pp + lane * 4) = o;
          if (lane < 32) {
            const float4 g1 = *(const float4*)(dg + 256 + lane * 4);
            u32x2 o2; o2.x = cvtpk(c0 * rs * g1.x, c1 * rs * g1.y); o2.y = cvtpk(c2f * rs * g1.z, c3 * rs * g1.w);
            *(u32x2*)(pp + 256 + lane * 4) = o2;
          }
        }
      }
    }
    __syncthreads();
  }
}

DI void route_phase(char* lds, const float* __restrict__ logits, const float* __restrict__ rgb, const float* __restrict__ reb, unsigned* __restrict__ list, int* __restrict__ cnt, float* __restrict__ gate) {
  unsigned* lcnt = (unsigned*)lds;
  unsigned* lbase = lcnt + 32;
  const int tid = otid();
  for (int u = blockIdx.x; u < T / NTHR; u += gridDim.x) {
    if (tid < 32) lcnt[tid] = 0u;
    __syncthreads();
    const int tok = u * NTHR + tid;
    const float* lg = logits + (size_t)tok * 36;
    float gl[4];
#pragma unroll
    for (int i = 0; i < 4; ++i) gl[i] = lg[i] + rgb[i];
    int gi = 0; float gm = gl[0];
#pragma unroll
    for (int i = 1; i < 4; ++i) if (gl[i] > gm) { gm = gl[i]; gi = i; }
    float gs = 0.f;
#pragma unroll
    for (int i = 0; i < 4; ++i) gs += __expf(gl[i] - gm);
    const float gw = 1.f / gs;
    float e1 = -INFINITY, e2 = -INFINITY; int j1 = 0, j2 = 0;
    for (int j = 0; j < 8; ++j) {
      const float v = lg[4 + gi * 8 + j] + reb[gi * 8 + j];
      if (v > e1) { e2 = e1; j2 = j1; e1 = v; j1 = j; }
      else if (v > e2) { e2 = v; j2 = j; }
    }
    const float p2 = 1.f / (1.f + __expf(e1 - e2)), p1 = 1.f - p2;
    const int ex1 = gi * 8 + j1, ex2 = gi * 8 + j2;
    gate[tok * 2] = gw * p1; gate[tok * 2 + 1] = gw * p2;
    const unsigned pos1 = atomicAdd(&lcnt[ex1], 1u);
    const unsigned pos2 = atomicAdd(&lcnt[ex2], 1u);
    __syncthreads();
    if (tid < 32) lbase[tid] = (unsigned)atomicAdd(&cnt[tid], (int)lcnt[tid]);
    __syncthreads();
    st_wt32(&list[(size_t)ex1 * 65536 + lbase[ex1] + pos1], (unsigned)(tok * 2));
    st_wt32(&list[(size_t)ex2 * 65536 + lbase[ex2] + pos2], (unsigned)(tok * 2 + 1));
    __syncthreads();
  }
}

DI void combine_phase(float* __restrict__ xio, const bf16_t* __restrict__ ys, const float* __restrict__ g2, int final_mode,
                      const float* __restrict__ g, const float* __restrict__ mod_sh, const float* __restrict__ mod_sc, bf16_t* __restrict__ h) {
  const int tid_ = otid(); const int lane = tid_ & 63, wid = tid_ >> 6;
  for (int row0 = (blockIdx.x * 8 + wid) * 2; row0 < T; row0 += gridDim.x * 16) {
    const int b = row0 >> 13;
    float4 v[2][4]; float ssa[4] = {0.f, 0.f, 0.f, 0.f};
    u32x2 ya[2][4], yc[2][4];
#pragma unroll
    for (int r = 0; r < 2; ++r) {
      const float* xr = xio + (size_t)(row0 + r) * D;
      const bf16_t* y0 = ys + (size_t)(row0 + r) * 2048;
#pragma unroll
      for (int i = 0; i < 4; ++i) {
        const int col = i * 256 + lane * 4;
        v[r][i] = *(const float4*)(xr + col);
        ya[r][i] = *(const u32x2*)(y0 + col); yc[r][i] = *(const u32x2*)(y0 + 1024 + col);
      }
    }
#pragma unroll
    for (int i = 0; i < 4; ++i) {
      const int col = i * 256 + lane * 4;
      const float4 gg = *(const float4*)(g2 + (size_t)b * 6144 + col);
#pragma unroll
      for (int r = 0; r < 2; ++r) {
        v[r][i].x += gg.x * (bflo(ya[r][i].x) + bflo(yc[r][i].x)); v[r][i].y += gg.y * (bfhi(ya[r][i].x) + bfhi(yc[r][i].x));
        v[r][i].z += gg.z * (bflo(ya[r][i].y) + bflo(yc[r][i].y)); v[r][i].w += gg.w * (bfhi(ya[r][i].y) + bfhi(yc[r][i].y));
        ssa[r] += v[r][i].x * v[r][i].x + v[r][i].y * v[r][i].y + v[r][i].z * v[r][i].z + v[r][i].w * v[r][i].w;
      }
    }
    wave_sum4(ssa);
#pragma unroll
    for (int i = 0; i < 4; ++i) {
      const int col = i * 256 + lane * 4;
      const float4 gg = *(const float4*)(g + col);
      float4 sc = make_float4(0.f, 0.f, 0.f, 0.f), sh = sc;
      if (!final_mode) { sc = *(const float4*)(mod_sc + (size_t)b * 6144 + col); sh = *(const float4*)(mod_sh + (size_t)b * 6144 + col); }
#pragma unroll
      for (int r = 0; r < 2; ++r) {
        const float rstd = rsqrtf(ssa[r] * (1.f / 1024.f) + EPS);
        float* xr = xio + (size_t)(row0 + r) * D;
        if (final_mode) {
          *(float4*)(xr + col) = make_float4(v[r][i].x * rstd * gg.x, v[r][i].y * rstd * gg.y, v[r][i].z * rstd * gg.z, v[r][i].w * rstd * gg.w);
        } else {
          *(float4*)(xr + col) = v[r][i];
          u32x2 o;
          o.x = cvtpk(v[r][i].x * rstd * gg.x * (1.f + sc.x) + sh.x, v[r][i].y * rstd * gg.y * (1.f + sc.y) + sh.y);
          o.y = cvtpk(v[r][i].z * rstd * gg.z * (1.f + sc.z) + sh.z, v[r][i].w * rstd * gg.w * (1.f + sc.w) + sh.w);
          *(u32x2*)(h + (size_t)(row0 + r) * D + col) = o;
        }
      }
    }
  }
}

#define XB_TMO      128
#define XB_XCNT(j)  (256  + 64 * (j))
#define XB_XSUB(j)  (1280 + 64 * (j))
#define XB_XGEN(j)  (2304 + 64 * (j))
#define XB_TOP      3328
#define XB_TOPGEN   3392
#define XCD_BAR_WORDS 3456
#define XB_SPIN_CAP (1u << 18)
DI unsigned xb_ld(unsigned* p) { return __hip_atomic_load(p, __ATOMIC_RELAXED, __HIP_MEMORY_SCOPE_AGENT); }
DI unsigned xb_add(unsigned* p, unsigned v) { return __hip_atomic_fetch_add(p, v, __ATOMIC_RELAXED, __HIP_MEMORY_SCOPE_AGENT); }
DI unsigned xb_xcc_id() { return (unsigned)__builtin_amdgcn_s_getreg((3 << 11) | 20) & 0xFu; }
#define XB_SPIN(cond, bar) do { unsigned _sp = 0; while (cond) { __builtin_amdgcn_s_sleep(1); \
    if ((++_sp & 255u) == 0u) { if (xb_ld(&(bar)[XB_TMO])) break; if (_sp > XB_SPIN_CAP) { atomicAdd(&(bar)[XB_TMO], 1u); break; } } } } while (0)
struct XcdBarrier { unsigned* bar; unsigned x; volatile LAS unsigned* st; };
DI XcdBarrier xcd_barrier_post(unsigned* bar, volatile LAS unsigned* st) {
  XcdBarrier b; b.bar = bar; b.x = xb_xcc_id(); b.st = st;
  if (threadIdx.x == 0) (void)xb_add(&bar[XB_XCNT(b.x)], 1u);
  return b;
}
DI void xcd_barrier_complete(unsigned* bar, unsigned x, unsigned& nloc, unsigned& nx) {
  const unsigned G = gridDim.x * gridDim.y * gridDim.z;
  unsigned sum, cnt, mine, sp = 0u;
  for (;;) {
    sum = 0u; cnt = 0u; mine = 0u;
#pragma unroll
    for (unsigned j = 0; j < 16; ++j) { const unsigned c = xb_ld(&bar[XB_XCNT(j)]); sum += c; cnt += (c > 0u) ? 1u : 0u; mine = (j == x) ? c : mine; }
    if (sum == G) break;
    __builtin_amdgcn_s_sleep(1);
    if ((++sp & 255u) == 0u) { if (xb_ld(&bar[XB_TMO])) break; if (sp > XB_SPIN_CAP) { atomicAdd(&bar[XB_TMO], 1u); break; } }
  }
  nloc = mine > 0u ? mine : 1u; nx = cnt > 0u ? cnt : 1u;
}
DI void xcd_barrier(const XcdBarrier& b) {
  asm volatile("s_waitcnt vmcnt(0)" ::: "memory");
  __syncthreads();
  if (threadIdx.x == 0) {
    unsigned* bar = b.bar;
    __builtin_amdgcn_s_waitcnt(0);
    unsigned nloc = b.st[0], nx = b.st[1];
    if (nloc == 0u) { xcd_barrier_complete(bar, b.x, nloc, nx); b.st[0] = nloc; b.st[1] = nx; }
    const unsigned old = xb_add(&bar[XB_XSUB(b.x)], 1u);
    const unsigned gen = old / nloc;
    if (old + 1u == (gen + 1u) * nloc) {
      __builtin_amdgcn_fence(__ATOMIC_RELEASE, "");
      asm volatile("s_waitcnt vmcnt(0)" ::: "memory");
      const unsigned og = xb_add(&bar[XB_TOP], 1u);
      const unsigned tg = og / nx;
      if (og + 1u == (tg + 1u) * nx) xb_add(&bar[XB_TOPGEN], 1u);
      else XB_SPIN(xb_ld(&bar[XB_TOPGEN]) == tg, bar);
      __builtin_amdgcn_fence(__ATOMIC_ACQUIRE, "");
      xb_add(&bar[XB_XGEN(b.x)], 1u);
      asm volatile("s_waitcnt vmcnt(0)" ::: "memory");
    } else {
      XB_SPIN(xb_ld(&bar[XB_XGEN(b.x)]) == gen, bar);
      __builtin_amdgcn_fence(__ATOMIC_ACQUIRE, "");
      asm volatile("s_waitcnt vmcnt(0)" ::: "memory");
    }
  }
  __syncthreads();
}

struct MegaP {
  const float *x, *c, *ada_w, *ada_b, *norm1_g, *w_in, *conv_w, *conv_b, *cln_g, *cln_b, *moba_g, *dsa_g, *w_out, *norm2_g, *rgw, *rgb, *rew, *reb, *w1, *w3, *w2, *final_g;
  float* out; char* ws;
};
constexpr int LDS_BST = 143360;
constexpr int MEGA_LDS = LDS_BST + 16;
constexpr int CW_BAR = 1024;
#ifndef PROBE
#define PROBE 0
#endif
#define NREP(k) ((PROBE == (k)) ? 2 : 1)

__global__ void __launch_bounds__(NTHR) mega(MegaP p) {
  extern __shared__ __attribute__((aligned(16))) char lds[];
  cg::grid_group grid = cg::this_grid();
  char* ws = p.ws;
  unsigned* ctl = (unsigned*)(ws + WS_CTL);
  float* mod = (float*)(ws + WS_MOD);
  float* kmean = (float*)(ws + WS_KMEAN);
  float* gate = (float*)(ws + WS_GATE);
  float* logits = (float*)(ws + WS_LOGIT);
  unsigned* list = (unsigned*)(ws + WS_LIST);
  bf16_t* winT = (bf16_t*)(ws + WS_WINT);
  bf16_t* woutT = (bf16_t*)(ws + WS_WOUTT);
  bf16_t* rt = (bf16_t*)(ws + WS_RT);
  bf16_t* w13T = (bf16_t*)(ws + WS_W13T);
  bf16_t* w2T = (bf16_t*)(ws + WS_W2T);
  bf16_t* hb = (bf16_t*)(ws + WS_HB);
  uint2* bmt = (uint2*)(ws + WS_BMT);
  bf16_t* proj = (bf16_t*)(ws + WS_PROJ);
  bf16_t* act = (bf16_t*)(ws + WS_ACT);
  bf16_t* ys = (bf16_t*)(ws + WS_YS);
  bf16_t* part_o = (bf16_t*)(ws + WS_PARTO);
  float2* part_ml = (float2*)(ws + WS_PARTML);
  unsigned* mlist = (unsigned*)(ws + WS_MLIST);
  float* out = p.out;
  const int nblk = gridDim.x, bid = blockIdx.x;
  volatile LAS unsigned* bst = (volatile LAS unsigned*)(LAS char*)(lds + LDS_BST);
  if (threadIdx.x < 2) bst[threadIdx.x] = 0u;
  __syncthreads();
  const XcdBarrier xb = xcd_barrier_post(ctl + CW_BAR, bst);
#define GSYNC() xcd_barrier(xb)
  grid.sync();

  {
    const int mb = nblk - 1 - bid;
    mod_units(lds, mb, nblk, p.c, p.ada_w, p.ada_b, mod);
    prep_small_units(lds, bid, nblk, p.w_in, p.w_out, p.rgw, p.rew, winT, woutT, rt);
  }
  GSYNC();
  rmsmod_phase(p.x, p.norm1_g, mod + 0, mod + 1024, hb);
  GSYNC();

  for (int l = 0; l < 2; ++l) {
    char* wsl = p.ws; asm volatile("" : "+s"(wsl));
    unsigned* ctl = (unsigned*)(wsl + WS_CTL);
    float* mod = (float*)(wsl + WS_MOD);
    float* kmean = (float*)(wsl + WS_KMEAN);
    float* gate = (float*)(wsl + WS_GATE);
    float* logits = (float*)(wsl + WS_LOGIT);
    unsigned* list = (unsigned*)(wsl + WS_LIST);
    bf16_t* winT = (bf16_t*)(wsl + WS_WINT);
    bf16_t* woutT = (bf16_t*)(wsl + WS_WOUTT);
    bf16_t* rt = (bf16_t*)(wsl + WS_RT);
    bf16_t* w13T = (bf16_t*)(wsl + WS_W13T);
    bf16_t* w2T = (bf16_t*)(wsl + WS_W2T);
    bf16_t* hb = (bf16_t*)(wsl + WS_HB);
    uint2* bmt = (uint2*)(wsl + WS_BMT);
    bf16_t* proj = (bf16_t*)(wsl + WS_PROJ);
    bf16_t* act = (bf16_t*)(wsl + WS_ACT);
    bf16_t* ys = (bf16_t*)(wsl + WS_YS);
    bf16_t* part_o = (bf16_t*)(wsl + WS_PARTO);
    float2* part_ml = (float2*)(wsl + WS_PARTML);
    unsigned* mlist = (unsigned*)(wsl + WS_MLIST);
    const float* modl = mod + (size_t)l * 4 * 6144;
    if (PROBE == 13) { GemmP P{}; P.A = hb; P.Bt = winT; P.lda = 1024; P.K = 1024; P.Obf = proj; P.ldo = PLD; gemm_phase<GM_INPROJ, 8, 1>(lds, P, T / 256, 14); GSYNC(); }
    if (PROBE == 14) { GemmP P{}; P.A = hb; P.Bt = winT; P.lda = 1024; P.K = 1024; P.Obf = proj; P.ldo = PLD; gemm_phase<GM_INPROJ, 8, 2>(lds, P, T / 256, 14); GSYNC(); }
    for (int rep = 0; rep < NREP(1); ++rep) {
      { GemmP P{}; P.A = hb; P.Bt = winT; P.lda = 1024; P.K = 1024; P.Obf = proj; P.ldo = PLD; gemm_phase<GM_INPROJ, 8>(lds, P, T / 256, 14); }
      GSYNC();
    }
    for (int u = bid; u < NB * 32; u += nblk) kmean_unit(lds, u, proj, kmean);
    GSYNC();
    unsigned* mcnt = ctl + CW_MC + l * 768;
    if (PROBE >= 10 && PROBE <= 12) {
      for (int u = bid; u < NB * 512; u += nblk) dsa_select_unit<(PROBE >= 10 && PROBE <= 12) ? PROBE - 9 : 1>(lds, proj, bmt, u & 3, 511 - (u >> 2));
      GSYNC();
    }
    for (int rep = 0; rep < NREP(2); ++rep) {
      unsigned* sq = ctl + CW_Q + 4 + 2 * rep + l;
      unsigned* qw = (unsigned*)(lds + SEL_LDS + 64);
      for (;;) {
        if (otid() == 0) qw[0] = atomicAdd(sq, 1u);
        __syncthreads();
        const int u = (int)qw[0];
        __syncthreads();
        if (u >= NB * 512 + T / 64) break;
        if (u < NB * 512) dsa_select_unit<0>(lds, proj, bmt, u & 3, 511 - (u >> 2));
        else if (rep == 0) gate_unit(lds, u - NB * 512, proj, kmean, mcnt, mlist);
      }
      GSYNC();
    }
    if (PROBE == 3) {
      attn_queue_phase(lds, proj, hb, bmt, part_o, part_ml, mcnt, mlist, ctl + CW_Q + 2 + l, p.w1 + (size_t)l * 32 * 1024 * 512, p.w3 + (size_t)l * 32 * 1024 * 512, p.w2 + (size_t)l * 32 * 512 * 1024, w13T, w2T,
                     p.conv_w + (size_t)l * 31 * 256, p.conv_b + l * 256, p.cln_g + l * 256, p.cln_b + l * 256);
      GSYNC();
    }
    attn_queue_phase(lds, proj, hb, bmt, part_o, part_ml, mcnt, mlist, ctl + CW_Q + l, p.w1 + (size_t)l * 32 * 1024 * 512, p.w3 + (size_t)l * 32 * 1024 * 512, p.w2 + (size_t)l * 32 * 512 * 1024, w13T, w2T,
                     p.conv_w + (size_t)l * 31 * 256, p.conv_b + l * 256, p.cln_g + l * 256, p.cln_b + l * 256);
    GSYNC();
    mixfin_phase(hb, p.moba_g + l * 384, p.dsa_g + l * 384, part_o, part_ml);
    GSYNC();
    { GemmP P{}; P.A = hb; P.Bt = woutT; P.lda = 1024; P.K = 1024; P.xin = (l == 0) ? p.x : out; P.xout = out; P.gvec = modl + 2048; gemm_phase<GM_OUTPROJ, 8>(lds, P, T / 256, 4); }
    GSYNC();
    for (int rep = 0; rep < NREP(4); ++rep) {
      rmsmod_phase(out, p.norm2_g + l * 1024, modl + 3072, modl + 4096, hb);
      GSYNC();
    }
    for (int rep = 0; rep < NREP(5); ++rep) {
      { GemmP P{}; P.A = hb; P.Bt = rt; P.lda = 1024; P.K = 1024; P.logits = logits; gemm_phase<GM_ROUTER, 4>(lds, P, T / 256, 1); }
      GSYNC();
    }
    int* cntl = (int*)(ctl + CW_CNT + l * 32);
    route_phase(lds, logits, p.rgb + l * 4, p.reb + l * 32, list, cntl, gate);
    GSYNC();
    for (int rep = 0; rep < NREP(6); ++rep) {
      { GemmP P{}; P.A = hb; P.Bt = w13T; P.lda = 1024; P.K = 1024; P.Obf = act; P.list = list; P.cnt = cntl; P.gate = gate; gemm_phase<GM_MOE1, 8>(lds, P, 0, 0); }
      GSYNC();
    }
    for (int rep = 0; rep < NREP(7); ++rep) {
      { GemmP P{}; P.A = act; P.Bt = w2T; P.lda = 512; P.K = 512; P.Obf = ys; P.list = list; P.cnt = cntl; P.gate = gate; gemm_phase<GM_MOE2, 8>(lds, P, 0, 0); }
      GSYNC();
    }
    for (int rep = 0; rep < NREP(9) - 1; ++rep) { GSYNC(); GSYNC(); GSYNC(); GSYNC(); GSYNC(); GSYNC(); GSYNC(); GSYNC(); GSYNC(); GSYNC(); }
    if (l == 0) {
      const float* mod1 = mod + (size_t)4 * 6144;
      combine_phase(out, ys, modl + 5120, 0, p.norm1_g + 1024, mod1 + 0, mod1 + 1024, hb);
      prep_small_units(lds, bid, nblk, p.w_in + (size_t)1024 * NIN, p.w_out + (size_t)1024 * 1024, p.rgw + 4096, p.rew + 32768, winT, woutT, rt);
      GSYNC();
    } else {
      combine_phase(out, ys, modl + 5120, 1, p.final_g, nullptr, nullptr, nullptr);
    }
  }
}

extern "C" void kernel_launch(void* const* d_in, const int* in_sizes, int n_in, void* d_out, int out_size, void* d_ws, size_t ws_size, hipStream_t stream) {
  if (ws_size < WS_END) return;
  MegaP p{};
  p.x = (const float*)d_in[0]; p.c = (const float*)d_in[1]; p.ada_w = (const float*)d_in[2]; p.ada_b = (const float*)d_in[3]; p.norm1_g = (const float*)d_in[4];
  p.w_in = (const float*)d_in[5]; p.conv_w = (const float*)d_in[6]; p.conv_b = (const float*)d_in[7]; p.cln_g = (const float*)d_in[8]; p.cln_b = (const float*)d_in[9];
  p.moba_g = (const float*)d_in[10]; p.dsa_g = (const float*)d_in[11]; p.w_out = (const float*)d_in[12]; p.norm2_g = (const float*)d_in[13]; p.rgw = (const float*)d_in[14];
  p.rgb = (const float*)d_in[15]; p.rew = (const float*)d_in[16]; p.reb = (const float*)d_in[17]; p.w1 = (const float*)d_in[18]; p.w3 = (const float*)d_in[19];
  p.w2 = (const float*)d_in[20]; p.final_g = (const float*)d_in[21];
  p.out = (float*)d_out; p.ws = (char*)d_ws;
  static int grid_blocks = 0;
  if (!grid_blocks) {
    int dev = 0, cus = 0, per_cu = 0;
    (void)hipGetDevice(&dev);
    (void)hipDeviceGetAttribute(&cus, hipDeviceAttributeMultiprocessorCount, dev);
    (void)hipFuncSetAttribute((const void*)mega, hipFuncAttributeMaxDynamicSharedMemorySize, MEGA_LDS);
    (void)hipOccupancyMaxActiveBlocksPerMultiprocessor(&per_cu, (const void*)mega, NTHR, MEGA_LDS);
    if (per_cu < 1) per_cu = 1;
    if (per_cu > 1) per_cu = 1;
    grid_blocks = cus * per_cu;
  }
  (void)hipMemsetAsync((char*)d_ws + WS_CTL, 0, 32768, stream);
  void* args[] = {&p};
  (void)hipLaunchCooperativeKernel((const void*)mega, dim3(grid_blocks), dim3(NTHR), args, MEGA_LDS, stream);
}
```
